# Optimizing an MI355X kernel written in HIP

```python
import math
import jax
import jax.numpy as jnp
from jax import lax

D_MODEL = 1024
BATCH = 1
SEQ = 16384
DEPTH = 4

CHUNK = 64
NORM_EPS = 1e-6
CONV_K = 4
D_FF = 2816
N_MOD = 9

GDN_HEADS = 4
GDN_DK = 128
GDN_DV = 128
GDN_WIDTH = GDN_HEADS * GDN_DV
GDN_CONV_CH = 2 * GDN_HEADS * GDN_DK + GDN_WIDTH

MLA_HEADS = 4
MLA_Q_RANK = 384
MLA_KV_RANK = 256
MLA_NOPE = 128
MLA_ROPE = 64
MLA_DV = 128
MLA_WIDTH = MLA_HEADS * MLA_DV
ROPE_THETA = 10000.0
Q_BLOCK = 128

MIX_WIDTH = GDN_WIDTH + MLA_WIDTH
EVEN_SPLITS = (GDN_CONV_CH, GDN_WIDTH, GDN_HEADS, GDN_HEADS, MLA_Q_RANK, MLA_KV_RANK, MLA_ROPE)
EVEN_IN = GDN_CONV_CH + GDN_WIDTH + 2 * GDN_HEADS + MLA_Q_RANK + MLA_KV_RANK + MLA_ROPE

SSD_D_INNER = 2 * D_MODEL
SSD_HEADDIM = 64
SSD_HEADS = SSD_D_INNER // SSD_HEADDIM
SSD_GROUPS = 4
SSD_STATE = 128
SSD_CONV_CH = SSD_D_INNER + 2 * SSD_GROUPS * SSD_STATE
ODD_SPLITS = (SSD_D_INNER, SSD_CONV_CH, SSD_HEADS)
ODD_IN = SSD_D_INNER + SSD_CONV_CH + SSD_HEADS

N_EVEN = (DEPTH + 1) // 2
N_ODD = DEPTH // 2

kernel_name = "hybrid_gdn_mla_mamba2_macaron_adaln"


def split_cols(t, sizes):
    out, start = [], 0
    for n in sizes:
        out.append(t[..., start:start + n])
        start += n
    return out


def rmsnorm(x, g):
    xf = x.astype(jnp.float32)
    y = xf * lax.rsqrt(jnp.mean(xf * xf, axis=-1, keepdims=True) + NORM_EPS)
    return (y * g.astype(jnp.float32)).astype(x.dtype)


def l2norm(x):
    xf = x.astype(jnp.float32)
    return xf * lax.rsqrt(jnp.sum(xf * xf, axis=-1, keepdims=True) + NORM_EPS)


def adaln_norm(x, g, shift, scale):
    return rmsnorm(x, g) * (1.0 + scale[:, None, :]) + shift[:, None, :]


def swiglu(h, w1, w3, w2):
    return (jax.nn.silu(h @ w1) * (h @ w3)) @ w2


def causal_conv(x, w, b=None):
    k_w = w.shape[0]
    s = x.shape[1]
    xp = jnp.pad(x, ((0, 0), (k_w - 1, 0), (0, 0)))
    y = sum(w[j] * xp[:, j:j + s] for j in range(k_w))
    return y if b is None else y + b


def rope_tables(positions, dim):
    half = dim // 2
    inv_freq = ROPE_THETA ** (-jnp.arange(half, dtype=jnp.float32) / half)
    ang = positions.astype(jnp.float32)[..., None] * inv_freq
    return jnp.cos(ang), jnp.sin(ang)


def apply_rope(x, cos, sin):
    half = x.shape[-1] // 2
    x1, x2 = x[..., :half], x[..., half:]
    return jnp.concatenate([x1 * cos - x2 * sin, x2 * cos + x1 * sin], axis=-1).astype(x.dtype)


def gated_delta_rule(q, k, v, beta_logit, a, a_log, dt_bias):
    b_, s, h, _ = q.shape
    nc = s // CHUNK
    f32 = jnp.float32
    q = l2norm(q) * (GDN_DK ** -0.5)
    k = l2norm(k)
    v = v.astype(f32)
    beta = jax.nn.sigmoid(beta_logit.astype(f32))
    g = -jnp.exp(a_log.astype(f32)) * jax.nn.softplus(a.astype(f32) + dt_bias.astype(f32))

    def to_chunks(t):
        return jnp.swapaxes(t.reshape(b_, nc, CHUNK, h, *t.shape[3:]), 2, 3)

    qc, kc, vc, bc = to_chunks(q), to_chunks(k), to_chunks(v), to_chunks(beta)
    gc = jnp.cumsum(to_chunks(g), axis=-1)
    lower = jnp.tril(jnp.ones((CHUNK, CHUNK), dtype=bool))
    strict = jnp.tril(jnp.ones((CHUNK, CHUNK), dtype=bool), -1)
    decay = jnp.exp(jnp.where(lower, gc[..., :, None] - gc[..., None, :], -jnp.inf))
    kb = kc * bc[..., None]
    a_strict = jnp.where(strict, jnp.einsum("bnhid,bnhjd->bnhij", kb, kc) * decay, 0.0)
    t_mat = a_strict + jnp.eye(CHUNK, dtype=f32)
    rhs = jnp.concatenate([vc * bc[..., None], kb * jnp.exp(gc)[..., None]], axis=-1)
    sol = lax.linalg.triangular_solve(t_mat, rhs, left_side=True, lower=True, unit_diagonal=True)
    u, w = sol[..., :GDN_DV], sol[..., GDN_DV:]
    attn = jnp.einsum("bnhid,bnhjd->bnhij", qc, kc) * decay
    g_last = gc[..., -1]
    k_end = kc * jnp.exp(g_last[..., None] - gc)[..., None]
    q_start = qc * jnp.exp(gc)[..., None]

    def step(state, inp):
        u_i, w_i, q_i, k_i, a_i, gl_i = inp
        v_new = u_i - jnp.einsum("bhck,bhkv->bhcv", w_i, state)
        o_i = jnp.einsum("bhck,bhkv->bhcv", q_i, state) + jnp.einsum("bhij,bhjv->bhiv", a_i, v_new)
        state = state * jnp.exp(gl_i)[..., None, None] + jnp.einsum("bhck,bhcv->bhkv", k_i, v_new)
        return state, o_i

    s0 = jnp.zeros((b_, h, GDN_DK, GDN_DV), f32)
    xs = (jnp.moveaxis(u, 1, 0), jnp.moveaxis(w, 1, 0), jnp.moveaxis(q_start, 1, 0),
          jnp.moveaxis(k_end, 1, 0), jnp.moveaxis(attn, 1, 0), jnp.moveaxis(g_last, 1, 0))
    _, o = lax.scan(step, s0, xs)
    return jnp.transpose(o, (1, 0, 3, 2, 4)).reshape(b_, s, h, GDN_DV)


def latent_attention(c_q, c_kv, k_rope, positions, q_norm_g, w_uq, kv_norm_g, w_ukv):
    b_, s, _ = c_q.shape
    q = jnp.einsum("bsr,rhd->bshd", rmsnorm(c_q, q_norm_g), w_uq)
    q_nope, q_pe = q[..., :MLA_NOPE], q[..., MLA_NOPE:]
    kv = jnp.einsum("bsr,rhd->bshd", rmsnorm(c_kv, kv_norm_g), w_ukv)
    k_nope, v = kv[..., :MLA_NOPE], kv[..., MLA_NOPE:]
    cos, sin = rope_tables(positions, MLA_ROPE)
    q_pe = apply_rope(q_pe, cos[:, :, None, :], sin[:, :, None, :])
    k_pe = apply_rope(k_rope, cos, sin)
    scale = (MLA_NOPE + MLA_ROPE) ** -0.5
    key_chunk = jnp.arange(s) // CHUNK

    def query_block(i):
        start = i * Q_BLOCK
        qn = lax.dynamic_slice_in_dim(q_nope, start, Q_BLOCK, axis=1)
        qp = lax.dynamic_slice_in_dim(q_pe, start, Q_BLOCK, axis=1)
        sc = jnp.einsum("bqhd,bkhd->bhqk", qn, k_nope) + jnp.einsum("bqhd,bkd->bhqk", qp, k_pe)
        sc = sc.astype(jnp.float32) * scale
        q_chunk = (start + jnp.arange(Q_BLOCK)) // CHUNK
        mask = key_chunk[None, :] <= q_chunk[:, None]
        p = jax.nn.softmax(jnp.where(mask, sc, -jnp.inf), axis=-1).astype(v.dtype)
        return jnp.einsum("bhqk,bkhd->bqhd", p, v)

    out = lax.map(query_block, jnp.arange(s // Q_BLOCK))
    return jnp.swapaxes(out, 0, 1).reshape(b_, s, MLA_WIDTH)


def ssd_chunked(x, dt_raw, bm, cm, a_log, dt_bias, d_skip):
    b_, s, _ = x.shape
    nc = s // CHUNK
    r = SSD_HEADS // SSD_GROUPS
    f32 = jnp.float32
    xh = x.astype(f32).reshape(b_, s, SSD_HEADS, SSD_HEADDIM)
    dt = jax.nn.softplus(dt_raw.astype(f32) + dt_bias.astype(f32))
    da = dt * (-jnp.exp(a_log.astype(f32)))
    xc = (xh * dt[..., None]).reshape(b_, nc, CHUNK, SSD_GROUPS, r, SSD_HEADDIM)
    bc = bm.astype(f32).reshape(b_, nc, CHUNK, SSD_GROUPS, SSD_STATE)
    cc = cm.astype(f32).reshape(b_, nc, CHUNK, SSD_GROUPS, SSD_STATE)
    acs = jnp.cumsum(da.reshape(b_, nc, CHUNK, SSD_GROUPS, r), axis=2)
    acs = jnp.transpose(acs, (0, 1, 3, 4, 2))
    lower = jnp.tril(jnp.ones((CHUNK, CHUNK), dtype=bool))
    lmat = jnp.exp(jnp.where(lower, acs[..., :, None] - acs[..., None, :], -jnp.inf))
    cb = jnp.einsum("bclgn,bcsgn->bcgls", cc, bc)
    y_diag = jnp.einsum("bcgls,bcgrls,bcsgrp->bclgrp", cb, lmat, xc)
    d_start = jnp.exp(acs)
    d_end = jnp.exp(acs[..., -1:] - acs)
    c_decay = jnp.exp(acs[..., -1])

    def step(hs, inp):
        c_i, b_i, x_i, ds_i, de_i, cd_i = inp
        y_off = jnp.einsum("blgn,bgrpn,bgrl->blgrp", c_i, hs, ds_i)
        hs = hs * cd_i[..., None, None] + jnp.einsum("blgn,bgrl,blgrp->bgrpn", b_i, de_i, x_i)
        return hs, y_off

    h0 = jnp.zeros((b_, SSD_GROUPS, r, SSD_HEADDIM, SSD_STATE), f32)
    xs = (jnp.moveaxis(cc, 1, 0), jnp.moveaxis(bc, 1, 0), jnp.moveaxis(xc, 1, 0),
          jnp.moveaxis(d_start, 1, 0), jnp.moveaxis(d_end, 1, 0), jnp.moveaxis(c_decay, 1, 0))
    _, y_off = lax.scan(step, h0, xs)
    y = (y_diag + jnp.moveaxis(y_off, 0, 1)).reshape(b_, s, SSD_HEADS, SSD_HEADDIM)
    y = y + d_skip.astype(f32)[:, None] * xh
    return y.reshape(b_, s, SSD_D_INNER)


def even_mixer(h, positions, w_in, conv_w, a_log, dt_bias, gdn_g,
               q_norm_g, w_uq, kv_norm_g, w_ukv, w_out):
    b_, s, _ = h.shape
    qkv, z, beta_logit, a, c_q, c_kv, k_rope = split_cols(h @ w_in, EVEN_SPLITS)
    qkv = jax.nn.silu(causal_conv(qkv, conv_w))
    q, k, v = split_cols(qkv, (GDN_HEADS * GDN_DK, GDN_HEADS * GDN_DK, GDN_WIDTH))
    o_a = gated_delta_rule(q.reshape(b_, s, GDN_HEADS, GDN_DK), k.reshape(b_, s, GDN_HEADS, GDN_DK),
                           v.reshape(b_, s, GDN_HEADS, GDN_DV), beta_logit, a, a_log, dt_bias)
    o_a = rmsnorm(o_a, gdn_g) * jax.nn.silu(z.astype(jnp.float32).reshape(b_, s, GDN_HEADS, GDN_DV))
    o_b = latent_attention(c_q, c_kv, k_rope, positions, q_norm_g, w_uq, kv_norm_g, w_ukv)
    o = jnp.concatenate([o_a.reshape(b_, s, GDN_WIDTH).astype(h.dtype), o_b.astype(h.dtype)], axis=-1)
    return o @ w_out


def odd_mixer(h, w_in, conv_w, conv_b, a_log, dt_bias, d_skip, norm_g, w_out):
    b_, s, _ = h.shape
    z, xbc, dt_raw = split_cols(h @ w_in, ODD_SPLITS)
    xbc = jax.nn.silu(causal_conv(xbc, conv_w, conv_b))
    xs, bm, cm = split_cols(xbc, (SSD_D_INNER, SSD_GROUPS * SSD_STATE, SSD_GROUPS * SSD_STATE))
    y = ssd_chunked(xs, dt_raw, bm, cm, a_log, dt_bias, d_skip)
    y = y * jax.nn.silu(z.astype(jnp.float32))
    yg = y.reshape(b_, s, SSD_GROUPS, SSD_D_INNER // SSD_GROUPS)
    yg = yg * lax.rsqrt(jnp.mean(yg * yg, axis=-1, keepdims=True) + NORM_EPS)
    y = (yg.reshape(b_, s, SSD_D_INNER) * norm_g.astype(jnp.float32)).astype(h.dtype)
    return y @ w_out


def setup_inputs(seed: int = 0) -> dict:
    key = jax.random.key(seed)
    ks = jax.random.split(key, 27)
    f32 = jnp.float32

    def nrm(k, shape, scale):
        return jax.random.normal(k, shape, f32) * scale

    def gain(k, shape):
        return 1.0 + 0.05 * jax.random.normal(k, shape, f32)

    def a_log_init(k, shape):
        return jnp.log(jax.random.uniform(k, shape, f32, 1.0, 16.0))

    def dt_bias_init(k, shape):
        dt = jnp.exp(jax.random.uniform(k, shape, f32, math.log(1e-3), math.log(1e-1)))
        return dt + jnp.log(-jnp.expm1(-dt))

    positions = jnp.broadcast_to(jnp.arange(SEQ, dtype=jnp.int32), (BATCH, SEQ))
    return {
        "x": nrm(ks[0], (BATCH, SEQ, D_MODEL), 1.0),
        "c": nrm(ks[1], (BATCH, D_MODEL), 1.0),
        "positions": positions,
        "ada_w": nrm(ks[2], (DEPTH, D_MODEL, N_MOD * D_MODEL), 0.5 * D_MODEL ** -0.5),
        "ada_b": nrm(ks[3], (DEPTH, N_MOD * D_MODEL), 0.02),
        "norm_g": gain(ks[4], (DEPTH, 3, D_MODEL)),
        "ffn_w1": nrm(ks[5], (DEPTH, 2, D_MODEL, D_FF), D_MODEL ** -0.5),
        "ffn_w3": nrm(ks[6], (DEPTH, 2, D_MODEL, D_FF), D_MODEL ** -0.5),
        "ffn_w2": nrm(ks[7], (DEPTH, 2, D_FF, D_MODEL), D_FF ** -0.5),
        "ev_w_in": nrm(ks[8], (N_EVEN, D_MODEL, EVEN_IN), D_MODEL ** -0.5),
        "gdn_conv_w": nrm(ks[9], (N_EVEN, CONV_K, GDN_CONV_CH), CONV_K ** -0.5),
        "gdn_A_log": a_log_init(ks[10], (N_EVEN, GDN_HEADS)),
        "gdn_dt_bias": dt_bias_init(ks[11], (N_EVEN, GDN_HEADS)),
        "gdn_norm_g": gain(ks[12], (N_EVEN, GDN_DV)),
        "mla_q_norm_g": gain(ks[13], (N_EVEN, MLA_Q_RANK)),
        "mla_w_uq": nrm(ks[14], (N_EVEN, MLA_Q_RANK, MLA_HEADS, MLA_NOPE + MLA_ROPE), MLA_Q_RANK ** -0.5),
        "mla_kv_norm_g": gain(ks[15], (N_EVEN, MLA_KV_RANK)),
        "mla_w_ukv": nrm(ks[16], (N_EVEN, MLA_KV_RANK, MLA_HEADS, MLA_NOPE + MLA_DV), MLA_KV_RANK ** -0.5),
        "ev_w_out": nrm(ks[17], (N_EVEN, MIX_WIDTH, D_MODEL), MIX_WIDTH ** -0.5),
        "ssd_w_in": nrm(ks[18], (N_ODD, D_MODEL, ODD_IN), D_MODEL ** -0.5),
        "ssd_conv_w": nrm(ks[19], (N_ODD, CONV_K, SSD_CONV_CH), CONV_K ** -0.5),
        "ssd_conv_b": nrm(ks[20], (N_ODD, SSD_CONV_CH), 0.02),
        "ssd_A_log": a_log_init(ks[21], (N_ODD, SSD_HEADS)),
        "ssd_dt_bias": dt_bias_init(ks[22], (N_ODD, SSD_HEADS)),
        "ssd_D": gain(ks[23], (N_ODD, SSD_HEADS)),
        "ssd_norm_g": gain(ks[24], (N_ODD, SSD_D_INNER)),
        "ssd_w_out": nrm(ks[25], (N_ODD, SSD_D_INNER, D_MODEL), SSD_D_INNER ** -0.5),
        "final_g": gain(ks[26], (D_MODEL,)),
    }


def reference(x, c, positions, ada_w, ada_b, norm_g, ffn_w1, ffn_w3, ffn_w2,
              ev_w_in, gdn_conv_w, gdn_A_log, gdn_dt_bias, gdn_norm_g,
              mla_q_norm_g, mla_w_uq, mla_kv_norm_g, mla_w_ukv, ev_w_out,
              ssd_w_in, ssd_conv_w, ssd_conv_b, ssd_A_log, ssd_dt_bias, ssd_D, ssd_norm_g, ssd_w_out,
              final_g):
    b_ = x.shape[0]
    c_act = jax.nn.silu(c)
    for l in range(DEPTH):
        mod = (c_act @ ada_w[l] + ada_b[l]).reshape(b_, 3, 3, D_MODEL)
        shift, scale, gate = mod[:, :, 0], mod[:, :, 1], mod[:, :, 2]
        h = adaln_norm(x, norm_g[l, 0], shift[:, 0], scale[:, 0])
        x = x + 0.5 * gate[:, 0, None] * swiglu(h, ffn_w1[l, 0], ffn_w3[l, 0], ffn_w2[l, 0])
        h = adaln_norm(x, norm_g[l, 1], shift[:, 1], scale[:, 1])
        if l % 2 == 0:
            e = l // 2
            y = even_mixer(h, positions, ev_w_in[e], gdn_conv_w[e], gdn_A_log[e], gdn_dt_bias[e],
                           gdn_norm_g[e], mla_q_norm_g[e], mla_w_uq[e], mla_kv_norm_g[e],
                           mla_w_ukv[e], ev_w_out[e])
        else:
            o = l // 2
            y = odd_mixer(h, ssd_w_in[o], ssd_conv_w[o], ssd_conv_b[o], ssd_A_log[o],
                          ssd_dt_bias[o], ssd_D[o], ssd_norm_g[o], ssd_w_out[o])
        x = x + gate[:, 1, None] * y
        h = adaln_norm(x, norm_g[l, 2], shift[:, 2], scale[:, 2])
        x = x + 0.5 * gate[:, 2, None] * swiglu(h, ffn_w1[l, 1], ffn_w3[l, 1], ffn_w2[l, 1])
    return rmsnorm(x, final_g)
```

```cpp
#include <hip/hip_runtime.h>
#include <hip/hip_cooperative_groups.h>
#include <cstdio>
namespace cg = cooperative_groups;

#define LAS __attribute__((address_space(3)))
typedef unsigned short bf16_t;
typedef short bf16x8 __attribute__((ext_vector_type(8)));
typedef float f32x4 __attribute__((ext_vector_type(4)));
typedef unsigned u32x4 __attribute__((ext_vector_type(4)));
typedef unsigned u32x2 __attribute__((ext_vector_type(2)));

constexpr int SEQ = 16384, DM = 1024, DFF = 2816, NCH = 256;
constexpr int EV_N = 2816, OD_N = 5376;
constexpr int LDS_BYTES = 147456;
constexpr size_t MiB = 1048576;
constexpr size_t OFF_MOD = 0;
constexpr size_t OFF_EGL = 256 * 1024;
constexpr size_t OFF_CD  = 320 * 1024;
constexpr size_t OFF_W   = 1 * MiB;
constexpr size_t W_13A = OFF_W, W_13B = W_13A + 11534336, W_2A = W_13B + 11534336, W_2B = W_2A + 5767168, W_MIX = W_2B + 5767168;
constexpr size_t OFF_HY  = 53 * MiB;
constexpr size_t OFF_BIG = 117 * MiB;
constexpr size_t OFF_MLA = OFF_BIG + 88 * MiB;
constexpr size_t M_CQN = OFF_MLA, M_CKVN = M_CQN + 12 * MiB, M_KPE = M_CKVN + 8 * MiB, M_Q = M_KPE + 2 * MiB, M_KN = M_Q + 24 * MiB, M_VT = M_KN + 16 * MiB;
constexpr size_t OFF_MIX = 285 * MiB;
constexpr size_t G_U = OFF_MIX, G_W = G_U + 32 * MiB, G_QS = G_W + 16 * MiB, G_KET = G_QS + 16 * MiB, G_ATT = G_KET + 16 * MiB, G_ORAW = G_ATT + 8 * MiB;
constexpr size_t WS_NEED = 413 * MiB;

struct Params {
    const float* x; const float* c; const int* pos;
    const float *ada_w, *ada_b, *norm_g, *w1, *w3, *w2, *ev_w_in, *gdn_conv_w, *gdn_A_log, *gdn_dt_bias, *gdn_norm_g,
        *mla_q_norm_g, *mla_w_uq, *mla_kv_norm_g, *mla_w_ukv, *ev_w_out, *ssd_w_in, *ssd_conv_w, *ssd_conv_b, *ssd_A_log, *ssd_dt_bias,
        *ssd_D, *ssd_norm_g, *ssd_w_out, *final_g;
    float* out; unsigned char* ws;
};

__device__ __forceinline__ float bf2f(bf16_t b) { return __uint_as_float(((unsigned)b) << 16); }
__device__ __forceinline__ bf16_t f2bf(float f) { unsigned u = __float_as_uint(f); u += 0x7FFFu + ((u >> 16) & 1u); return (bf16_t)(u >> 16); }
__device__ __forceinline__ unsigned pack2(float lo, float hi) { return (unsigned)f2bf(lo) | ((unsigned)f2bf(hi) << 16); }
__device__ __forceinline__ float silu_f(float x) { return x / (1.0f + __expf(-x)); }
__device__ __forceinline__ float sigmoid_f(float x) { return 1.0f / (1.0f + __expf(-x)); }
__device__ __forceinline__ float softplus_f(float x) { return fmaxf(x, 0.f) + log1pf(__expf(-fabsf(x))); }
__device__ __forceinline__ float wave_sum(float v) {
#pragma unroll
    for (int o = 32; o > 0; o >>= 1) v += __shfl_xor(v, o);
    return v;
}
__device__ __forceinline__ float wave_incl_scan(float v, int lane) {
#pragma unroll
    for (int o = 1; o < 64; o <<= 1) { float t = __shfl_up(v, o); if (lane >= o) v += t; }
    return v;
}
__device__ __forceinline__ f32x4 mfma16(bf16x8 a, bf16x8 b, f32x4 c) { return __builtin_amdgcn_mfma_f32_16x16x32_bf16(a, b, c, 0, 0, 0); }

__constant__ double ROPE_INV_FREQ[32] = {1.0, 0.7498942093324559, 0.5623413251903491, 0.4216965034285822, 0.31622776601683794, 0.23713737056616552, 0.1778279410038923, 0.1333521432163324, 0.1, 0.07498942093324558, 0.05623413251903491, 0.042169650342858224, 0.03162277660168379, 0.023713737056616554, 0.01778279410038923, 0.01333521432163324, 0.01, 0.007498942093324558, 0.005623413251903491, 0.004216965034285823, 0.0031622776601683794, 0.0023713737056616554, 0.0017782794100389228, 0.001333521432163324, 0.001, 0.0007498942093324559, 0.0005623413251903491, 0.00042169650342858224, 0.00031622776601683794, 0.00023713737056616554, 0.00017782794100389227, 0.0001333521432163324};
__device__ __forceinline__ void rope_cs(int pos, int idx, float& c, float& s) {
    double t = (double)pos * ROPE_INV_FREQ[idx] * 0.15915494309189535;
    t -= floor(t);
    float f = (float)t;
    s = __builtin_amdgcn_sinf(f); c = __builtin_amdgcn_cosf(f);
}

__device__ __forceinline__ int opaque_tid() { int t = threadIdx.x; asm volatile("" : "+v"(t)); return t; }

constexpr int LDS_PARAMS_OFF = 147200;
__device__ __forceinline__ Params lds_params(const unsigned char* lds) {
    Params q;
    const LAS unsigned* w = (const LAS unsigned*)(LAS unsigned char*)lds + LDS_PARAMS_OFF / 4;
    unsigned long long v[31];
#pragma unroll
    for (int i = 0; i < 31; ++i) { const unsigned lo = __builtin_amdgcn_readfirstlane(w[2 * i]), hi = __builtin_amdgcn_readfirstlane(w[2 * i + 1]); v[i] = ((unsigned long long)hi << 32) | lo; }
    q.x = (const float*)v[0]; q.c = (const float*)v[1]; q.pos = (const int*)v[2];
    q.ada_w = (const float*)v[3];
    q.ada_b = (const float*)v[4];
    q.norm_g = (const float*)v[5];
    q.w1 = (const float*)v[6];
    q.w3 = (const float*)v[7];
    q.w2 = (const float*)v[8];
    q.ev_w_in = (const float*)v[9];
    q.gdn_conv_w = (const float*)v[10];
    q.gdn_A_log = (const float*)v[11];
    q.gdn_dt_bias = (const float*)v[12];
    q.gdn_norm_g = (const float*)v[13];
    q.mla_q_norm_g = (const float*)v[14];
    q.mla_w_uq = (const float*)v[15];
    q.mla_kv_norm_g = (const float*)v[16];
    q.mla_w_ukv = (const float*)v[17];
    q.ev_w_out = (const float*)v[18];
    q.ssd_w_in = (const float*)v[19];
    q.ssd_conv_w = (const float*)v[20];
    q.ssd_conv_b = (const float*)v[21];
    q.ssd_A_log = (const float*)v[22];
    q.ssd_dt_bias = (const float*)v[23];
    q.ssd_D = (const float*)v[24];
    q.ssd_norm_g = (const float*)v[25];
    q.ssd_w_out = (const float*)v[26];
    q.final_g = (const float*)v[27];
    q.out = (float*)v[28]; q.ws = (unsigned char*)v[29];
    return q;
}
namespace pg8 {
#define PG8_LAS __attribute__((address_space(3)))
typedef unsigned short bf16_t;
typedef short bf16x8 __attribute__((ext_vector_type(8)));
typedef float f32x4 __attribute__((ext_vector_type(4)));
typedef unsigned u32x4 __attribute__((ext_vector_type(4)));
constexpr int BM = 256, BK = 64, HALF = 128, HTB = HALF * BK * 2  , STAGE_BYTES = 8 * HTB, NXCD = 8, WGM = 8;

__host__ __device__ __forceinline__ int lds_byte(int r, int c) { const int st = (r >> 4) * 2 + (c >> 5), rr = r & 15, cc = c & 31, ob = rr * 64 + cc * 2; return st * 1024 + (ob ^ (((ob >> 9) & 1) << 5)); }
__host__ __device__ __forceinline__ void stage_rc(int b, int& R, int& C) { const int st = b / 1024, sb = b % 1024, swz = sb ^ (((sb >> 9) & 1) << 5); R = (st >> 1) * 16 + swz / 64; C = (st & 1) * 32 + (swz % 64) / 2; }
__host__ __device__ __forceinline__ int perm32(int rho) { const int n = rho >> 4, i = rho & 15; return 8 * (i >> 2) + 4 * n + (i & 3); }

struct Unit { int pm, pn; };
struct Gemm { const bf16_t* A; const bf16_t* Bt; int M, N, K; };

struct StaticOrder {
    int nM, nN, nwg, G, c;
    __host__ __device__ void init(int M, int N, int G_, int c_) { nM = M / BM; nN = N / BM; nwg = nM * nN; G = G_; c = c_; }
    __host__ __device__ bool next(int i, Unit& u) const {
        const long L = (long)i * G + c; if (L >= nwg) return false;
        int wgid = (int)L; { const int q = nwg / NXCD, r = nwg % NXCD, xcd = wgid % NXCD, off = wgid / NXCD; wgid = (xcd < r ? xcd * (q + 1) : r * (q + 1) + (xcd - r) * q) + off; }
        const int nig = WGM * nN, gid = wgid / nig, fm = gid * WGM, gsz = (nM - fm) < WGM ? (nM - fm) : WGM;
        u.pm = fm + ((wgid % nig) % gsz); u.pn = (wgid % nig) / gsz; return true;
    }
    __device__ __forceinline__ void a_ready(const Unit&) const {}
    __device__ __forceinline__ void done(const Unit&) const {}
};
__device__ __forceinline__ unsigned cvt_pk_bf16(float lo, float hi) { unsigned r; asm volatile("v_cvt_pk_bf16_f32 %0, %1, %2" : "=v"(r) : "v"(lo), "v"(hi)); return r; }
struct EpiBf16Plain {
    static constexpr bool PERM = true, AFTER_DRAIN = false;
    bf16_t* O; int ldc;
    __device__ __forceinline__ void operator()(const f32x4 (&acc)[2][2][4][2], const Unit& u, int wr, int wc, int fr, int fq) const {
        const int row0 = u.pm * BM + wr * 64 + fr; const int col0 = u.pn * BM + wc * 32 + 8 * fq;
#pragma unroll
        for (int ai = 0; ai < 2; ++ai)
#pragma unroll
            for (int m = 0; m < 4; ++m) { bf16_t* rowp = O + (size_t)(row0 + ai * HALF + m * 16) * ldc + col0;
#pragma unroll
                for (int bj = 0; bj < 2; ++bj) { const f32x4 v0 = acc[ai][bj][m][0], v1 = acc[ai][bj][m][1];
                    u32x4 w; w.x = cvt_pk_bf16(v0[0], v0[1]); w.y = cvt_pk_bf16(v0[2], v0[3]); w.z = cvt_pk_bf16(v1[0], v1[1]); w.w = cvt_pk_bf16(v1[2], v1[3]);
                    *(u32x4*)(rowp + bj * HALF) = w; } }
    }
};
struct EpiSwiglu {
    static constexpr bool PERM = true, AFTER_DRAIN = false;
    bf16_t* U; int ldc;
    __device__ __forceinline__ void operator()(const f32x4 (&acc)[2][2][4][2], const Unit& u, int wr, int wc, int fr, int fq) const {
        const int row0 = u.pm * BM + wr * 64 + fr; const int col0 = u.pn * HALF + wc * 32 + 8 * fq;
#pragma unroll
        for (int ai = 0; ai < 2; ++ai)
#pragma unroll
            for (int m = 0; m < 4; ++m) { bf16_t* rowp = U + (size_t)(row0 + ai * HALF + m * 16) * ldc + col0;
                float r[8];
#pragma unroll
                for (int n = 0; n < 2; ++n)
#pragma unroll
                    for (int j = 0; j < 4; ++j) { const float a = acc[ai][0][m][n][j], b = acc[ai][1][m][n][j]; r[n * 4 + j] = a / (1.0f + __expf(-a)) * b; }
                u32x4 w; w.x = cvt_pk_bf16(r[0], r[1]); w.y = cvt_pk_bf16(r[2], r[3]); w.z = cvt_pk_bf16(r[4], r[5]); w.w = cvt_pk_bf16(r[6], r[7]);
                *(u32x4*)rowp = w; }
    }
};
struct EpiResid {
    static constexpr bool PERM = false, AFTER_DRAIN = false;
    float* X; const float* gate; float coef;
    __device__ __forceinline__ void operator()(const f32x4 (&acc)[2][2][4][2], const Unit& u, int wr, int wc, int fr, int fq) const {
        const int row0 = u.pm * BM + wr * 64 + fr, col0 = u.pn * BM + wc * 32 + 4 * fq;
        f32x4 gv[2][2];
#pragma unroll
        for (int bj = 0; bj < 2; ++bj)
#pragma unroll
            for (int n = 0; n < 2; ++n) gv[bj][n] = *(const f32x4*)(gate + col0 + bj * HALF + n * 16) * coef;
#pragma unroll
        for (int ai = 0; ai < 2; ++ai)
#pragma unroll
            for (int m = 0; m < 4; ++m) { float* rowp = X + (size_t)(row0 + ai * HALF + m * 16) * 1024 + col0;
#pragma unroll
                for (int bj = 0; bj < 2; ++bj)
#pragma unroll
                    for (int n = 0; n < 2; ++n) { f32x4 xv = *(const f32x4*)(rowp + bj * HALF + n * 16); xv += gv[bj][n] * acc[ai][bj][m][n]; *(f32x4*)(rowp + bj * HALF + n * 16) = xv; } }
    }
};
template <class Epi, class Sched, bool STAMP = false>
__device__ __forceinline__ void gemm_phase(PG8_LAS unsigned char* lds, const Gemm g, const Sched& S, const Epi& E, unsigned long long* stamps) {
    int tid_ = threadIdx.x; asm volatile("" : "+v"(tid_)); const int tid = tid_, wid = __builtin_amdgcn_readfirstlane(tid >> 6), lane = tid & 63, wr = wid >> 2, wc = wid & 3, fr = lane & 15, fq = lane >> 4;
    const int K = g.K, nt = K / BK;
    int ts_lo = 0, ts_hi = 0, nts = 0; const unsigned long long rt_entry = STAMP ? (unsigned long long)wall_clock64() : 0ull;
#define PG8_STAMP() do { if (STAMP && wid == 0 && nts < 64) { const unsigned long long _c = (unsigned long long)clock64(); \
        ts_lo = (lane == nts) ? (int)(unsigned)_c : ts_lo; ts_hi = (lane == nts) ? (int)(unsigned)(_c >> 32) : ts_hi; ++nts; } } while (0)
    PG8_STAMP();
    unsigned voffA[2], voffB[2];
#pragma unroll
    for (int i = 0; i < 2; ++i) { int R, C; stage_rc(tid * 16 + i * 8192, R, C); const int Rb = Epi::PERM ? ((R & ~31) + perm32(R & 31)) : R;
        voffA[i] = (unsigned)(R * K + C) * 2u; voffB[i] = (unsigned)(Rb * K + C) * 2u; }
    const size_t kstep = (size_t)(BK * 2);
    const size_t hstep = (size_t)HALF * K * 2;
    const size_t tstep = 2 * hstep;
    const unsigned ldsw = (unsigned)wid * 1024u;
    const int aoff = lds_byte(wr * 64 + fr, fq * 8), boff = lds_byte(wc * 32 + fr, fq * 8);
#define PG8_SA(b, h) (((b) * 2 + (h)) * HTB)
#define PG8_SB(b, h) ((4 + (b) * 2 + (h)) * HTB)
#define PG8_STAGE(bufoff, gbase, voff) do { _Pragma("unroll") for (int _i = 0; _i < 2; ++_i) \
        __builtin_amdgcn_global_load_lds((const unsigned*)((const char*)(gbase) + (voff)[_i]), (PG8_LAS unsigned*)(lds + (bufoff) + ldsw + _i * 8192), 16, 0, 0); } while (0)
#define PG8_LDA(dst, b, h) do { _Pragma("unroll") for (int m = 0; m < 4; ++m) _Pragma("unroll") for (int k = 0; k < 2; ++k) dst[m][k] = *(const PG8_LAS bf16x8*)(lds + PG8_SA(b, h) + aoff + m * 2048 + k * 1024); } while (0)
#define PG8_LDB(dst, b, h) do { _Pragma("unroll") for (int n = 0; n < 2; ++n) _Pragma("unroll") for (int k = 0; k < 2; ++k) dst[n][k] = *(const PG8_LAS bf16x8*)(lds + PG8_SB(b, h) + boff + n * 2048 + k * 1024); } while (0)
#define PG8_MMA(ai, bj, At, Bt) do { __builtin_amdgcn_s_setprio(1); _Pragma("unroll") for (int m = 0; m < 4; ++m) _Pragma("unroll") for (int n = 0; n < 2; ++n) _Pragma("unroll") for (int k = 0; k < 2; ++k) \
        acc[ai][bj][m][n] = __builtin_amdgcn_mfma_f32_16x16x32_bf16(Bt[n][k], At[m][k], acc[ai][bj][m][n], 0, 0, 0); __builtin_amdgcn_s_setprio(0); } while (0)
#define PG8_WAIT_V(n) asm volatile("s_waitcnt vmcnt(" #n ")" ::: "memory")
#define PG8_WAIT_L(n) asm volatile("s_waitcnt lgkmcnt(" #n ")" ::: "memory")
#define PG8_BAR __builtin_amdgcn_s_barrier()
#define PG8_SCHED __builtin_amdgcn_sched_barrier(0)
    Unit cur, nxt; int ui = 0;
    if (!S.next(0, cur)) return;
    f32x4 acc[2][2][4][2];
#pragma unroll
    for (int a = 0; a < 2; ++a)
#pragma unroll
        for (int b = 0; b < 2; ++b)
#pragma unroll
            for (int m = 0; m < 4; ++m)
#pragma unroll
                for (int n = 0; n < 2; ++n) acc[a][b][m][n] = (f32x4){0.f, 0.f, 0.f, 0.f};
    bf16x8 At[4][2], B0[2][2], B1[2][2];
    const char* cA = (const char*)g.A + (size_t)cur.pm * tstep; const char* cB = (const char*)g.Bt + (size_t)cur.pn * tstep;
    S.a_ready(cur);
    PG8_STAGE(PG8_SB(0, 0), cB, voffB); PG8_STAGE(PG8_SA(0, 0), cA, voffA); PG8_STAGE(PG8_SB(0, 1), cB + hstep, voffB); PG8_STAGE(PG8_SA(0, 1), cA + hstep, voffA);
    if (wr == 1) PG8_BAR;
    PG8_WAIT_V(4); PG8_BAR;
    PG8_STAGE(PG8_SB(1, 0), cB + kstep, voffB); PG8_STAGE(PG8_SA(1, 0), cA + kstep, voffA); PG8_STAGE(PG8_SB(1, 1), cB + hstep + kstep, voffB);
    PG8_WAIT_V(6); PG8_BAR;
    PG8_STAMP();
    for (;;) {
        const bool has_next = S.next(ui + 1, nxt);
        const char* nA = has_next ? (const char*)g.A + (size_t)nxt.pm * tstep : cA; const char* nB = has_next ? (const char*)g.Bt + (size_t)nxt.pn * tstep : cB;
        for (int t = 0; t < nt; t += 2) {
            const bool last = (t == nt - 2);
            const char* a1 = cA + (size_t)(t + 1) * kstep;
            const char* a2 = last ? nA : cA + (size_t)(t + 2) * kstep; const char* b2 = last ? nB : cB + (size_t)(t + 2) * kstep;
            const char* a3 = a2 + kstep; const char* b3 = b2 + kstep;
            if (last && has_next) S.a_ready(nxt);
            PG8_LDB(B0, 0, 0); PG8_SCHED; PG8_LDA(At, 0, 0); PG8_STAGE(PG8_SA(1, 1), a1 + hstep, voffA);
            PG8_WAIT_L(8); PG8_BAR; PG8_WAIT_L(0); PG8_MMA(0, 0, At, B0); PG8_BAR; PG8_SCHED;
            PG8_LDB(B1, 0, 1); PG8_STAGE(PG8_SB(0, 0), b2, voffB);
            PG8_BAR; PG8_WAIT_L(0); PG8_MMA(0, 1, At, B1); PG8_BAR;
            PG8_LDA(At, 0, 1); PG8_STAGE(PG8_SA(0, 0), a2, voffA);
            PG8_BAR; PG8_WAIT_L(0); PG8_MMA(1, 0, At, B0); PG8_BAR; PG8_SCHED;
            PG8_STAGE(PG8_SB(0, 1), b2 + hstep, voffB);
            PG8_WAIT_V(6); PG8_BAR; PG8_MMA(1, 1, At, B1); PG8_BAR;
            PG8_LDB(B0, 1, 0); PG8_SCHED; PG8_LDA(At, 1, 0); PG8_STAGE(PG8_SA(0, 1), a2 + hstep, voffA);
            PG8_WAIT_L(8); PG8_BAR; PG8_WAIT_L(0); PG8_MMA(0, 0, At, B0); PG8_BAR; PG8_SCHED;
            PG8_LDB(B1, 1, 1); PG8_STAGE(PG8_SB(1, 0), b3, voffB);
            PG8_BAR; PG8_WAIT_L(0); PG8_MMA(0, 1, At, B1); PG8_BAR;
            PG8_LDA(At, 1, 1); PG8_STAGE(PG8_SA(1, 0), a3, voffA);
            PG8_BAR; PG8_WAIT_L(0); PG8_MMA(1, 0, At, B0); PG8_BAR; PG8_SCHED;
            PG8_STAGE(PG8_SB(1, 1), b3 + hstep, voffB);
            PG8_WAIT_V(6); PG8_BAR; PG8_MMA(1, 1, At, B1); PG8_BAR;
        }
        PG8_STAMP();
        if constexpr (!Epi::AFTER_DRAIN) { E(acc, cur, wr, wc, fr, fq); S.done(cur); }
        PG8_STAMP();
        if (!has_next) break;
#pragma unroll
        for (int a = 0; a < 2; ++a)
#pragma unroll
            for (int b = 0; b < 2; ++b)
#pragma unroll
                for (int m = 0; m < 4; ++m)
#pragma unroll
                    for (int n = 0; n < 2; ++n) acc[a][b][m][n] = (f32x4){0.f, 0.f, 0.f, 0.f};
        cur = nxt; cA = nA; cB = nB; ++ui;
    }
    PG8_WAIT_V(0);
    if (wr == 0) PG8_BAR;
    PG8_BAR;
    if constexpr (Epi::AFTER_DRAIN) { E.fused(acc, cur, wr, wc, fr, fq, lds, wid, lane); S.done(cur); }
    PG8_STAMP();
    if (STAMP && wid == 0) { stamps[lane] = lane < nts ? (((unsigned long long)(unsigned)ts_hi << 32) | (unsigned)ts_lo) : 0ull;
        if (lane == 62) stamps[62] = rt_entry; if (lane == 63) stamps[63] = (unsigned long long)wall_clock64(); }
#undef PG8_STAMP
#undef PG8_SA
#undef PG8_SB
#undef PG8_STAGE
#undef PG8_LDA
#undef PG8_LDB
#undef PG8_MMA
#undef PG8_WAIT_V
#undef PG8_WAIT_L
#undef PG8_BAR
#undef PG8_SCHED
}
}

__device__ void phase_ada(const Params& p, float* ldsf) {
    const int tid = opaque_tid(), G = gridDim.x;
    float* mod = (float*)(p.ws + OFF_MOD);
    const int cq = tid & 15, ks = tid >> 4;
    for (int t = blockIdx.x; t < 576; t += G) {
        const int l = t / 144, cgi = t % 144; const int col = cgi * 64 + cq * 4;
        const float* W = p.ada_w + (size_t)l * 1024 * 9216 + col;
        f32x4 acc = {0.f, 0.f, 0.f, 0.f};
#pragma unroll 8
        for (int k = ks * 32; k < ks * 32 + 32; ++k) { const float cv = p.c[k]; const float ca = cv / (1.0f + expf(-cv)); const f32x4 w = *(const f32x4*)(W + (size_t)k * 9216); acc += w * ca; }
        *(f32x4*)(ldsf + (ks * 16 + cq) * 4) = acc;
        __syncthreads();
        if (tid < 64) { const int cqq = tid >> 2, j = tid & 3; float s = 0.f; for (int k2 = 0; k2 < 32; ++k2) s += ldsf[(k2 * 16 + cqq) * 4 + j];
            const int o = l * 9216 + cgi * 64 + cqq * 4 + j; mod[o] = s + p.ada_b[o]; }
        __syncthreads();
    }
    const f32x4* xi = (const f32x4*)p.x; f32x4* xo = (f32x4*)p.out;
    for (size_t i = (size_t)blockIdx.x * 512 + tid; i < (size_t)SEQ * DM / 4; i += (size_t)G * 512) xo[i] = xi[i];
}

__device__ __forceinline__ int conv_col(int mode, int r, int& which) {
    which = 0;
    if (mode == 1) { const int pn = r >> 8, w = r & 255; which = (w >= 128) ? 1 : 0; return pn * 128 + (w & 127); }
    if (mode == 2) { if (r < 512) return (r >> 7) * 256 + (r & 127); const int rr = r - 512; return (rr >> 7) * 256 + 128 + (rr & 127); }
    return r;
}
__device__ void convT(bf16_t* dst, const float* src0, const float* src1, int K, int ldsrc, int Nsrc, int Ndst, int mode, int& tbase, float* tile) {
    const int G = gridDim.x, tid = opaque_tid();
    const int nkt = K >> 6, ntiles = nkt * (Ndst >> 6);
    const int first = (int)(((int)blockIdx.x + G - (tbase % G)) % G);
    for (int t = first; t < ntiles; t += G) {
        const int nt_ = t / nkt, kt = t % nkt; const int r0 = nt_ * 64, k0 = kt * 64;
        { const int n = tid & 63, kk = tid >> 6; int which; const int col = conv_col(mode, r0 + n, which); const bool valid = col < Nsrc;
          const float* src = which ? src1 : src0;
#pragma unroll
          for (int it = 0; it < 8; ++it) { const int kl = kk + it * 8; const float v = valid ? src[(size_t)(k0 + kl) * ldsrc + col] : 0.f; tile[kl * 65 + n] = v; } }
        __syncthreads();
        { const int kp = tid & 31, n = tid >> 5;
#pragma unroll
          for (int it = 0; it < 4; ++it) { const int nn = n + it * 16; const float v0 = tile[(2 * kp) * 65 + nn], v1 = tile[(2 * kp + 1) * 65 + nn];
              *(unsigned*)(dst + (size_t)(r0 + nn) * K + k0 + 2 * kp) = pack2(v0, v1); } }
        __syncthreads();
    }
    tbase += ntiles;
}
__device__ void phase_convert(const Params& p, int l, float* tile) {
    int tb = 0;
    for (int f = 0; f < 2; ++f) {
        const size_t wo = (size_t)(l * 2 + f) * 1024 * 2816;
        convT((bf16_t*)(p.ws + (f ? W_13B : W_13A)), p.w1 + wo, p.w3 + wo, 1024, 2816, 2816, 5632, 1, tb, tile);
        convT((bf16_t*)(p.ws + (f ? W_2B : W_2A)), p.w2 + wo, nullptr, 2816, 1024, 1024, 1024, 0, tb, tile);
    }
    const int e = l >> 1;
    if ((l & 1) == 0) {
        bf16_t* wi = (bf16_t*)(p.ws + W_MIX); bf16_t* wout = wi + 2816 * 1024; bf16_t* wuq = wout + 1024 * 1024; bf16_t* wukv = wuq + 768 * 384;
        convT(wi, p.ev_w_in + (size_t)e * 1024 * 2760, nullptr, 1024, 2760, 2760, 2816, 0, tb, tile);
        convT(wout, p.ev_w_out + (size_t)e * 1024 * 1024, nullptr, 1024, 1024, 1024, 1024, 0, tb, tile);
        convT(wuq, p.mla_w_uq + (size_t)e * 384 * 768, nullptr, 384, 768, 768, 768, 0, tb, tile);
        convT(wukv, p.mla_w_ukv + (size_t)e * 256 * 1024, nullptr, 256, 1024, 1024, 1024, 2, tb, tile);
    } else {
        bf16_t* wi = (bf16_t*)(p.ws + W_MIX); bf16_t* wout = wi + 5376 * 1024;
        convT(wi, p.ssd_w_in + (size_t)e * 1024 * 5152, nullptr, 1024, 5152, 5152, 5376, 0, tb, tile);
        convT(wout, p.ssd_w_out + (size_t)e * 2048 * 1024, nullptr, 2048, 1024, 1024, 1024, 0, tb, tile);
    }
}

__device__ void phase_norm(const float* X, bf16_t* H, const float* g, const float* shift, const float* scale) {
    const int tid = opaque_tid(), wave = tid >> 6, lane = tid & 63;
    for (int row = blockIdx.x * 8 + wave; row < SEQ; row += gridDim.x * 8) {
        const f32x4* xr = (const f32x4*)(X + (size_t)row * 1024);
        f32x4 v[4]; float ss = 0.f;
#pragma unroll
        for (int i = 0; i < 4; ++i) { v[i] = xr[lane + 64 * i]; ss += v[i][0] * v[i][0] + v[i][1] * v[i][1] + v[i][2] * v[i][2] + v[i][3] * v[i][3]; }
        ss = wave_sum(ss);
        const float rstd = rsqrtf(ss * (1.0f / 1024.0f) + 1e-6f);
#pragma unroll
        for (int i = 0; i < 4; ++i) { const int col = (lane + 64 * i) * 4;
            const f32x4 g4 = *(const f32x4*)(g + col), sc = *(const f32x4*)(scale + col), sh = *(const f32x4*)(shift + col);
            float y[4];
#pragma unroll
            for (int j = 0; j < 4; ++j) y[j] = (v[i][j] * rstd * g4[j]) * (1.0f + sc[j]) + sh[j];
            u32x2 w; w.x = pack2(y[0], y[1]); w.y = pack2(y[2], y[3]);
            *(u32x2*)(H + (size_t)row * 1024 + col) = w; }
    }
}
__device__ void phase_final(float* X, const float* g) {
    const int tid = opaque_tid(), wave = tid >> 6, lane = tid & 63;
    for (int row = blockIdx.x * 8 + wave; row < SEQ; row += gridDim.x * 8) {
        f32x4* xr = (f32x4*)(X + (size_t)row * 1024);
        f32x4 v[4]; float ss = 0.f;
#pragma unroll
        for (int i = 0; i < 4; ++i) { v[i] = xr[lane + 64 * i]; ss += v[i][0] * v[i][0] + v[i][1] * v[i][1] + v[i][2] * v[i][2] + v[i][3] * v[i][3]; }
        ss = wave_sum(ss);
        const float rstd = rsqrtf(ss * (1.0f / 1024.0f) + 1e-6f);
#pragma unroll
        for (int i = 0; i < 4; ++i) { const f32x4 g4 = *(const f32x4*)(g + (lane + 64 * i) * 4); xr[lane + 64 * i] = v[i] * rstd * g4; }
    }
}

__device__ void phase_mla_prep(const Params& p, int e) {
    const int tid = opaque_tid(), wave = tid >> 6, lane = tid & 63;
    const bf16_t* P = (const bf16_t*)(p.ws + OFF_BIG);
    bf16_t* CQN = (bf16_t*)(p.ws + M_CQN); bf16_t* CKVN = (bf16_t*)(p.ws + M_CKVN); bf16_t* KPE = (bf16_t*)(p.ws + M_KPE);
    const float* gq = p.mla_q_norm_g + e * 384; const float* gkv = p.mla_kv_norm_g + e * 256;
    for (int tok = blockIdx.x * 8 + wave; tok < SEQ; tok += gridDim.x * 8) {
        const bf16_t* pr = P + (size_t)tok * EV_N;
        { float q[6]; float ss = 0.f;
#pragma unroll
          for (int i = 0; i < 3; ++i) { const unsigned w = *(const unsigned*)(pr + 2056 + lane * 2 + 128 * i); q[2 * i] = bf2f((bf16_t)(w & 0xffff)); q[2 * i + 1] = bf2f((bf16_t)(w >> 16)); ss += q[2 * i] * q[2 * i] + q[2 * i + 1] * q[2 * i + 1]; }
          ss = wave_sum(ss); const float r = rsqrtf(ss * (1.0f / 384.0f) + 1e-6f);
#pragma unroll
          for (int i = 0; i < 3; ++i) { const int col = lane * 2 + 128 * i; *(unsigned*)(CQN + (size_t)tok * 384 + col) = pack2(q[2 * i] * r * gq[col], q[2 * i + 1] * r * gq[col + 1]); } }
        { const u32x2 w = *(const u32x2*)(pr + 2440 + lane * 4); float v[4] = {bf2f((bf16_t)(w.x & 0xffff)), bf2f((bf16_t)(w.x >> 16)), bf2f((bf16_t)(w.y & 0xffff)), bf2f((bf16_t)(w.y >> 16))};
          float ss = v[0] * v[0] + v[1] * v[1] + v[2] * v[2] + v[3] * v[3]; ss = wave_sum(ss); const float r = rsqrtf(ss * (1.0f / 256.0f) + 1e-6f);
          const int col = lane * 4; u32x2 o; o.x = pack2(v[0] * r * gkv[col], v[1] * r * gkv[col + 1]); o.y = pack2(v[2] * r * gkv[col + 2], v[3] * r * gkv[col + 3]);
          *(u32x2*)(CKVN + (size_t)tok * 256 + col) = o; }
        { const float v = bf2f(pr[2696 + lane]); const float pa = __shfl_xor(v, 32); float c, s; rope_cs(p.pos[tok], lane & 31, c, s);
          KPE[(size_t)tok * 64 + lane] = f2bf(lane < 32 ? v * c - pa * s : v * c + pa * s); }
    }
}

__device__ void phase_gdn_intra(const Params& p, int e, unsigned char* lds) {
    const int tid = opaque_tid(), wave = tid >> 6, lane = tid & 63, fr = lane & 15, fq = lane >> 4;
    float* R0 = (float*)lds; float* R1 = (float*)(lds + 33792); float* R2 = (float*)(lds + 67584);
    bf16_t* QB = (bf16_t*)(lds + 101376); bf16_t* KB = (bf16_t*)(lds + 118784);
    float* sBeta = (float*)(lds + 136192); float* sGc = sBeta + 64;
    const bf16_t* P = (const bf16_t*)(p.ws + OFF_BIG);
    float* U = (float*)(p.ws + G_U); bf16_t* Wb = (bf16_t*)(p.ws + G_W); bf16_t* QS = (bf16_t*)(p.ws + G_QS); bf16_t* KET = (bf16_t*)(p.ws + G_KET); bf16_t* ATT = (bf16_t*)(p.ws + G_ATT);
    float* EGL = (float*)(p.ws + OFF_EGL);
    const float* cw = p.gdn_conv_w + (size_t)e * 4 * 1536;
    for (int item = blockIdx.x; item < 1024; item += gridDim.x) {
        const int h = item & 3, n = item >> 2, tok0 = n * 64;
        if (tid < 384) {
            const int part = tid >> 7, c = tid & 127, ch = part * 512 + h * 128 + c;
            const float w0 = cw[ch], w1 = cw[1536 + ch], w2 = cw[3072 + ch], w3 = cw[4608 + ch];
            const bf16_t* src = P + (size_t)tok0 * EV_N + ch;
            float x0 = 0.f, x1 = 0.f, x2 = 0.f;
            if (tok0 > 0) { x0 = bf2f(src[-3 * EV_N]); x1 = bf2f(src[-2 * EV_N]); x2 = bf2f(src[-1 * EV_N]); }
            float* dst = (part == 0 ? R0 : (part == 1 ? R1 : R2)) + c;
#pragma unroll 8
            for (int t = 0; t < 64; ++t) { const float x3 = bf2f(src[(size_t)t * EV_N]); const float y = w0 * x0 + w1 * x1 + w2 * x2 + w3 * x3; dst[t * 132] = silu_f(y); x0 = x1; x1 = x2; x2 = x3; }
        } else if (tid < 448) {
            const int t = tid - 384; const bf16_t* pr = P + (size_t)(tok0 + t) * EV_N;
            const float bl = bf2f(pr[2048 + h]), a = bf2f(pr[2052 + h]);
            sBeta[t] = sigmoid_f(bl);
            float g = -expf(p.gdn_A_log[e * 4 + h]) * softplus_f(a + p.gdn_dt_bias[e * 4 + h]);
            g = wave_incl_scan(g, lane);
            sGc[t] = g;
        }
        __syncthreads();
        for (int i = 0; i < 16; ++i) {
            const int r = wave * 16 + i; const bool isq = r < 64; const int t = r & 63; float* row = (isq ? R0 : R1) + t * 132;
            float a = row[lane], b = row[lane + 64]; const float ss = wave_sum(a * a + b * b); const float sc = rsqrtf(ss + 1e-6f) * (isq ? 0.08838834764831845f : 1.0f);
            a *= sc; b *= sc;
            bf16_t* brow = (isq ? QB : KB) + t * 136; brow[lane] = f2bf(a); brow[lane + 64] = f2bf(b);
            if (!isq) { row[lane] = a; row[lane + 64] = b; }
            else { const float eg = __expf(sGc[t]); bf16_t* qo = QS + (size_t)(tok0 + t) * 512 + h * 128; qo[lane] = f2bf(a * eg); qo[lane + 64] = f2bf(b * eg); }
        }
        __syncthreads();
        {
            float* Amat = R0;
            const int m = wave >> 2, ib = wave & 3; const bf16_t* Y = m ? QB : KB;
            bf16x8 yf[4];
#pragma unroll
            for (int ks = 0; ks < 4; ++ks) yf[ks] = *(const bf16x8*)(Y + (ib * 16 + fr) * 136 + ks * 32 + fq * 8);
            const int irow = ib * 16 + fr; const float gi = sGc[irow], bi = sBeta[irow];
#pragma unroll
            for (int jb = 0; jb < 4; ++jb) {
                f32x4 d = {0.f, 0.f, 0.f, 0.f};
#pragma unroll
                for (int ks = 0; ks < 4; ++ks) { const bf16x8 xf = *(const bf16x8*)(KB + (jb * 16 + fr) * 136 + ks * 32 + fq * 8); d = mfma16(xf, yf[ks], d); }
                float v[4];
#pragma unroll
                for (int i = 0; i < 4; ++i) { const int j = jb * 16 + fq * 4 + i; const bool keep = m ? (j <= irow) : (j < irow); const float dec = keep ? __expf(gi - sGc[j]) : 0.f; v[i] = d[i] * dec * (m ? 1.0f : bi); }
                if (m == 0) { f32x4 o = {v[0], v[1], v[2], v[3]}; *(f32x4*)(Amat + irow * 64 + jb * 16 + fq * 4) = o; }
                else { u32x2 o; o.x = pack2(v[0], v[1]); o.y = pack2(v[2], v[3]); *(u32x2*)(ATT + ((size_t)(h * 256 + n) * 64 + irow) * 64 + jb * 16 + fq * 4) = o; }
            }
            const float gl = sGc[63];
            { const int t = tid & 63; const float ek = __expf(gl - sGc[t]);
#pragma unroll 4
              for (int it = 0; it < 16; ++it) { const int k = (tid >> 6) + 8 * it; KET[((size_t)(h * 256 + n) * 128 + k) * 64 + t] = f2bf(R1[t * 132 + k] * ek); } }
            if (tid == 0) EGL[h * 256 + n] = __expf(gl);
        }
        __syncthreads();
        if (tid < 256) {
            const float* Amat = R0;
            const int c = tid & 127; const bool isw = tid >= 128;
            float s[64];
#pragma unroll
            for (int i = 0; i < 64; ++i) s[i] = 0.f;
#pragma unroll
            for (int i = 0; i < 64; ++i) {
                float rhs = isw ? R1[i * 132 + c] * sBeta[i] * __expf(sGc[i]) : R2[i * 132 + c] * sBeta[i];
#pragma unroll
                for (int j4 = 0; j4 < (i + 3) / 4; ++j4) { const f32x4 a = *(const f32x4*)(Amat + i * 64 + j4 * 4);
                    rhs -= a[0] * s[j4 * 4 + 0]; rhs -= a[1] * s[j4 * 4 + 1]; rhs -= a[2] * s[j4 * 4 + 2]; rhs -= a[3] * s[j4 * 4 + 3]; }
                s[i] = rhs;
                if (isw) Wb[(size_t)(tok0 + i) * 512 + h * 128 + c] = f2bf(rhs); else U[(size_t)(tok0 + i) * 512 + h * 128 + c] = rhs;
            }
        }
        __syncthreads();
    }
}

__device__ void phase_gdn_scan(const Params& p, unsigned char* lds_) {
    const int tid = opaque_tid(), wave = __builtin_amdgcn_readfirstlane(tid >> 6), lane = tid & 63, fr = lane & 15, fq = lane >> 4;
    const int h = blockIdx.x >> 3, j0 = (blockIdx.x & 7) * 16;
    LAS bf16_t* ST = (LAS bf16_t*)lds_; LAS bf16_t* VN = ST + 16 * 136;
    for (int i = tid; i < 16 * 136 / 2; i += 512) ((LAS unsigned*)ST)[i] = 0u;
    __syncthreads();
    const float* U = (const float*)(p.ws + G_U); const bf16_t* Wb = (const bf16_t*)(p.ws + G_W); const bf16_t* QS = (const bf16_t*)(p.ws + G_QS);
    const bf16_t* KET = (const bf16_t*)(p.ws + G_KET); const bf16_t* ATT = (const bf16_t*)(p.ws + G_ATT); const float* EG = (const float*)(p.ws + OFF_EGL) + h * 256;
    float* ORAW = (float*)(p.ws + G_ORAW);
    const bool lo = wave < 4; const int rb = wave & 3;
    const bf16_t* A1 = (lo ? Wb : QS) + (size_t)(rb * 16 + fr) * 512 + h * 128 + fq * 8;
    const size_t uoff = (size_t)(rb * 16 + fq * 4) * 512 + h * 128 + j0 + fr;
    const bf16_t* ATp = ATT + ((size_t)(h * 256) * 64 + rb * 16 + fr) * 64 + fq * 8;
    const bf16_t* KEp = KET + ((size_t)(h * 256) * 128 + wave * 16 + fr) * 64 + fq * 8;
    f32x4 Sreg = {0.f, 0.f, 0.f, 0.f};
    bf16x8 a1[4], ka[2], at[2]; float uu[4]; float eg;
#define GDN_LOAD(N_, a1_, ka_, at_, uu_, eg_) do { const size_t tb_ = (size_t)(N_) * 64 * 512; \
        _Pragma("unroll") for (int ks = 0; ks < 4; ++ks) a1_[ks] = *(const bf16x8*)(A1 + tb_ + ks * 32); \
        _Pragma("unroll") for (int ks = 0; ks < 2; ++ks) { ka_[ks] = *(const bf16x8*)(KEp + (size_t)(N_) * 8192 + ks * 32); at_[ks] = *(const bf16x8*)(ATp + (size_t)(N_) * 4096 + ks * 32); } \
        _Pragma("unroll") for (int i = 0; i < 4; ++i) uu_[i] = U[tb_ + uoff + (size_t)i * 512]; \
        eg_ = EG[N_]; } while (0)
    GDN_LOAD(0, a1, ka, at, uu, eg);
#pragma unroll 1
    for (int n = 0; n < NCH; ++n) {
        const int nn = (n + 1 < NCH) ? n + 1 : n;
        bf16x8 a1n[4], kan[2], atn[2]; float uun[4]; float egn;
        GDN_LOAD(nn, a1n, kan, atn, uun, egn);
        bf16x8 sb[4];
#pragma unroll
        for (int ks = 0; ks < 4; ++ks) sb[ks] = *(const LAS bf16x8*)(ST + fr * 136 + ks * 32 + fq * 8);
        f32x4 acc1 = {0.f, 0.f, 0.f, 0.f};
#pragma unroll
        for (int ks = 0; ks < 4; ++ks) acc1 = mfma16(a1[ks], sb[ks], acc1);
        if (lo) { u32x2 w; w.x = pack2(uu[0] - acc1[0], uu[1] - acc1[1]); w.y = pack2(uu[2] - acc1[2], uu[3] - acc1[3]); *(LAS u32x2*)(VN + fr * 72 + rb * 16 + fq * 4) = w; }
        __syncthreads();
        bf16x8 vb[2];
#pragma unroll
        for (int ks = 0; ks < 2; ++ks) vb[ks] = *(const LAS bf16x8*)(VN + fr * 72 + ks * 32 + fq * 8);
        if (!lo) { f32x4 o = acc1;
#pragma unroll
            for (int ks = 0; ks < 2; ++ks) o = mfma16(at[ks], vb[ks], o);
            float* op = ORAW + (size_t)n * 64 * 512 + uoff;
#pragma unroll
            for (int i = 0; i < 4; ++i) op[(size_t)i * 512] = o[i]; }
        f32x4 sacc = Sreg * eg;
#pragma unroll
        for (int ks = 0; ks < 2; ++ks) sacc = mfma16(ka[ks], vb[ks], sacc);
        Sreg = sacc;
        { u32x2 w; w.x = pack2(Sreg[0], Sreg[1]); w.y = pack2(Sreg[2], Sreg[3]); *(LAS u32x2*)(ST + fr * 136 + wave * 16 + fq * 4) = w; }
        __syncthreads();
#pragma unroll
        for (int ks = 0; ks < 4; ++ks) a1[ks] = a1n[ks];
#pragma unroll
        for (int ks = 0; ks < 2; ++ks) { ka[ks] = kan[ks]; at[ks] = atn[ks]; }
#pragma unroll
        for (int i = 0; i < 4; ++i) uu[i] = uun[i];
        eg = egn;
    }
#undef GDN_LOAD
}

__device__ void phase_gdn_post(const Params& p, int e) {
    const int tid = opaque_tid(), wave = tid >> 6, lane = tid & 63;
    const float* ORAW = (const float*)(p.ws + G_ORAW); const bf16_t* P = (const bf16_t*)(p.ws + OFF_BIG); bf16_t* O = (bf16_t*)(p.ws + OFF_HY);
    const float* gg = p.gdn_norm_g + e * 128;
    for (int r = blockIdx.x * 8 + wave; r < SEQ * 4; r += gridDim.x * 8) {
        const int tok = r >> 2, h = r & 3;
        const float* op = ORAW + (size_t)tok * 512 + h * 128; const bf16_t* zp = P + (size_t)tok * EV_N + 1536 + h * 128;
        const float a = op[lane], b = op[lane + 64]; const float ss = wave_sum(a * a + b * b); const float rs = rsqrtf(ss * (1.0f / 128.0f) + 1e-6f);
        bf16_t* o = O + (size_t)tok * 1024 + h * 128;
        o[lane] = f2bf(a * rs * gg[lane] * silu_f(bf2f(zp[lane]))); o[lane + 64] = f2bf(b * rs * gg[lane + 64] * silu_f(bf2f(zp[lane + 64])));
    }
}

__device__ void phase_attn(const Params& p, unsigned char* lds_) {
    const int tid = opaque_tid(), wave = __builtin_amdgcn_readfirstlane(tid >> 6), lane = tid & 63, fr = lane & 15, fq = lane >> 4;
    LAS unsigned char* lds = (LAS unsigned char*)lds_;
    const bf16_t* Qb = (const bf16_t*)(p.ws + M_Q); const bf16_t* KN = (const bf16_t*)(p.ws + M_KN); const bf16_t* VT = (const bf16_t*)(p.ws + M_VT); const bf16_t* KPE = (const bf16_t*)(p.ws + M_KPE);
    bf16_t* O = (bf16_t*)(p.ws + OFF_HY);
    const float C = 0.07216878364870323f * 1.4426950408889634f;
    const int sw = (fr >> 1) & 7;
    const int kbn = fr * 256 + ((fq ^ fr) << 4);
    const int kbp = 16384 + fr * 128 + ((fq ^ sw) << 4);
    const int vb0 = fr * 128 + (((fq >> 1) ^ sw) << 4) + (fq & 1) * 8;
    for (int u = blockIdx.x; u < 256; u += gridDim.x) {
        const int h = u & 3, x = u >> 2;
        const int blk = (wave < 4) ? x : 127 - x;
        const int rowbase = blk * 128 + (wave & 3) * 32;
        const int cw = rowbase >> 6;
        const int ktmax = 2 * (127 - x) + 1;
        unsigned okn[2], okp, ov[2];
#pragma unroll
        for (int j = 0; j < 2; ++j) { const int key = (wave * 2 + j) * 4 + (lane >> 4); okn[j] = (unsigned)(key * 512 + h * 128 + (((lane & 15) ^ (key & 15)) << 3)); }
        { const int key = wave * 8 + (lane >> 3); okp = (unsigned)(key * 64 + (((lane & 7) ^ ((key >> 1) & 7)) << 3)); }
#pragma unroll
        for (int j = 0; j < 2; ++j) { const int d = (wave * 2 + j) * 8 + (lane >> 3); ov[j] = (unsigned)((h * 128 + d) * SEQ + (((lane & 7) ^ ((d >> 1) & 7)) << 3)); }
#define ATT_DMA(KT_) do { LAS unsigned char* b_ = lds + ((KT_) & 1) * 40960; const bf16_t* kn_ = KN + (size_t)(KT_) * 64 * 512; const bf16_t* kq_ = KPE + (size_t)(KT_) * 64 * 64; const bf16_t* vt_ = VT + (size_t)(KT_) * 64; \
        _Pragma("unroll") for (int j = 0; j < 2; ++j) __builtin_amdgcn_global_load_lds((const unsigned*)(kn_ + okn[j]), (LAS unsigned*)(b_ + (wave * 2 + j) * 1024), 16, 0, 0); \
        __builtin_amdgcn_global_load_lds((const unsigned*)(kq_ + okp), (LAS unsigned*)(b_ + 16384 + wave * 1024), 16, 0, 0); \
        _Pragma("unroll") for (int j = 0; j < 2; ++j) __builtin_amdgcn_global_load_lds((const unsigned*)(vt_ + ov[j]), (LAS unsigned*)(b_ + 24576 + (wave * 2 + j) * 1024), 16, 0, 0); } while (0)
        ATT_DMA(0);
        bf16x8 qf[2][6];
#pragma unroll
        for (int qs = 0; qs < 2; ++qs) {
            const int row = rowbase + qs * 16 + fr; const bf16_t* qp = Qb + (size_t)row * 768 + h * 192 + fq * 8;
#pragma unroll
            for (int ks = 0; ks < 6; ++ks) qf[qs][ks] = *(const bf16x8*)(qp + ks * 32);
            const int pos = p.pos[row];
#pragma unroll
            for (int i = 0; i < 8; ++i) { float c, s; rope_cs(pos, fq * 8 + i, c, s); const float x1 = bf2f((bf16_t)qf[qs][4][i]), x2 = bf2f((bf16_t)qf[qs][5][i]);
                qf[qs][4][i] = (short)f2bf(x1 * c - x2 * s); qf[qs][5][i] = (short)f2bf(x2 * c + x1 * s); }
        }
        f32x4 acc[2][8];
#pragma unroll
        for (int qs = 0; qs < 2; ++qs)
#pragma unroll
            for (int db = 0; db < 8; ++db) acc[qs][db] = (f32x4){0.f, 0.f, 0.f, 0.f};
        float mrun[2] = {-1e30f, -1e30f}, lrun[2] = {0.f, 0.f};
#pragma unroll 1
        for (int kt = 0; kt <= ktmax; ++kt) {
            asm volatile("s_waitcnt vmcnt(0)" ::: "memory");
            __syncthreads();
            asm volatile("" ::: "memory");
            if (kt < ktmax) ATT_DMA(kt + 1);
            if (kt <= cw) {
                LAS unsigned char* Kt = lds + (kt & 1) * 40960; LAS unsigned char* Vt = Kt + 24576;
                f32x4 st[2][4];
#pragma unroll
                for (int qs = 0; qs < 2; ++qs)
#pragma unroll
                    for (int nb = 0; nb < 4; ++nb) st[qs][nb] = (f32x4){0.f, 0.f, 0.f, 0.f};
#pragma unroll
                for (int ks = 0; ks < 6; ++ks)
#pragma unroll
                    for (int nb = 0; nb < 4; ++nb) { const bf16x8 a = (ks < 4) ? *(const LAS bf16x8*)(Kt + (kbn ^ (ks << 6)) + nb * 4096) : *(const LAS bf16x8*)(Kt + (kbp ^ ((ks - 4) << 6)) + nb * 2048);
                        st[0][nb] = mfma16(a, qf[0][ks], st[0][nb]); st[1][nb] = mfma16(a, qf[1][ks], st[1][nb]); }
                bf16x8 bp[2][2];
#pragma unroll
                for (int qs = 0; qs < 2; ++qs) {
                    float mx = -1e30f;
#pragma unroll
                    for (int nb = 0; nb < 4; ++nb)
#pragma unroll
                        for (int i = 0; i < 4; ++i) mx = fmaxf(mx, st[qs][nb][i]);
                    mx = fmaxf(mx, __shfl_xor(mx, 16)); mx = fmaxf(mx, __shfl_xor(mx, 32));
                    const float mnew = fmaxf(mrun[qs], mx * C); const float alpha = __builtin_amdgcn_exp2f(mrun[qs] - mnew); mrun[qs] = mnew;
                    float ps = 0.f;
#pragma unroll
                    for (int nb = 0; nb < 4; ++nb)
#pragma unroll
                        for (int i = 0; i < 4; ++i) { const float pv = __builtin_amdgcn_exp2f(st[qs][nb][i] * C - mnew); ps += pv; st[qs][nb][i] = pv; }
                    lrun[qs] = lrun[qs] * alpha + ps;
#pragma unroll
                    for (int db = 0; db < 8; ++db) acc[qs][db] *= alpha;
#pragma unroll
                    for (int kk = 0; kk < 2; ++kk) { u32x4 w; w.x = pack2(st[qs][2 * kk][0], st[qs][2 * kk][1]); w.y = pack2(st[qs][2 * kk][2], st[qs][2 * kk][3]);
                        w.z = pack2(st[qs][2 * kk + 1][0], st[qs][2 * kk + 1][1]); w.w = pack2(st[qs][2 * kk + 1][2], st[qs][2 * kk + 1][3]); bp[qs][kk] = __builtin_bit_cast(bf16x8, w); }
                }
#pragma unroll
                for (int kk = 0; kk < 2; ++kk)
#pragma unroll
                    for (int db = 0; db < 8; ++db) { const u32x2 lo2 = *(const LAS u32x2*)(Vt + (vb0 ^ ((kk * 4) << 4)) + db * 2048), hi2 = *(const LAS u32x2*)(Vt + (vb0 ^ ((kk * 4 + 2) << 4)) + db * 2048);
                        u32x4 w; w.x = lo2.x; w.y = lo2.y; w.z = hi2.x; w.w = hi2.y; const bf16x8 a = __builtin_bit_cast(bf16x8, w);
                        acc[0][db] = mfma16(a, bp[0][kk], acc[0][db]); acc[1][db] = mfma16(a, bp[1][kk], acc[1][db]); }
            }
        }
#undef ATT_DMA
#pragma unroll
        for (int qs = 0; qs < 2; ++qs) {
            float l = lrun[qs]; l += __shfl_xor(l, 16); l += __shfl_xor(l, 32); const float inv = 1.0f / l;
            bf16_t* op = O + (size_t)(rowbase + qs * 16 + fr) * 1024 + 512 + h * 128 + fq * 4;
#pragma unroll
            for (int db = 0; db < 8; ++db) { u32x2 w; w.x = pack2(acc[qs][db][0] * inv, acc[qs][db][1] * inv); w.y = pack2(acc[qs][db][2] * inv, acc[qs][db][3] * inv); *(u32x2*)(op + db * 16) = w; }
        }
        __syncthreads();
    }
}

__device__ __forceinline__ void mixer_even(int e, cg::grid_group& grid, unsigned char* lds) {
#define LP() const Params p = lds_params(lds)
    { LP(); phase_mla_prep(p, e); }
    { LP(); phase_gdn_intra(p, e, lds); }
    grid.sync();
    if (blockIdx.x < 32) { LP(); phase_gdn_scan(p, lds); }
    else {
        const int Gp = gridDim.x - 32, c = blockIdx.x - 32;
#pragma unroll 1
        for (int j = 0; j < 3; ++j) {
            LP();
            const bf16_t* CQN = (const bf16_t*)(p.ws + M_CQN); const bf16_t* CKVN = (const bf16_t*)(p.ws + M_CKVN);
            const bf16_t* wuq = (const bf16_t*)(p.ws + W_MIX) + 2816 * 1024 + 1024 * 1024; const bf16_t* wukv = wuq + 768 * 384;
            pg8::Gemm g; bf16_t* Op; int ldc, off;
            if (j == 0) { g = pg8::Gemm{CQN, wuq, SEQ, 768, 384}; Op = (bf16_t*)(p.ws + M_Q); ldc = 768; off = 0; }
            else if (j == 1) { g = pg8::Gemm{CKVN, wukv, SEQ, 512, 256}; Op = (bf16_t*)(p.ws + M_KN); ldc = 512; off = 192 % Gp; }
            else { g = pg8::Gemm{wukv + 512 * 256, CKVN, 512, SEQ, 256}; Op = (bf16_t*)(p.ws + M_VT); ldc = SEQ; off = 320 % Gp; }
            pg8::StaticOrder S; S.init(g.M, g.N, Gp, (c + Gp - off) % Gp); pg8::EpiBf16Plain E{Op, ldc};
            pg8::gemm_phase<pg8::EpiBf16Plain, pg8::StaticOrder, false>((LAS unsigned char*)lds, g, S, E, nullptr);
        }
    }
    grid.sync();
    { LP(); phase_gdn_post(p, e); }
    { LP(); phase_attn(p, lds); }
    grid.sync();
#undef LP
}

#define SSD_CONV(P_, tok0_, cc_, cwt_, cb_, BODY) do { \
        const float w0_ = (cwt_)[cc_], w1_ = (cwt_)[3072 + (cc_)], w2_ = (cwt_)[6144 + (cc_)], w3_ = (cwt_)[9216 + (cc_)], b_ = (cb_)[cc_]; \
        const bf16_t* src_ = (P_) + (size_t)(tok0_) * OD_N + 2048 + (cc_); \
        float x0_ = 0.f, x1_ = 0.f, x2_ = 0.f; \
        if ((tok0_) > 0) { x0_ = bf2f(src_[-3 * OD_N]); x1_ = bf2f(src_[-2 * OD_N]); x2_ = bf2f(src_[-1 * OD_N]); } \
        _Pragma("unroll 8") for (int t = 0; t < 64; ++t) { const float x3_ = bf2f(src_[(size_t)t * OD_N]); const float y = silu_f(b_ + w0_ * x0_ + w1_ * x1_ + w2_ * x2_ + w3_ * x3_); BODY; x0_ = x1_; x1_ = x2_; x2_ = x3_; } } while (0)

__device__ void phase_ssd_states(const Params& p, int o, unsigned char* lds) {
    const int tid = opaque_tid(), wave = tid >> 6, lane = tid & 63, fr = lane & 15, fq = lane >> 4;
    bf16_t* XTS = (bf16_t*)lds; bf16_t* BT = (bf16_t*)(lds + 73728); float* sSc = (float*)(lds + 73728 + 18432);
    const bf16_t* P = (const bf16_t*)(p.ws + OFF_BIG);
    bf16_t* STt = (bf16_t*)(p.ws + OFF_MIX); float* CD = (float*)(p.ws + OFF_CD);
    const float* cwt = p.ssd_conv_w + (size_t)o * 4 * 3072; const float* cb = p.ssd_conv_b + (size_t)o * 3072;
    for (int item = blockIdx.x; item < 1024; item += gridDim.x) {
        const int g = item & 3, n = item >> 2, tok0 = n * 64;
        { const int hh = g * 8 + wave; const float raw = bf2f(P[(size_t)(tok0 + lane) * OD_N + 5120 + hh]); const float dt = softplus_f(raw + p.ssd_dt_bias[o * 32 + hh]);
          const float da = -expf(p.ssd_A_log[o * 32 + hh]) * dt; const float acs = wave_incl_scan(da, lane); const float last = __shfl(acs, 63);
          sSc[wave * 64 + lane] = dt * __expf(last - acs); if (lane == 63) CD[n * 32 + hh] = __expf(acs); }
        __syncthreads();
        { const int cc = g * 512 + tid; const float* sc = sSc + (tid >> 6) * 64; bf16_t* dst = XTS + tid * 72;
          SSD_CONV(P, tok0, cc, cwt, cb, dst[t] = f2bf(y * sc[t])); }
        if (tid < 128) { const int cc = 2048 + g * 128 + tid; bf16_t* dst = BT + tid * 72;
          SSD_CONV(P, tok0, cc, cwt, cb, dst[t] = f2bf(y)); }
        __syncthreads();
        { const int hh = g * 8 + wave;
#pragma unroll 1
          for (int pb = 0; pb < 4; ++pb) {
              bf16x8 xf[2];
#pragma unroll
              for (int ks = 0; ks < 2; ++ks) xf[ks] = *(const bf16x8*)(XTS + (wave * 64 + pb * 16 + fr) * 72 + ks * 32 + fq * 8);
#pragma unroll
              for (int nb = 0; nb < 8; ++nb) { f32x4 d = {0.f, 0.f, 0.f, 0.f};
#pragma unroll
                  for (int ks = 0; ks < 2; ++ks) { const bf16x8 bf = *(const bf16x8*)(BT + (nb * 16 + fr) * 72 + ks * 32 + fq * 8); d = mfma16(bf, xf[ks], d); }
                  u32x2 w; w.x = pack2(d[0], d[1]); w.y = pack2(d[2], d[3]);
                  *(u32x2*)(STt + (((size_t)n * 32 + hh) * 64 + pb * 16 + fr) * 128 + nb * 16 + fq * 4) = w; } } }
        __syncthreads();
    }
}

__device__ void phase_ssd_scan(const Params& p) {
    unsigned* ST = (unsigned*)(p.ws + OFF_MIX); const float* CD = (const float*)(p.ws + OFF_CD);
    for (size_t e2 = (size_t)blockIdx.x * 512 + opaque_tid(); e2 < 131072; e2 += (size_t)gridDim.x * 512) {
        const int hh = (int)(e2 >> 12); unsigned* ptr = ST + e2; float h0 = 0.f, h1 = 0.f;
#pragma unroll 1
        for (int c0 = 0; c0 < NCH; c0 += 8) {
            unsigned w[8]; float cd[8];
#pragma unroll
            for (int j = 0; j < 8; ++j) { w[j] = ptr[(size_t)(c0 + j) * 131072]; cd[j] = CD[(c0 + j) * 32 + hh]; }
#pragma unroll
            for (int j = 0; j < 8; ++j) { ptr[(size_t)(c0 + j) * 131072] = pack2(h0, h1); h0 = h0 * cd[j] + bf2f((bf16_t)(w[j] & 0xffff)); h1 = h1 * cd[j] + bf2f((bf16_t)(w[j] >> 16)); }
        }
    }
}

__device__ void phase_ssd_out(const Params& p, int o, unsigned char* lds) {
    const int tid = opaque_tid(), wave = tid >> 6, lane = tid & 63, fr = lane & 15, fq = lane >> 4;
    bf16_t* Cs = (bf16_t*)lds; bf16_t* Bs = (bf16_t*)(lds + 17408); float* CBm = (float*)(lds + 34816); bf16_t* XT = (bf16_t*)(lds + 52224);
    float* sDt = (float*)(lds + 125952); float* sAcs = sDt + 512; float* sSum = sAcs + 512;
    const bf16_t* P = (const bf16_t*)(p.ws + OFF_BIG); const bf16_t* HS = (const bf16_t*)(p.ws + OFF_MIX); bf16_t* Y = (bf16_t*)(p.ws + OFF_HY);
    const float* cwt = p.ssd_conv_w + (size_t)o * 4 * 3072; const float* cb = p.ssd_conv_b + (size_t)o * 3072;
    for (int item = blockIdx.x; item < 1024; item += gridDim.x) {
        const int g = item & 3, n = item >> 2, tok0 = n * 64;
        const int hh = g * 8 + wave;
        { const float raw = bf2f(P[(size_t)(tok0 + lane) * OD_N + 5120 + hh]); const float dt = softplus_f(raw + p.ssd_dt_bias[o * 32 + hh]);
          const float da = -expf(p.ssd_A_log[o * 32 + hh]) * dt; const float acs = wave_incl_scan(da, lane);
          sDt[wave * 64 + lane] = dt; sAcs[wave * 64 + lane] = acs; if (tid < 64) sSum[tid] = 0.f; }
        { const int cc = g * 512 + tid; bf16_t* dst = XT + tid * 72;
          SSD_CONV(P, tok0, cc, cwt, cb, dst[t] = f2bf(y)); }
        if (tid < 256) { const int ch = tid & 127; const bool isc = tid >= 128; const int cc = 2048 + (isc ? 512 : 0) + g * 128 + ch; bf16_t* dst = (isc ? Cs : Bs) + ch;
          SSD_CONV(P, tok0, cc, cwt, cb, dst[t * 136] = f2bf(y)); }
        __syncthreads();
        for (int tI = wave * 2; tI < wave * 2 + 2; ++tI) { const int lb = tI >> 2, sb = tI & 3; f32x4 d = {0.f, 0.f, 0.f, 0.f};
#pragma unroll
            for (int ks = 0; ks < 4; ++ks) { const bf16x8 xb = *(const bf16x8*)(Bs + (sb * 16 + fr) * 136 + ks * 32 + fq * 8), yb = *(const bf16x8*)(Cs + (lb * 16 + fr) * 136 + ks * 32 + fq * 8); d = mfma16(xb, yb, d); }
            *(f32x4*)(CBm + (lb * 16 + fr) * 68 + sb * 16 + fq * 4) = d; }
        __syncthreads();
        float yv[4][4][4]; float ssq[4];
        const float* dts = sDt + wave * 64; const float* acss = sAcs + wave * 64; const float Dh = p.ssd_D[o * 32 + hh];
#pragma unroll
        for (int lb = 0; lb < 4; ++lb) {
            const int l = lb * 16 + fr; const float al = acss[l]; const float eal = __expf(al);
            bf16x8 ga[2], ca[4];
#pragma unroll
            for (int ks = 0; ks < 2; ++ks) { float gv[8];
#pragma unroll
                for (int i = 0; i < 8; ++i) { const int s = ks * 32 + fq * 8 + i; gv[i] = (s <= l) ? CBm[l * 68 + s] * __expf(al - acss[s]) * dts[s] : 0.f; }
                u32x4 w; w.x = pack2(gv[0], gv[1]); w.y = pack2(gv[2], gv[3]); w.z = pack2(gv[4], gv[5]); w.w = pack2(gv[6], gv[7]); ga[ks] = __builtin_bit_cast(bf16x8, w); }
#pragma unroll
            for (int ks = 0; ks < 4; ++ks) ca[ks] = *(const bf16x8*)(Cs + l * 136 + ks * 32 + fq * 8);
            float sq = 0.f;
#pragma unroll
            for (int pb = 0; pb < 4; ++pb) {
                f32x4 yd = {0.f, 0.f, 0.f, 0.f}, yo = {0.f, 0.f, 0.f, 0.f};
#pragma unroll
                for (int ks = 0; ks < 2; ++ks) { const bf16x8 xb = *(const bf16x8*)(XT + (wave * 64 + pb * 16 + fr) * 72 + ks * 32 + fq * 8); yd = mfma16(xb, ga[ks], yd); }
#pragma unroll
                for (int ks = 0; ks < 4; ++ks) { const bf16x8 hb = *(const bf16x8*)(HS + (((size_t)n * 32 + hh) * 64 + pb * 16 + fr) * 128 + ks * 32 + fq * 8); yo = mfma16(hb, ca[ks], yo); }
                const u32x2 zw = *(const u32x2*)(P + (size_t)(tok0 + l) * OD_N + hh * 64 + pb * 16 + fq * 4);
                const float zz[4] = {bf2f((bf16_t)(zw.x & 0xffff)), bf2f((bf16_t)(zw.x >> 16)), bf2f((bf16_t)(zw.y & 0xffff)), bf2f((bf16_t)(zw.y >> 16))};
#pragma unroll
                for (int i = 0; i < 4; ++i) { const float xv = bf2f(XT[(wave * 64 + pb * 16 + fq * 4 + i) * 72 + l]); float v = yd[i] + eal * yo[i] + Dh * xv; v *= silu_f(zz[i]); yv[lb][pb][i] = v; sq += v * v; }
            }
            sq += __shfl_xor(sq, 16); sq += __shfl_xor(sq, 32);
            ssq[lb] = sq;
            if (fq == 0) atomicAdd(&sSum[l], sq);
        }
        __syncthreads();
        const float* ng = p.ssd_norm_g + (size_t)o * 2048 + hh * 64;
#pragma unroll
        for (int lb = 0; lb < 4; ++lb) { const int l = lb * 16 + fr; const float rs = rsqrtf(sSum[l] * (1.0f / 512.0f) + 1e-6f);
#pragma unroll
            for (int pb = 0; pb < 4; ++pb) { const f32x4 g4 = *(const f32x4*)(ng + pb * 16 + fq * 4);
                u32x2 w; w.x = pack2(yv[lb][pb][0] * rs * g4[0], yv[lb][pb][1] * rs * g4[1]); w.y = pack2(yv[lb][pb][2] * rs * g4[2], yv[lb][pb][3] * rs * g4[3]);
                *(u32x2*)(Y + (size_t)(tok0 + l) * 2048 + hh * 64 + pb * 16 + fq * 4) = w; } }
        __syncthreads();
    }
}

__device__ __forceinline__ void mixer_odd(int o, cg::grid_group& grid, unsigned char* lds) {
#define LP() const Params p = lds_params(lds)
    { LP(); phase_ssd_states(p, o, lds); }
    grid.sync();
    { LP(); phase_ssd_scan(p); }
    grid.sync();
    { LP(); phase_ssd_out(p, o, lds); }
    grid.sync();
#undef LP
}

__global__ void __launch_bounds__(512) mega(Params pk) {
    extern __shared__ __attribute__((aligned(16))) unsigned char lds[];
    cg::grid_group grid = cg::this_grid();
    LAS unsigned char* l3 = (LAS unsigned char*)lds;
    float* ldsf = (float*)lds;
    const int G = gridDim.x, bid = blockIdx.x;
    if (threadIdx.x == 0) {
        unsigned long long* dst = (unsigned long long*)(lds + LDS_PARAMS_OFF);
        dst[0] = (unsigned long long)pk.x; dst[1] = (unsigned long long)pk.c; dst[2] = (unsigned long long)pk.pos;
        const float* const* fp = &pk.ada_w;
        for (int i = 0; i < 25; ++i) dst[3 + i] = (unsigned long long)fp[i];
        dst[28] = (unsigned long long)pk.out; dst[29] = (unsigned long long)pk.ws;
    }
    __syncthreads();
#define LP() const Params p = lds_params(lds)
    { LP(); phase_ada(p, ldsf); }
    grid.sync();
#pragma unroll 1
    for (int l = 0; l < 4; ++l) {
        const bool even = (l & 1) == 0; const int e = l >> 1;
#pragma unroll 1
        for (int sub = 0; sub < 3; ++sub) {
            if (sub == 0) { LP(); phase_convert(p, l, ldsf); }
            { LP(); const float* ml = (const float*)(p.ws + OFF_MOD) + l * 9216 + sub * 3072;
              phase_norm(p.out, (bf16_t*)(p.ws + OFF_HY), p.norm_g + (l * 3 + sub) * 1024, ml, ml + 1024); }
            grid.sync();
            const bf16_t* A2; const bf16_t* B2; int K2; float coef;
            if (sub != 1) {
                { LP(); const bf16_t* W13 = (const bf16_t*)(p.ws + (sub ? W_13B : W_13A));
                  pg8::Gemm g{(const bf16_t*)(p.ws + OFF_HY), W13, SEQ, 5632, 1024}; pg8::StaticOrder S; S.init(SEQ, 5632, G, bid); pg8::EpiSwiglu E{(bf16_t*)(p.ws + OFF_BIG), DFF};
                  pg8::gemm_phase<pg8::EpiSwiglu, pg8::StaticOrder, false>(l3, g, S, E, nullptr); }
                grid.sync();
                { LP(); A2 = (const bf16_t*)(p.ws + OFF_BIG); B2 = (const bf16_t*)(p.ws + (sub ? W_2B : W_2A)); } K2 = DFF; coef = 0.5f;
            } else {
                const int Nin = even ? EV_N : OD_N;
                { LP(); pg8::Gemm g{(const bf16_t*)(p.ws + OFF_HY), (const bf16_t*)(p.ws + W_MIX), SEQ, Nin, 1024}; pg8::StaticOrder S; S.init(SEQ, Nin, G, bid); pg8::EpiBf16Plain E{(bf16_t*)(p.ws + OFF_BIG), Nin};
                  pg8::gemm_phase<pg8::EpiBf16Plain, pg8::StaticOrder, false>(l3, g, S, E, nullptr); }
                grid.sync();
                if (even) mixer_even(e, grid, lds); else mixer_odd(e, grid, lds);
                { LP(); A2 = (const bf16_t*)(p.ws + OFF_HY); B2 = (const bf16_t*)(p.ws + W_MIX) + (even ? 2816 * 1024 : 5376 * 1024); } K2 = even ? 1024 : 2048;
                coef = 1.0f;
            }
            { LP(); const float* ml = (const float*)(p.ws + OFF_MOD) + l * 9216 + sub * 3072;
              pg8::Gemm g{A2, B2, SEQ, 1024, K2}; pg8::StaticOrder S; S.init(SEQ, 1024, G, bid); pg8::EpiResid E{p.out, ml + 2048, coef};
              pg8::gemm_phase<pg8::EpiResid, pg8::StaticOrder, false>(l3, g, S, E, nullptr); }
            grid.sync();
        }
    }
    { LP(); phase_final(p.out, p.final_g); }
}

extern "C" void kernel_launch(void* const* d_in, const int* in_sizes, int n_in, void* d_out, int out_size, void* d_ws, size_t ws_size, hipStream_t stream) {
    static int grid_blocks = 0;
    if (grid_blocks == 0) {
        int dev = 0, cus = 0, per_cu = 0;
        hipGetDevice(&dev);
        hipDeviceGetAttribute(&cus, hipDeviceAttributeMultiprocessorCount, dev);
        if (hipFuncSetAttribute((const void*)mega, hipFuncAttributeMaxDynamicSharedMemorySize, LDS_BYTES) != hipSuccess) { fprintf(stderr, "hipFuncSetAttribute failed\n"); grid_blocks = -1; return; }
        hipOccupancyMaxActiveBlocksPerMultiprocessor(&per_cu, (const void*)mega, 512, LDS_BYTES);
        (void)hipGetLastError();
        if (per_cu < 1) per_cu = 1;
        grid_blocks = cus * per_cu;
        if (ws_size < WS_NEED || n_in != 28) { fprintf(stderr, "kernel_launch: ws %zu < %zu or n_in %d\n", ws_size, (size_t)WS_NEED, n_in); grid_blocks = -1; return; }
    }
    if (grid_blocks < 0) return;
    Params p{};
    p.x = (const float*)d_in[0]; p.c = (const float*)d_in[1]; p.pos = (const int*)d_in[2];
    const float** fp = &p.ada_w;
    for (int i = 0; i < 25; ++i) fp[i] = (const float*)d_in[3 + i];
    p.out = (float*)d_out; p.ws = (unsigned char*)d_ws;
    void* args[] = {&p};
    hipError_t e = hipLaunchCooperativeKernel((const void*)mega, dim3(grid_blocks), dim3(512), args, LDS_BYTES, stream);
    if (e != hipSuccess) fprintf(stderr, "cooperative launch failed: %s (grid %d)\n", hipGetErrorString(e), grid_blocks);
}
```

```cpp
#include <hip/hip_runtime.h>
#include <hip/hip_cooperative_groups.h>
#include <cstdio>
namespace cg = cooperative_groups;

#define LAS __attribute__((address_space(3)))
typedef unsigned short bf16_t;
typedef short bf16x8 __attribute__((ext_vector_type(8)));
typedef float f32x4 __attribute__((ext_vector_type(4)));
typedef unsigned u32x4 __attribute__((ext_vector_type(4)));
typedef unsigned u32x2 __attribute__((ext_vector_type(2)));

constexpr int PROBE = 0;
constexpr int SEQ = 16384, DM = 1024, DFF = 2816, NCH = 256;
constexpr int EV_N = 2816, OD_N = 5376;
constexpr int LDS_BYTES = 147456;
constexpr size_t MiB = 1048576;
constexpr size_t OFF_MOD = 0;
constexpr size_t OFF_EGL = 256 * 1024;
constexpr size_t OFF_CD  = 320 * 1024;
constexpr size_t OFF_W   = 1 * MiB;
constexpr size_t W_13A = OFF_W, W_13B = W_13A + 11534336, W_2A = W_13B + 11534336, W_2B = W_2A + 5767168, W_MIX = W_2B + 5767168;
constexpr size_t OFF_HY  = 53 * MiB;
constexpr size_t OFF_BIG = 117 * MiB;
constexpr size_t OFF_MLA = OFF_BIG + 88 * MiB;
constexpr size_t M_CQN = OFF_MLA, M_CKVN = M_CQN + 12 * MiB, M_KPE = M_CKVN + 8 * MiB, M_Q = M_KPE + 2 * MiB, M_KN = M_Q + 24 * MiB, M_VT = M_KN + 16 * MiB;
constexpr size_t OFF_MIX = 285 * MiB;
constexpr size_t G_U = OFF_MIX, G_W = G_U + 32 * MiB, G_QS = G_W + 16 * MiB, G_KET = G_QS + 16 * MiB, G_ATT = G_KET + 16 * MiB, G_ORAW = G_ATT + 8 * MiB;
constexpr size_t G_SST = G_ORAW, G_VNT = G_SST + 32 * MiB;
constexpr size_t W_REGION2 = 420 * MiB;
constexpr size_t WS_NEED = 473 * MiB;

struct Params {
    const float* x; const float* c; const int* pos;
    const float *ada_w, *ada_b, *norm_g, *w1, *w3, *w2, *ev_w_in, *gdn_conv_w, *gdn_A_log, *gdn_dt_bias, *gdn_norm_g,
        *mla_q_norm_g, *mla_w_uq, *mla_kv_norm_g, *mla_w_ukv, *ev_w_out, *ssd_w_in, *ssd_conv_w, *ssd_conv_b, *ssd_A_log, *ssd_dt_bias,
        *ssd_D, *ssd_norm_g, *ssd_w_out, *final_g;
    float* out; unsigned char* ws;
};

__device__ __forceinline__ float bf2f(bf16_t b) { return __uint_as_float(((unsigned)b) << 16); }
typedef float f32x2_t __attribute__((ext_vector_type(2)));
typedef __bf16 bf16x2_t __attribute__((ext_vector_type(2)));
__device__ __forceinline__ unsigned pack2(float lo, float hi) { const f32x2_t v = {lo, hi}; const bf16x2_t b = __builtin_convertvector(v, bf16x2_t); return __builtin_bit_cast(unsigned, b); }
__device__ __forceinline__ bf16_t f2bf(float f) { return (bf16_t)(pack2(f, 0.f) & 0xffffu); }
__device__ __forceinline__ float silu_f(float x) { return x * __builtin_amdgcn_rcpf(1.0f + __expf(-x)); }
__device__ __forceinline__ float sigmoid_f(float x) { return __builtin_amdgcn_rcpf(1.0f + __expf(-x)); }
__device__ __forceinline__ float softplus_f(float x) { return fmaxf(x, 0.f) + log1pf(__expf(-fabsf(x))); }
__device__ __forceinline__ float wave_sum(float v) {
#pragma unroll
    for (int o = 32; o > 0; o >>= 1) v += __shfl_xor(v, o);
    return v;
}
__device__ __forceinline__ float wave_incl_scan(float v, int lane) {
#pragma unroll
    for (int o = 1; o < 64; o <<= 1) { float t = __shfl_up(v, o); if (lane >= o) v += t; }
    return v;
}
__device__ __forceinline__ f32x4 mfma16(bf16x8 a, bf16x8 b, f32x4 c) { return __builtin_amdgcn_mfma_f32_16x16x32_bf16(a, b, c, 0, 0, 0); }

__constant__ double ROPE_INV_FREQ[32] = {1.0, 0.7498942093324559, 0.5623413251903491, 0.4216965034285822, 0.31622776601683794, 0.23713737056616552, 0.1778279410038923, 0.1333521432163324, 0.1, 0.07498942093324558, 0.05623413251903491, 0.042169650342858224, 0.03162277660168379, 0.023713737056616554, 0.01778279410038923, 0.01333521432163324, 0.01, 0.007498942093324558, 0.005623413251903491, 0.004216965034285823, 0.0031622776601683794, 0.0023713737056616554, 0.0017782794100389228, 0.001333521432163324, 0.001, 0.0007498942093324559, 0.0005623413251903491, 0.00042169650342858224, 0.00031622776601683794, 0.00023713737056616554, 0.00017782794100389227, 0.0001333521432163324};
__device__ __forceinline__ void rope_cs(int pos, int idx, float& c, float& s) {
    double t = (double)pos * ROPE_INV_FREQ[idx] * 0.15915494309189535;
    t -= floor(t);
    float f = (float)t;
    s = __builtin_amdgcn_sinf(f); c = __builtin_amdgcn_cosf(f);
}

__device__ __forceinline__ int opaque_tid() { int t = threadIdx.x; asm volatile("" : "+v"(t)); return t; }

constexpr int LDS_PARAMS_OFF = 147200;
__device__ __forceinline__ Params lds_params(const unsigned char* lds) {
    Params q;
    const LAS unsigned* w = (const LAS unsigned*)(LAS unsigned char*)lds + LDS_PARAMS_OFF / 4;
    unsigned long long v[31];
#pragma unroll
    for (int i = 0; i < 31; ++i) { const unsigned lo = __builtin_amdgcn_readfirstlane(w[2 * i]), hi = __builtin_amdgcn_readfirstlane(w[2 * i + 1]); v[i] = ((unsigned long long)hi << 32) | lo; }
    q.x = (const float*)v[0]; q.c = (const float*)v[1]; q.pos = (const int*)v[2];
    q.ada_w = (const float*)v[3];
    q.ada_b = (const float*)v[4];
    q.norm_g = (const float*)v[5];
    q.w1 = (const float*)v[6];
    q.w3 = (const float*)v[7];
    q.w2 = (const float*)v[8];
    q.ev_w_in = (const float*)v[9];
    q.gdn_conv_w = (const float*)v[10];
    q.gdn_A_log = (const float*)v[11];
    q.gdn_dt_bias = (const float*)v[12];
    q.gdn_norm_g = (const float*)v[13];
    q.mla_q_norm_g = (const float*)v[14];
    q.mla_w_uq = (const float*)v[15];
    q.mla_kv_norm_g = (const float*)v[16];
    q.mla_w_ukv = (const float*)v[17];
    q.ev_w_out = (const float*)v[18];
    q.ssd_w_in = (const float*)v[19];
    q.ssd_conv_w = (const float*)v[20];
    q.ssd_conv_b = (const float*)v[21];
    q.ssd_A_log = (const float*)v[22];
    q.ssd_dt_bias = (const float*)v[23];
    q.ssd_D = (const float*)v[24];
    q.ssd_norm_g = (const float*)v[25];
    q.ssd_w_out = (const float*)v[26];
    q.final_g = (const float*)v[27];
    q.out = (float*)v[28]; q.ws = (unsigned char*)v[29];
    return q;
}

#define XB_TMO      128
#define XB_XCNT(j)  (256  + 64 * (j))
#define XB_XSUB(j)  (1280 + 64 * (j))
#define XB_XGEN(j)  (2304 + 64 * (j))
#define XB_TOP      3328
#define XB_TOPGEN   3392
#define XCD_BAR_WORDS 3456
#define XB_SPIN_CAP (1u << 18)

__device__ __forceinline__ unsigned xb_ld(unsigned* p)              { return __hip_atomic_load(p, __ATOMIC_RELAXED, __HIP_MEMORY_SCOPE_AGENT); }
__device__ __forceinline__ unsigned xb_add(unsigned* p, unsigned v) { return __hip_atomic_fetch_add(p, v, __ATOMIC_RELAXED, __HIP_MEMORY_SCOPE_AGENT); }
__device__ __forceinline__ unsigned xb_xcc_id() { return (unsigned)__builtin_amdgcn_s_getreg((3 << 11) | 20) & 0xFu; }
#define XB_SPIN(cond, bar) do { unsigned _sp = 0; while (cond) { if (_sp < 64u) __builtin_amdgcn_s_sleep(1); else __builtin_amdgcn_s_sleep(32); \
    if ((++_sp & 255u) == 0u) { if (xb_ld(&(bar)[XB_TMO])) break; if (_sp > XB_SPIN_CAP) { atomicAdd(&(bar)[XB_TMO], 1u); break; } } } } while (0)

struct XcdBarrier {
    unsigned* bar; unsigned x;
    volatile LAS unsigned* st;
};

__device__ __forceinline__ XcdBarrier xcd_barrier_post(unsigned* bar, volatile LAS unsigned* st) {
    XcdBarrier b; b.bar = bar; b.x = xb_xcc_id(); b.st = st;
    if (threadIdx.x == 0) (void)xb_add(&bar[XB_XCNT(b.x)], 1u);
    return b;
}
__device__ __forceinline__ void xcd_barrier_complete(unsigned* bar, unsigned x, unsigned& nloc, unsigned& nx) {
    const unsigned G = gridDim.x * gridDim.y * gridDim.z;
    unsigned sum, cnt, mine, sp = 0u;
    for (;;) {
        sum = 0u; cnt = 0u; mine = 0u;
#pragma unroll
        for (unsigned j = 0; j < 16; ++j) { const unsigned c = xb_ld(&bar[XB_XCNT(j)]); sum += c; cnt += (c > 0u) ? 1u : 0u; mine = (j == x) ? c : mine; }
        if (sum == G) break;
        __builtin_amdgcn_s_sleep(1);
        if ((++sp & 255u) == 0u) { if (xb_ld(&bar[XB_TMO])) break; if (sp > XB_SPIN_CAP) { atomicAdd(&bar[XB_TMO], 1u); break; } }
    }
    nloc = mine > 0u ? mine : 1u; nx = cnt > 0u ? cnt : 1u;
}

__device__ __forceinline__ void xcd_barrier(const XcdBarrier& b) {
    asm volatile("s_waitcnt vmcnt(0)" ::: "memory");
    __syncthreads();
    if (threadIdx.x == 0) {
        unsigned* bar = b.bar;
        __builtin_amdgcn_s_waitcnt(0);
        unsigned nloc = b.st[0], nx = b.st[1];
        if (nloc == 0u) { xcd_barrier_complete(bar, b.x, nloc, nx); b.st[0] = nloc; b.st[1] = nx; }
        const unsigned old = xb_add(&bar[XB_XSUB(b.x)], 1u);
        const unsigned gen = old / nloc;
        if (old + 1u == (gen + 1u) * nloc) {
            __builtin_amdgcn_fence(__ATOMIC_RELEASE, "agent");
            asm volatile("s_waitcnt vmcnt(0)" ::: "memory");
            const unsigned og = xb_add(&bar[XB_TOP], 1u);
            const unsigned tg = og / nx;
            if (og + 1u == (tg + 1u) * nx) xb_add(&bar[XB_TOPGEN], 1u);
            else XB_SPIN(xb_ld(&bar[XB_TOPGEN]) == tg, bar);
            __builtin_amdgcn_fence(__ATOMIC_ACQUIRE, "agent");
            xb_add(&bar[XB_XGEN(b.x)], 1u);
            asm volatile("s_waitcnt vmcnt(0)" ::: "memory");
        } else {
            XB_SPIN(xb_ld(&bar[XB_XGEN(b.x)]) == gen, bar);
            __builtin_amdgcn_fence(__ATOMIC_ACQUIRE, "agent");
            asm volatile("s_waitcnt vmcnt(0)" ::: "memory");
        }
    }
    __syncthreads();
}


#define GSYNC() do { xcd_barrier(xbar); if (PROBE == 9) xcd_barrier(xbar); } while (0)
constexpr size_t OFF_BAR = 384 * 1024;

#define CONV_PAIR_HALF(P_, pitch_, col_, tok0_, T0_, w_, wstride_, cc_, b0_, b1_, BODY) do { \
        const unsigned* src_ = (const unsigned*)((P_) + (size_t)((tok0_) + (T0_)) * (pitch_) + (col_)); \
        unsigned raw_[35]; \
        _Pragma("unroll") for (int t = 0; t < 35; ++t) raw_[t] = ((t >= 3) || ((tok0_) + (T0_)) > 0) ? src_[((long)t - 3) * ((pitch_) / 2)] : 0u; \
        const float wa0_ = (w_)[cc_], wa1_ = (w_)[(wstride_) + (cc_)], wa2_ = (w_)[2 * (wstride_) + (cc_)], wa3_ = (w_)[3 * (wstride_) + (cc_)]; \
        const float wb0_ = (w_)[(cc_) + 1], wb1_ = (w_)[(wstride_) + (cc_) + 1], wb2_ = (w_)[2 * (wstride_) + (cc_) + 1], wb3_ = (w_)[3 * (wstride_) + (cc_) + 1]; \
        __builtin_amdgcn_sched_barrier(0); \
        _Pragma("unroll") for (int tt = 0; tt < 32; ++tt) { const int t = (T0_) + tt; \
            const float y0 = silu_f((b0_) + wa0_ * __uint_as_float(raw_[tt] << 16) + wa1_ * __uint_as_float(raw_[tt + 1] << 16) + wa2_ * __uint_as_float(raw_[tt + 2] << 16) + wa3_ * __uint_as_float(raw_[tt + 3] << 16)); \
            const float y1 = silu_f((b1_) + wb0_ * __uint_as_float(raw_[tt] & 0xffff0000u) + wb1_ * __uint_as_float(raw_[tt + 1] & 0xffff0000u) + wb2_ * __uint_as_float(raw_[tt + 2] & 0xffff0000u) + wb3_ * __uint_as_float(raw_[tt + 3] & 0xffff0000u)); \
            BODY; } } while (0)
#define CONV_PAIR(P_, pitch_, col_, tok0_, w_, wstride_, cc_, b0_, b1_, BODY) do { \
        const unsigned* src_ = (const unsigned*)((P_) + (size_t)(tok0_) * (pitch_) + (col_)); \
        unsigned raw_[67]; \
        _Pragma("unroll") for (int t = 0; t < 67; ++t) raw_[t] = ((t >= 3) || (tok0_) > 0) ? src_[((long)t - 3) * ((pitch_) / 2)] : 0u; \
        const float wa0_ = (w_)[cc_], wa1_ = (w_)[(wstride_) + (cc_)], wa2_ = (w_)[2 * (wstride_) + (cc_)], wa3_ = (w_)[3 * (wstride_) + (cc_)]; \
        const float wb0_ = (w_)[(cc_) + 1], wb1_ = (w_)[(wstride_) + (cc_) + 1], wb2_ = (w_)[2 * (wstride_) + (cc_) + 1], wb3_ = (w_)[3 * (wstride_) + (cc_) + 1]; \
        __builtin_amdgcn_sched_barrier(0); \
        _Pragma("unroll") for (int t = 0; t < 64; ++t) { \
            const float y0 = silu_f((b0_) + wa0_ * __uint_as_float(raw_[t] << 16) + wa1_ * __uint_as_float(raw_[t + 1] << 16) + wa2_ * __uint_as_float(raw_[t + 2] << 16) + wa3_ * __uint_as_float(raw_[t + 3] << 16)); \
            const float y1 = silu_f((b1_) + wb0_ * __uint_as_float(raw_[t] & 0xffff0000u) + wb1_ * __uint_as_float(raw_[t + 1] & 0xffff0000u) + wb2_ * __uint_as_float(raw_[t + 2] & 0xffff0000u) + wb3_ * __uint_as_float(raw_[t + 3] & 0xffff0000u)); \
            BODY; } } while (0)
namespace pg8 {
#define PG8_LAS __attribute__((address_space(3)))
typedef unsigned short bf16_t;
typedef short bf16x8 __attribute__((ext_vector_type(8)));
typedef float f32x4 __attribute__((ext_vector_type(4)));
typedef unsigned u32x4 __attribute__((ext_vector_type(4)));
constexpr int BM = 256, BK = 64, HALF = 128, HTB = HALF * BK * 2  , STAGE_BYTES = 8 * HTB, NXCD = 8, WGM = 8;

__host__ __device__ __forceinline__ int lds_byte(int r, int c) { const int st = (r >> 4) * 2 + (c >> 5), rr = r & 15, cc = c & 31, ob = rr * 64 + cc * 2; return st * 1024 + (ob ^ (((ob >> 9) & 1) << 5)); }
__host__ __device__ __forceinline__ void stage_rc(int b, int& R, int& C) { const int st = b / 1024, sb = b % 1024, swz = sb ^ (((sb >> 9) & 1) << 5); R = (st >> 1) * 16 + swz / 64; C = (st & 1) * 32 + (swz % 64) / 2; }
__host__ __device__ __forceinline__ int perm32(int rho) { const int n = rho >> 4, i = rho & 15; return 8 * (i >> 2) + 4 * n + (i & 3); }

struct Unit { int pm, pn; };
struct Gemm { const bf16_t* A; const bf16_t* Bt; int M, N, K; };

struct StaticOrder {
    int nM, nN, nwg, G, c;
    __host__ __device__ void init(int M, int N, int G_, int c_) { nM = M / BM; nN = N / BM; nwg = nM * nN; G = G_; c = c_; }
    __host__ __device__ bool next(int i, Unit& u) const {
        const long L = (long)i * G + c; if (L >= nwg) return false;
        int wgid = (int)L; { const int q = nwg / NXCD, r = nwg % NXCD, xcd = wgid % NXCD, off = wgid / NXCD; wgid = (xcd < r ? xcd * (q + 1) : r * (q + 1) + (xcd - r) * q) + off; }
        const int nig = WGM * nN, gid = wgid / nig, fm = gid * WGM, gsz = (nM - fm) < WGM ? (nM - fm) : WGM;
        u.pm = fm + ((wgid % nig) % gsz); u.pn = (wgid % nig) / gsz; return true;
    }
    __device__ __forceinline__ void a_ready(const Unit&) const {}
    __device__ __forceinline__ void done(const Unit&) const {}
};
__device__ __forceinline__ unsigned cvt_pk_bf16(float lo, float hi) { unsigned r; asm volatile("v_cvt_pk_bf16_f32 %0, %1, %2" : "=v"(r) : "v"(lo), "v"(hi)); return r; }
struct EpiBf16Plain {
    static constexpr bool PERM = true, AFTER_DRAIN = false;
    bf16_t* O; int ldc;
    __device__ __forceinline__ void operator()(const f32x4 (&acc)[2][2][4][2], const Unit& u, int wr, int wc, int fr, int fq) const {
        const int row0 = u.pm * BM + wr * 64 + fr; const int col0 = u.pn * BM + wc * 32 + 8 * fq;
#pragma unroll
        for (int ai = 0; ai < 2; ++ai)
#pragma unroll
            for (int m = 0; m < 4; ++m) { bf16_t* rowp = O + (size_t)(row0 + ai * HALF + m * 16) * ldc + col0;
#pragma unroll
                for (int bj = 0; bj < 2; ++bj) { const f32x4 v0 = acc[ai][bj][m][0], v1 = acc[ai][bj][m][1];
                    u32x4 w; w.x = cvt_pk_bf16(v0[0], v0[1]); w.y = cvt_pk_bf16(v0[2], v0[3]); w.z = cvt_pk_bf16(v1[0], v1[1]); w.w = cvt_pk_bf16(v1[2], v1[3]);
                    *(u32x4*)(rowp + bj * HALF) = w; } }
    }
};
struct EpiSwiglu {
    static constexpr bool PERM = true, AFTER_DRAIN = false;
    bf16_t* U; int ldc;
    __device__ __forceinline__ void operator()(const f32x4 (&acc)[2][2][4][2], const Unit& u, int wr, int wc, int fr, int fq) const {
        const int row0 = u.pm * BM + wr * 64 + fr; const int col0 = u.pn * HALF + wc * 32 + 8 * fq;
#pragma unroll
        for (int ai = 0; ai < 2; ++ai)
#pragma unroll
            for (int m = 0; m < 4; ++m) { bf16_t* rowp = U + (size_t)(row0 + ai * HALF + m * 16) * ldc + col0;
                float r[8];
#pragma unroll
                for (int n = 0; n < 2; ++n)
#pragma unroll
                    for (int j = 0; j < 4; ++j) { const float a = acc[ai][0][m][n][j], b = acc[ai][1][m][n][j]; r[n * 4 + j] = a * __builtin_amdgcn_rcpf(1.0f + __expf(-a)) * b; }
                u32x4 w; w.x = cvt_pk_bf16(r[0], r[1]); w.y = cvt_pk_bf16(r[2], r[3]); w.z = cvt_pk_bf16(r[4], r[5]); w.w = cvt_pk_bf16(r[6], r[7]);
                *(u32x4*)rowp = w; }
    }
};
struct EpiResid {
    static constexpr bool PERM = false, AFTER_DRAIN = false;
    float* X; const float* Xin; const float* gate; float coef;
    __device__ __forceinline__ void operator()(const f32x4 (&acc)[2][2][4][2], const Unit& u, int wr, int wc, int fr, int fq) const {
        const int row0 = u.pm * BM + wr * 64 + fr, col0 = u.pn * BM + wc * 32 + 4 * fq;
        f32x4 gv[2][2];
#pragma unroll
        for (int bj = 0; bj < 2; ++bj)
#pragma unroll
            for (int n = 0; n < 2; ++n) gv[bj][n] = *(const f32x4*)(gate + col0 + bj * HALF + n * 16) * coef;
#pragma unroll
        for (int am = 0; am < 4; ++am) {
            const int ai = am >> 1, m0 = (am & 1) * 2;
            f32x4 xv[2][2][2];
#pragma unroll
            for (int mm = 0; mm < 2; ++mm) { const float* rowp = Xin + (size_t)(row0 + ai * HALF + (m0 + mm) * 16) * 1024 + col0;
#pragma unroll
                for (int bj = 0; bj < 2; ++bj)
#pragma unroll
                    for (int n = 0; n < 2; ++n) xv[mm][bj][n] = *(const f32x4*)(rowp + bj * HALF + n * 16); }
#pragma unroll
            for (int mm = 0; mm < 2; ++mm) { float* rowp = X + (size_t)(row0 + ai * HALF + (m0 + mm) * 16) * 1024 + col0;
#pragma unroll
                for (int bj = 0; bj < 2; ++bj)
#pragma unroll
                    for (int n = 0; n < 2; ++n) *(f32x4*)(rowp + bj * HALF + n * 16) = xv[mm][bj][n] + gv[bj][n] * acc[ai][bj][m0 + mm][n]; }
            asm volatile("" ::: "memory");
        }
    }
};
template <class Epi, class Sched, bool STAMP = false>
__device__ __forceinline__ void gemm_phase(PG8_LAS unsigned char* lds, const Gemm g, const Sched& S, const Epi& E, unsigned long long* stamps) {
    int tid_ = threadIdx.x; asm volatile("" : "+v"(tid_)); const int tid = tid_, wid = __builtin_amdgcn_readfirstlane(tid >> 6), lane = tid & 63, wr = wid >> 2, wc = wid & 3, fr = lane & 15, fq = lane >> 4;
    const int K = g.K, nt = K / BK;
    int ts_lo = 0, ts_hi = 0, nts = 0; const unsigned long long rt_entry = STAMP ? (unsigned long long)wall_clock64() : 0ull;
#define PG8_STAMP() do { if (STAMP && wid == 0 && nts < 64) { const unsigned long long _c = (unsigned long long)clock64(); \
        ts_lo = (lane == nts) ? (int)(unsigned)_c : ts_lo; ts_hi = (lane == nts) ? (int)(unsigned)(_c >> 32) : ts_hi; ++nts; } } while (0)
    PG8_STAMP();
    unsigned voffA[2], voffB[2];
#pragma unroll
    for (int i = 0; i < 2; ++i) { int R, C; stage_rc(tid * 16 + i * 8192, R, C); const int Rb = Epi::PERM ? ((R & ~31) + perm32(R & 31)) : R;
        voffA[i] = (unsigned)(R * K + C) * 2u; voffB[i] = (unsigned)(Rb * K + C) * 2u; }
    const size_t kstep = (size_t)(BK * 2);
    const size_t hstep = (size_t)HALF * K * 2;
    const size_t tstep = 2 * hstep;
    const unsigned ldsw = (unsigned)wid * 1024u;
    const int aoff = lds_byte(wr * 64 + fr, fq * 8), boff = lds_byte(wc * 32 + fr, fq * 8);
#define PG8_SA(b, h) (((b) * 2 + (h)) * HTB)
#define PG8_SB(b, h) ((4 + (b) * 2 + (h)) * HTB)
#define PG8_STAGE(bufoff, gbase, voff) do { _Pragma("unroll") for (int _i = 0; _i < 2; ++_i) \
        __builtin_amdgcn_global_load_lds((const unsigned*)((const char*)(gbase) + (voff)[_i]), (PG8_LAS unsigned*)(lds + (bufoff) + ldsw + _i * 8192), 16, 0, 0); } while (0)
#define PG8_LDA(dst, b, h) do { _Pragma("unroll") for (int m = 0; m < 4; ++m) _Pragma("unroll") for (int k = 0; k < 2; ++k) dst[m][k] = *(const PG8_LAS bf16x8*)(lds + PG8_SA(b, h) + aoff + m * 2048 + k * 1024); } while (0)
#define PG8_LDB(dst, b, h) do { _Pragma("unroll") for (int n = 0; n < 2; ++n) _Pragma("unroll") for (int k = 0; k < 2; ++k) dst[n][k] = *(const PG8_LAS bf16x8*)(lds + PG8_SB(b, h) + boff + n * 2048 + k * 1024); } while (0)
#define PG8_MMA(ai, bj, At, Bt) do { __builtin_amdgcn_s_setprio(1); _Pragma("unroll") for (int m = 0; m < 4; ++m) _Pragma("unroll") for (int n = 0; n < 2; ++n) _Pragma("unroll") for (int k = 0; k < 2; ++k) \
        acc[ai][bj][m][n] = __builtin_amdgcn_mfma_f32_16x16x32_bf16(Bt[n][k], At[m][k], acc[ai][bj][m][n], 0, 0, 0); __builtin_amdgcn_s_setprio(0); } while (0)
#define PG8_WAIT_V(n) asm volatile("s_waitcnt vmcnt(" #n ")" ::: "memory")
#define PG8_WAIT_L(n) asm volatile("s_waitcnt lgkmcnt(" #n ")" ::: "memory")
#define PG8_BAR __builtin_amdgcn_s_barrier()
#define PG8_SCHED __builtin_amdgcn_sched_barrier(0)
    Unit cur, nxt; int ui = 0;
    if (!S.next(0, cur)) return;
    f32x4 acc[2][2][4][2];
#pragma unroll
    for (int a = 0; a < 2; ++a)
#pragma unroll
        for (int b = 0; b < 2; ++b)
#pragma unroll
            for (int m = 0; m < 4; ++m)
#pragma unroll
                for (int n = 0; n < 2; ++n) acc[a][b][m][n] = (f32x4){0.f, 0.f, 0.f, 0.f};
    bf16x8 At[4][2], B0[2][2], B1[2][2];
    const char* cA = (const char*)g.A + (size_t)cur.pm * tstep; const char* cB = (const char*)g.Bt + (size_t)cur.pn * tstep;
    S.a_ready(cur);
    PG8_STAGE(PG8_SB(0, 0), cB, voffB); PG8_STAGE(PG8_SA(0, 0), cA, voffA); PG8_STAGE(PG8_SB(0, 1), cB + hstep, voffB); PG8_STAGE(PG8_SA(0, 1), cA + hstep, voffA);
    if (wr == 1) PG8_BAR;
    PG8_WAIT_V(4); PG8_BAR;
    PG8_STAGE(PG8_SB(1, 0), cB + kstep, voffB); PG8_STAGE(PG8_SA(1, 0), cA + kstep, voffA); PG8_STAGE(PG8_SB(1, 1), cB + hstep + kstep, voffB);
    PG8_WAIT_V(6); PG8_BAR;
    PG8_STAMP();
    for (;;) {
        const bool has_next = S.next(ui + 1, nxt);
        const char* nA = has_next ? (const char*)g.A + (size_t)nxt.pm * tstep : cA; const char* nB = has_next ? (const char*)g.Bt + (size_t)nxt.pn * tstep : cB;
        for (int t = 0; t < nt; t += 2) {
            const bool last = (t == nt - 2);
            const char* a1 = cA + (size_t)(t + 1) * kstep;
            const char* a2 = last ? nA : cA + (size_t)(t + 2) * kstep; const char* b2 = last ? nB : cB + (size_t)(t + 2) * kstep;
            const char* a3 = a2 + kstep; const char* b3 = b2 + kstep;
            if (last && has_next) S.a_ready(nxt);
            PG8_LDB(B0, 0, 0); PG8_SCHED; PG8_LDA(At, 0, 0); PG8_STAGE(PG8_SA(1, 1), a1 + hstep, voffA);
            PG8_WAIT_L(8); PG8_BAR; PG8_WAIT_L(0); PG8_MMA(0, 0, At, B0); PG8_BAR; PG8_SCHED;
            PG8_LDB(B1, 0, 1); PG8_STAGE(PG8_SB(0, 0), b2, voffB);
            PG8_BAR; PG8_WAIT_L(0); PG8_MMA(0, 1, At, B1); PG8_BAR;
            PG8_LDA(At, 0, 1); PG8_STAGE(PG8_SA(0, 0), a2, voffA);
            PG8_BAR; PG8_WAIT_L(0); PG8_MMA(1, 0, At, B0); PG8_BAR; PG8_SCHED;
            PG8_STAGE(PG8_SB(0, 1), b2 + hstep, voffB);
            PG8_WAIT_V(6); PG8_BAR; PG8_MMA(1, 1, At, B1); PG8_BAR;
            PG8_LDB(B0, 1, 0); PG8_SCHED; PG8_LDA(At, 1, 0); PG8_STAGE(PG8_SA(0, 1), a2 + hstep, voffA);
            PG8_WAIT_L(8); PG8_BAR; PG8_WAIT_L(0); PG8_MMA(0, 0, At, B0); PG8_BAR; PG8_SCHED;
            PG8_LDB(B1, 1, 1); PG8_STAGE(PG8_SB(1, 0), b3, voffB);
            PG8_BAR; PG8_WAIT_L(0); PG8_MMA(0, 1, At, B1); PG8_BAR;
            PG8_LDA(At, 1, 1); PG8_STAGE(PG8_SA(1, 0), a3, voffA);
            PG8_BAR; PG8_WAIT_L(0); PG8_MMA(1, 0, At, B0); PG8_BAR; PG8_SCHED;
            PG8_STAGE(PG8_SB(1, 1), b3 + hstep, voffB);
            PG8_WAIT_V(6); PG8_BAR; PG8_MMA(1, 1, At, B1); PG8_BAR;
        }
        PG8_STAMP();
        if constexpr (!Epi::AFTER_DRAIN) { E(acc, cur, wr, wc, fr, fq); S.done(cur); }
        PG8_STAMP();
        if (!has_next) break;
#pragma unroll
        for (int a = 0; a < 2; ++a)
#pragma unroll
            for (int b = 0; b < 2; ++b)
#pragma unroll
                for (int m = 0; m < 4; ++m)
#pragma unroll
                    for (int n = 0; n < 2; ++n) acc[a][b][m][n] = (f32x4){0.f, 0.f, 0.f, 0.f};
        cur = nxt; cA = nA; cB = nB; ++ui;
    }
    PG8_WAIT_V(0);
    if (wr == 0) PG8_BAR;
    PG8_BAR;
    if constexpr (Epi::AFTER_DRAIN) { E.fused(acc, cur, wr, wc, fr, fq, lds, wid, lane); S.done(cur); }
    PG8_STAMP();
    if (STAMP && wid == 0) { stamps[lane] = lane < nts ? (((unsigned long long)(unsigned)ts_hi << 32) | (unsigned)ts_lo) : 0ull;
        if (lane == 62) stamps[62] = rt_entry; if (lane == 63) stamps[63] = (unsigned long long)wall_clock64(); }
#undef PG8_STAMP
#undef PG8_SA
#undef PG8_SB
#undef PG8_STAGE
#undef PG8_LDA
#undef PG8_LDB
#undef PG8_MMA
#undef PG8_WAIT_V
#undef PG8_WAIT_L
#undef PG8_BAR
#undef PG8_SCHED
}
}

__device__ __forceinline__ void phase_ada(const Params& p, float* ldsf) {
    const int tid = opaque_tid(), G = gridDim.x;
    float* mod = (float*)(p.ws + OFF_MOD);
    const int cq = tid & 15, ks = tid >> 4;
    for (int t = blockIdx.x; t < 576; t += G) {
        const int l = t / 144, cgi = t % 144; const int col = cgi * 64 + cq * 4;
        const float* W = p.ada_w + (size_t)l * 1024 * 9216 + col;
        f32x4 acc = {0.f, 0.f, 0.f, 0.f};
        f32x4 wv[32];
#pragma unroll
        for (int i = 0; i < 32; ++i) wv[i] = __builtin_nontemporal_load((const f32x4*)(W + (size_t)(ks * 32 + i) * 9216));
        __builtin_amdgcn_sched_barrier(0);
#pragma unroll
        for (int i = 0; i < 32; ++i) { const float cv = p.c[ks * 32 + i]; const float ca = cv / (1.0f + expf(-cv)); acc += wv[i] * ca; }
        *(f32x4*)(ldsf + (ks * 16 + cq) * 4) = acc;
        __syncthreads();
        if (tid < 64) { const int cqq = tid >> 2, j = tid & 3; float s = 0.f; for (int k2 = 0; k2 < 32; ++k2) s += ldsf[(k2 * 16 + cqq) * 4 + j];
            const int o = l * 9216 + cgi * 64 + cqq * 4 + j; mod[o] = s + p.ada_b[o]; }
        __syncthreads();
    }
}

__device__ __forceinline__ int conv_col(int mode, int r, int& which) {
    which = 0;
    if (mode == 1) { const int pn = r >> 8, w = r & 255; which = (w >= 128) ? 1 : 0; return pn * 128 + (w & 127); }
    if (mode == 2) { if (r < 512) return (r >> 7) * 256 + (r & 127); const int rr = r - 512; return (rr >> 7) * 256 + 128 + (rr & 127); }
    return r;
}
__device__ __forceinline__ void convT(bf16_t* dst, const float* src0, const float* src1, int K, int ldsrc, int Nsrc, int Ndst, int mode, int& tbase, float* tile, int vb, int VG) {
    const int tid = opaque_tid();
    const int nkt = K >> 7, ntiles = nkt * (Ndst >> 6);
    const int first = (vb + VG - (tbase % VG)) % VG;
    for (int t = first; t < ntiles; t += VG) {
        const int nt_ = t / nkt, kt = t % nkt; const int r0 = nt_ * 64, k0 = kt * 128;
        { const int n = tid & 63, kk = tid >> 6; int which; const int col = conv_col(mode, r0 + n, which); const bool valid = col < Nsrc;
          const float* src = (which ? src1 : src0) + (size_t)k0 * ldsrc + col;
          float v[16];
#pragma unroll
          for (int it = 0; it < 16; ++it) v[it] = valid ? __builtin_nontemporal_load(src + (size_t)(kk + it * 8) * ldsrc) : 0.f;
#pragma unroll
          for (int it = 0; it < 16; ++it) tile[(kk + it * 8) * 65 + n] = v[it]; }
        __syncthreads();
        { const int kp = tid & 63, n = tid >> 6;
#pragma unroll
          for (int it = 0; it < 8; ++it) { const int nn = n + it * 8; const float v0 = tile[(2 * kp) * 65 + nn], v1 = tile[(2 * kp + 1) * 65 + nn];
              *(unsigned*)(dst + (size_t)(r0 + nn) * K + k0 + 2 * kp) = pack2(v0, v1); } }
        __syncthreads();
    }
    tbase += ntiles;
}
__device__ __forceinline__ void phase_convert(const Params& p, int l, float* tile, int vb, int VG) {
    int tb = 0;
    unsigned char* wsw = p.ws + (size_t)(l & 1) * W_REGION2;
    for (int f = 0; f < 2; ++f) {
        const size_t wo = (size_t)(l * 2 + f) * 1024 * 2816;
        convT((bf16_t*)(wsw + (f ? W_13B : W_13A)), p.w1 + wo, p.w3 + wo, 1024, 2816, 2816, 5632, 1, tb, tile, vb, VG);
        convT((bf16_t*)(wsw + (f ? W_2B : W_2A)), p.w2 + wo, nullptr, 2816, 1024, 1024, 1024, 0, tb, tile, vb, VG);
    }
    const int e = l >> 1;
    if ((l & 1) == 0) {
        bf16_t* wi = (bf16_t*)(wsw + W_MIX); bf16_t* wout = wi + 2816 * 1024; bf16_t* wuq = wout + 1024 * 1024; bf16_t* wukv = wuq + 768 * 384;
        convT(wi, p.ev_w_in + (size_t)e * 1024 * 2760, nullptr, 1024, 2760, 2760, 2816, 0, tb, tile, vb, VG);
        convT(wout, p.ev_w_out + (size_t)e * 1024 * 1024, nullptr, 1024, 1024, 1024, 1024, 0, tb, tile, vb, VG);
        convT(wuq, p.mla_w_uq + (size_t)e * 384 * 768, nullptr, 384, 768, 768, 768, 0, tb, tile, vb, VG);
        convT(wukv, p.mla_w_ukv + (size_t)e * 256 * 1024, nullptr, 256, 1024, 1024, 1024, 2, tb, tile, vb, VG);
    } else {
        bf16_t* wi = (bf16_t*)(wsw + W_MIX); bf16_t* wout = wi + 5376 * 1024;
        convT(wi, p.ssd_w_in + (size_t)e * 1024 * 5152, nullptr, 1024, 5152, 5152, 5376, 0, tb, tile, vb, VG);
        convT(wout, p.ssd_w_out + (size_t)e * 2048 * 1024, nullptr, 2048, 1024, 1024, 1024, 0, tb, tile, vb, VG);
    }
}

__device__ __forceinline__ void phase_norm(const float* X, bf16_t* H, const float* g, const float* shift, const float* scale) {
    const int tid = opaque_tid(), wave = tid >> 6, lane = tid & 63;
    for (int row = (blockIdx.x * 8 + wave) * 2; row < SEQ; row += gridDim.x * 16) {
        const f32x4* xr = (const f32x4*)(X + (size_t)row * 1024);
        f32x4 v[2][4]; float ss[2] = {0.f, 0.f};
#pragma unroll
        for (int r = 0; r < 2; ++r)
#pragma unroll
            for (int i = 0; i < 4; ++i) v[r][i] = xr[r * 256 + lane + 64 * i];
#pragma unroll
        for (int r = 0; r < 2; ++r) {
#pragma unroll
            for (int i = 0; i < 4; ++i) ss[r] += v[r][i][0] * v[r][i][0] + v[r][i][1] * v[r][i][1] + v[r][i][2] * v[r][i][2] + v[r][i][3] * v[r][i][3];
            ss[r] = wave_sum(ss[r]); }
#pragma unroll
        for (int i = 0; i < 4; ++i) { const int col = (lane + 64 * i) * 4;
            const f32x4 g4 = *(const f32x4*)(g + col), sc = *(const f32x4*)(scale + col), sh = *(const f32x4*)(shift + col);
#pragma unroll
            for (int r = 0; r < 2; ++r) { const float rstd = rsqrtf(ss[r] * (1.0f / 1024.0f) + 1e-6f);
                float y[4];
#pragma unroll
                for (int j = 0; j < 4; ++j) y[j] = (v[r][i][j] * rstd * g4[j]) * (1.0f + sc[j]) + sh[j];
                u32x2 w; w.x = pack2(y[0], y[1]); w.y = pack2(y[2], y[3]);
                *(u32x2*)(H + (size_t)(row + r) * 1024 + col) = w; } }
    }
}
__device__ __forceinline__ void phase_final(float* X, const float* g) {
    const int tid = opaque_tid(), wave = tid >> 6, lane = tid & 63;
    for (int row = (blockIdx.x * 8 + wave) * 2; row < SEQ; row += gridDim.x * 16) {
        f32x4* xr = (f32x4*)(X + (size_t)row * 1024);
        f32x4 v[2][4]; float ss[2] = {0.f, 0.f};
#pragma unroll
        for (int r = 0; r < 2; ++r)
#pragma unroll
            for (int i = 0; i < 4; ++i) v[r][i] = xr[r * 256 + lane + 64 * i];
#pragma unroll
        for (int r = 0; r < 2; ++r) {
#pragma unroll
            for (int i = 0; i < 4; ++i) ss[r] += v[r][i][0] * v[r][i][0] + v[r][i][1] * v[r][i][1] + v[r][i][2] * v[r][i][2] + v[r][i][3] * v[r][i][3];
            ss[r] = wave_sum(ss[r]); }
#pragma unroll
        for (int i = 0; i < 4; ++i) { const f32x4 g4 = *(const f32x4*)(g + (lane + 64 * i) * 4);
#pragma unroll
            for (int r = 0; r < 2; ++r) xr[r * 256 + lane + 64 * i] = v[r][i] * rsqrtf(ss[r] * (1.0f / 1024.0f) + 1e-6f) * g4; }
    }
}

__device__ __forceinline__ void phase_mla_prep(const Params& p, int e) {
    const int tid = opaque_tid(), wave = tid >> 6, lane = tid & 63;
    const bf16_t* P = (const bf16_t*)(p.ws + OFF_BIG);
    bf16_t* CQN = (bf16_t*)(p.ws + M_CQN); bf16_t* CKVN = (bf16_t*)(p.ws + M_CKVN); bf16_t* KPE = (bf16_t*)(p.ws + M_KPE);
    const float* gq = p.mla_q_norm_g + e * 384; const float* gkv = p.mla_kv_norm_g + e * 256;
    for (int tok = blockIdx.x * 8 + wave; tok < SEQ; tok += gridDim.x * 8) {
        const bf16_t* pr = P + (size_t)tok * EV_N;
        { float q[6]; float ss = 0.f;
#pragma unroll
          for (int i = 0; i < 3; ++i) { const unsigned w = *(const unsigned*)(pr + 2056 + lane * 2 + 128 * i); q[2 * i] = bf2f((bf16_t)(w & 0xffff)); q[2 * i + 1] = bf2f((bf16_t)(w >> 16)); ss += q[2 * i] * q[2 * i] + q[2 * i + 1] * q[2 * i + 1]; }
          ss = wave_sum(ss); const float r = rsqrtf(ss * (1.0f / 384.0f) + 1e-6f);
#pragma unroll
          for (int i = 0; i < 3; ++i) { const int col = lane * 2 + 128 * i; *(unsigned*)(CQN + (size_t)tok * 384 + col) = pack2(q[2 * i] * r * gq[col], q[2 * i + 1] * r * gq[col + 1]); } }
        { const u32x2 w = *(const u32x2*)(pr + 2440 + lane * 4); float v[4] = {bf2f((bf16_t)(w.x & 0xffff)), bf2f((bf16_t)(w.x >> 16)), bf2f((bf16_t)(w.y & 0xffff)), bf2f((bf16_t)(w.y >> 16))};
          float ss = v[0] * v[0] + v[1] * v[1] + v[2] * v[2] + v[3] * v[3]; ss = wave_sum(ss); const float r = rsqrtf(ss * (1.0f / 256.0f) + 1e-6f);
          const int col = lane * 4; u32x2 o; o.x = pack2(v[0] * r * gkv[col], v[1] * r * gkv[col + 1]); o.y = pack2(v[2] * r * gkv[col + 2], v[3] * r * gkv[col + 3]);
          *(u32x2*)(CKVN + (size_t)tok * 256 + col) = o; }
        { const float v = bf2f(pr[2696 + lane]); const float pa = __shfl_xor(v, 32); float c, s; rope_cs(p.pos[tok], lane & 31, c, s);
          KPE[(size_t)tok * 64 + lane] = f2bf(lane < 32 ? v * c - pa * s : v * c + pa * s); }
    }
}

__device__ __forceinline__ void phase_gdn_intra(const Params& p, int e, unsigned char* lds) {
    const int tid = opaque_tid(), wave = tid >> 6, lane = tid & 63, fr = lane & 15, fq = lane >> 4;
    float* R0 = (float*)lds; float* R1 = (float*)(lds + 33792); float* R2 = (float*)(lds + 67584);
    bf16_t* QB = (bf16_t*)(lds + 101376); bf16_t* KB = (bf16_t*)(lds + 118784);
    float* sBeta = (float*)(lds + 136192); float* sGc = sBeta + 64;
    const bf16_t* P = (const bf16_t*)(p.ws + OFF_BIG);
    float* U = (float*)(p.ws + G_U); bf16_t* Wb = (bf16_t*)(p.ws + G_W); bf16_t* QS = (bf16_t*)(p.ws + G_QS); bf16_t* KET = (bf16_t*)(p.ws + G_KET); bf16_t* ATT = (bf16_t*)(p.ws + G_ATT);
    float* EGL = (float*)(p.ws + OFF_EGL);
    const float* cw = p.gdn_conv_w + (size_t)e * 4 * 1536;
    for (int item = blockIdx.x; item < 1024; item += gridDim.x) {
        const int h = item & 3, n = item >> 2, tok0 = n * 64;
        if (tid < 384) {
            const int hw = tid >= 192 ? 1 : 0, t2 = tid - hw * 192;
            const int part = t2 >> 6, c2 = (t2 & 63) * 2, ch = part * 512 + h * 128 + c2;
            float* dst = (part == 0 ? R0 : (part == 1 ? R1 : R2)) + c2;
            if (hw == 0) CONV_PAIR_HALF(P, EV_N, ch, tok0, 0, cw, 1536, ch, 0.f, 0.f, { dst[t * 132] = y0; dst[t * 132 + 1] = y1; });
            else         CONV_PAIR_HALF(P, EV_N, ch, tok0, 32, cw, 1536, ch, 0.f, 0.f, { dst[t * 132] = y0; dst[t * 132 + 1] = y1; });
        } else if (tid >= 384 && tid < 448) {
            const int t = tid - 384; const bf16_t* pr = P + (size_t)(tok0 + t) * EV_N;
            const float bl = bf2f(pr[2048 + h]), a = bf2f(pr[2052 + h]);
            sBeta[t] = sigmoid_f(bl);
            float g = -expf(p.gdn_A_log[e * 4 + h]) * softplus_f(a + p.gdn_dt_bias[e * 4 + h]);
            g = wave_incl_scan(g, lane);
            sGc[t] = g;
        }
        __syncthreads();
        for (int i = 0; i < 16; ++i) {
            const int r = wave * 16 + i; const bool isq = r < 64; const int t = r & 63; float* row = (isq ? R0 : R1) + t * 132;
            float a = row[lane], b = row[lane + 64]; const float ss = wave_sum(a * a + b * b); const float sc = rsqrtf(ss + 1e-6f) * (isq ? 0.08838834764831845f : 1.0f);
            a *= sc; b *= sc;
            bf16_t* brow = (isq ? QB : KB) + t * 136; brow[lane] = f2bf(a); brow[lane + 64] = f2bf(b);
            if (!isq) { row[lane] = a; row[lane + 64] = b; }
            else { const float eg = __expf(sGc[t]); bf16_t* qo = QS + (size_t)(tok0 + t) * 512 + h * 128; qo[lane] = f2bf(a * eg); qo[lane + 64] = f2bf(b * eg); }
        }
        __syncthreads();
        {
            float* Amat = R0;
            const int m = wave >> 2, ib = wave & 3; const bf16_t* Y = m ? QB : KB;
            bf16x8 yf[4];
#pragma unroll
            for (int ks = 0; ks < 4; ++ks) yf[ks] = *(const bf16x8*)(Y + (ib * 16 + fr) * 136 + ks * 32 + fq * 8);
            const int irow = ib * 16 + fr; const float gi = sGc[irow], bi = sBeta[irow];
#pragma unroll
            for (int jb = 0; jb < 4; ++jb) {
                f32x4 d = {0.f, 0.f, 0.f, 0.f};
#pragma unroll
                for (int ks = 0; ks < 4; ++ks) { const bf16x8 xf = *(const bf16x8*)(KB + (jb * 16 + fr) * 136 + ks * 32 + fq * 8); d = mfma16(xf, yf[ks], d); }
                float v[4];
#pragma unroll
                for (int i = 0; i < 4; ++i) { const int j = jb * 16 + fq * 4 + i; const bool keep = m ? (j <= irow) : (j < irow); const float dec = keep ? __expf(gi - sGc[j]) : 0.f; v[i] = d[i] * dec * (m ? 1.0f : bi); }
                if (m == 0) { f32x4 o = {v[0], v[1], v[2], v[3]}; *(f32x4*)(Amat + irow * 64 + jb * 16 + fq * 4) = o; }
                else { u32x2 o; o.x = pack2(v[0], v[1]); o.y = pack2(v[2], v[3]); *(u32x2*)(ATT + ((size_t)(h * 256 + n) * 64 + irow) * 64 + jb * 16 + fq * 4) = o; }
            }
            const float gl = sGc[63];
            { const int t = tid & 63; const float ek = __expf(gl - sGc[t]);
#pragma unroll 4
              for (int it = 0; it < 16; ++it) { const int k = (tid >> 6) + 8 * it; KET[((size_t)(h * 256 + n) * 128 + k) * 64 + t] = f2bf(R1[t * 132 + k] * ek); } }
            if (tid == 0) EGL[h * 256 + n] = __expf(gl);
        }
        __syncthreads();
        if (tid < 256) {
            const float* Amat = R0;
            const int c = tid & 127; const bool isw = tid >= 128;
            float s[64];
#pragma unroll
            for (int i = 0; i < 64; ++i) s[i] = 0.f;
#pragma unroll
            for (int i = 0; i < 64; ++i) {
                float rhs = isw ? R1[i * 132 + c] * sBeta[i] * __expf(sGc[i]) : R2[i * 132 + c] * sBeta[i];
#pragma unroll
                for (int j4 = 0; j4 < (i + 3) / 4; ++j4) { const f32x4 a = *(const f32x4*)(Amat + i * 64 + j4 * 4);
                    rhs -= a[0] * s[j4 * 4 + 0]; rhs -= a[1] * s[j4 * 4 + 1]; rhs -= a[2] * s[j4 * 4 + 2]; rhs -= a[3] * s[j4 * 4 + 3]; }
                s[i] = rhs;
                if (isw) Wb[(size_t)(tok0 + i) * 512 + h * 128 + c] = f2bf(rhs); else U[(size_t)(tok0 + i) * 512 + h * 128 + c] = rhs;
            }
        }
        __syncthreads();
    }
}

__device__ __forceinline__ void phase_gdn_scan(const Params& p, unsigned char* lds_) {
    const int tid = opaque_tid(), wave = __builtin_amdgcn_readfirstlane(tid >> 6), lane = tid & 63, fr = lane & 15, fq = lane >> 4;
    const int h = blockIdx.x & 7, slice = blockIdx.x >> 3, j0 = slice * 16;
    LAS bf16_t* ST = (LAS bf16_t*)lds_; LAS bf16_t* VN = ST + 16 * 136;
    for (int i = tid; i < 16 * 136 / 2; i += 512) ((LAS unsigned*)ST)[i] = 0u;
    const float* U = (const float*)(p.ws + G_U); const bf16_t* Wb = (const bf16_t*)(p.ws + G_W);
    const bf16_t* KET = (const bf16_t*)(p.ws + G_KET); const float* EG = (const float*)(p.ws + OFF_EGL) + h * 256;
    bf16_t* SST = (bf16_t*)(p.ws + G_SST) + (size_t)(h * 256) * 16384 + (size_t)(j0 + fr) * 128 + wave * 16 + fq * 4;
    bf16_t* VNT = (bf16_t*)(p.ws + G_VNT) + (size_t)(h * 256) * 8192 + (size_t)(j0 + fr) * 64 + (wave & 3) * 16 + fq * 4;
    { u32x2 z; z.x = 0u; z.y = 0u; *(u32x2*)(SST) = z; }
    __syncthreads();
    const bool lo = wave < 4; const int rb = wave & 3;
    const bf16_t* A1 = Wb + (size_t)(rb * 16 + fr) * 512 + h * 128 + fq * 8;
    const size_t uoff = (size_t)(rb * 16 + fq * 4) * 512 + h * 128 + j0 + fr;
    const bf16_t* KEp = KET + ((size_t)(h * 256) * 128 + wave * 16 + fr) * 64 + fq * 8;
    const float* tch; size_t tstep;
    { const int L = slice * 32 + (wave & 3) * 8 + (lane & 7);
      if (L < 128) { tch = (const float*)(Wb + (size_t)(L >> 1) * 512 + h * 128 + (L & 1) * 64); tstep = 64 * 512 / 2; }
      else         { tch = (const float*)(KET + (size_t)(h * 256) * 8192 + (L - 128) * 64); tstep = 8192 / 2; } }
#define GLD128(dst, ptr) asm volatile("global_load_dwordx4 %0, %1, off" : "=v"(dst) : "v"(ptr))
#define GLD32(dst, ptr) asm volatile("global_load_dword %0, %1, off" : "=v"(dst) : "v"(ptr))
#define GDN_LOAD(LO_, N_, a1_, ka_, uu_, eg_, td_) do { const size_t tb_ = (size_t)(N_) * 64 * 512; \
        if (LO_) { _Pragma("unroll") for (int ks = 0; ks < 4; ++ks) GLD128(a1_[ks], A1 + tb_ + ks * 32); \
                  _Pragma("unroll") for (int i = 0; i < 4; ++i) GLD32(uu_[i], U + tb_ + uoff + (size_t)i * 512); } \
        _Pragma("unroll") for (int ks = 0; ks < 2; ++ks) GLD128(ka_[ks], KEp + (size_t)(N_) * 8192 + ks * 32); \
        GLD32(eg_, EG + (N_)); \
        if (!(LO_)) { GLD32(td_, tch + (size_t)GDN_CL((N_) + 5) * tstep); } } while (0)
#define GDN_WAIT(LO_, a1_, ka_, uu_, eg_, td_) do { if (LO_) asm volatile("s_waitcnt vmcnt(33)" : "+v"(a1_[0]), "+v"(a1_[1]), "+v"(a1_[2]), "+v"(a1_[3]), "+v"(ka_[0]), "+v"(ka_[1]), \
            "+v"(uu_[0]), "+v"(uu_[1]), "+v"(uu_[2]), "+v"(uu_[3]), "+v"(eg_)); \
        else asm volatile("s_waitcnt vmcnt(12)" : "+v"(ka_[0]), "+v"(ka_[1]), "+v"(eg_), "+v"(td_)); } while (0)
#define LDS_BAR() do { asm volatile("s_waitcnt lgkmcnt(0)" ::: "memory"); __builtin_amdgcn_s_barrier(); asm volatile("" ::: "memory"); } while (0)
#define GDN_STEP(LO_, N_, a1_, ka_, uu_, eg_) do { \
        if (LO_) { bf16x8 sb[4]; \
            _Pragma("unroll") for (int ks = 0; ks < 4; ++ks) sb[ks] = *(const LAS bf16x8*)(ST + fr * 136 + ks * 32 + fq * 8); \
            f32x4 acc1 = {0.f, 0.f, 0.f, 0.f}; \
            _Pragma("unroll") for (int ks = 0; ks < 4; ++ks) acc1 = mfma16(a1_[ks], sb[ks], acc1); \
            u32x2 w; w.x = pack2(uu_[0] - acc1[0], uu_[1] - acc1[1]); w.y = pack2(uu_[2] - acc1[2], uu_[3] - acc1[3]); \
            *(LAS u32x2*)(VN + fr * 72 + rb * 16 + fq * 4) = w; *(u32x2*)(VNT + (size_t)(N_) * 8192) = w; } \
        LDS_BAR(); \
        bf16x8 vb[2]; \
        _Pragma("unroll") for (int ks = 0; ks < 2; ++ks) vb[ks] = *(const LAS bf16x8*)(VN + fr * 72 + ks * 32 + fq * 8); \
        f32x4 sacc = Sreg * eg_; \
        _Pragma("unroll") for (int ks = 0; ks < 2; ++ks) sacc = mfma16(ka_[ks], vb[ks], sacc); \
        Sreg = sacc; \
        { u32x2 w; w.x = pack2(Sreg[0], Sreg[1]); w.y = pack2(Sreg[2], Sreg[3]); *(LAS u32x2*)(ST + fr * 136 + wave * 16 + fq * 4) = w; \
          if ((N_) + 1 < NCH) *(u32x2*)(SST + (size_t)((N_) + 1) * 16384) = w; } \
        LDS_BAR(); } while (0)
#define GDN_CL(x) ((x) < NCH ? (x) : NCH - 1)
#define GDN_RUN(LO_) do { \
    f32x4 Sreg = {0.f, 0.f, 0.f, 0.f}; \
    bf16x8 a1[4], ka[2]; float uu[4]; float eg; float td = 0.f, tdb = 0.f, tdc = 0.f, tdd = 0.f; \
    bf16x8 a1b[4], kab[2]; float uub[4]; float egb; \
    bf16x8 a1c[4], kac[2]; float uuc[4]; float egc; \
    bf16x8 a1d[4], kad[2]; float uud[4]; float egd; \
    GDN_LOAD(LO_, 0, a1, ka, uu, eg, td); GDN_LOAD(LO_, 1, a1b, kab, uub, egb, tdb); GDN_LOAD(LO_, 2, a1c, kac, uuc, egc, tdc); \
    _Pragma("unroll 1") for (int n = 0; n < NCH; n += 4) { \
        GDN_LOAD(LO_, GDN_CL(n + 3), a1d, kad, uud, egd, tdd); \
        GDN_WAIT(LO_, a1, ka, uu, eg, td); \
        GDN_STEP(LO_, n, a1, ka, uu, eg); \
        GDN_LOAD(LO_, GDN_CL(n + 4), a1, ka, uu, eg, td); \
        GDN_WAIT(LO_, a1b, kab, uub, egb, tdb); \
        GDN_STEP(LO_, n + 1, a1b, kab, uub, egb); \
        GDN_LOAD(LO_, GDN_CL(n + 5), a1b, kab, uub, egb, tdb); \
        GDN_WAIT(LO_, a1c, kac, uuc, egc, tdc); \
        GDN_STEP(LO_, n + 2, a1c, kac, uuc, egc); \
        GDN_LOAD(LO_, GDN_CL(n + 6), a1c, kac, uuc, egc, tdc); \
        GDN_WAIT(LO_, a1d, kad, uud, egd, tdd); \
        GDN_STEP(LO_, n + 3, a1d, kad, uud, egd); \
    } \
    asm volatile("s_waitcnt vmcnt(0)" ::: "memory"); } while (0)
    if (lo) GDN_RUN(true); else GDN_RUN(false);
#undef GDN_RUN
#undef GDN_CL
#undef GDN_STEP
#undef GDN_LOAD
#undef GDN_WAIT
#undef GLD128
#undef GLD32
}

__device__ __forceinline__ void phase_gdn_out(const Params& p, int e, unsigned char* lds) {
    const int tid = opaque_tid(), wave = tid >> 6, lane = tid & 63, fr = lane & 15, fq = lane >> 4;
    float* sPart = (float*)lds;
    const bf16_t* QS = (const bf16_t*)(p.ws + G_QS); const bf16_t* ATT = (const bf16_t*)(p.ws + G_ATT);
    const bf16_t* SST = (const bf16_t*)(p.ws + G_SST); const bf16_t* VNT = (const bf16_t*)(p.ws + G_VNT);
    const bf16_t* P = (const bf16_t*)(p.ws + OFF_BIG); bf16_t* O = (bf16_t*)(p.ws + OFF_HY);
    const float* gg = p.gdn_norm_g + e * 128;
    const int rb = wave & 3, chh = wave >> 2;
    for (int item = blockIdx.x; item < 1024; item += gridDim.x) {
        const int h = item & 3, n = item >> 2, tok = n * 64 + rb * 16 + fr;
        bf16x8 qa[4], aa[2];
#pragma unroll
        for (int ks = 0; ks < 4; ++ks) qa[ks] = *(const bf16x8*)(QS + (size_t)tok * 512 + h * 128 + ks * 32 + fq * 8);
#pragma unroll
        for (int ks = 0; ks < 2; ++ks) aa[ks] = *(const bf16x8*)(ATT + ((size_t)(h * 256 + n) * 64 + rb * 16 + fr) * 64 + ks * 32 + fq * 8);
        bf16x8 sbf[4][4], vbf[4][2]; u32x2 zwf[4];
#pragma unroll
        for (int jb = 0; jb < 4; ++jb) { const int j = chh * 64 + jb * 16 + fr;
#pragma unroll
            for (int ks = 0; ks < 4; ++ks) sbf[jb][ks] = *(const bf16x8*)(SST + ((size_t)(h * 256 + n) * 128 + j) * 128 + ks * 32 + fq * 8);
#pragma unroll
            for (int ks = 0; ks < 2; ++ks) vbf[jb][ks] = *(const bf16x8*)(VNT + ((size_t)(h * 256 + n) * 128 + j) * 64 + ks * 32 + fq * 8);
            zwf[jb] = *(const u32x2*)(P + (size_t)tok * EV_N + 1536 + h * 128 + chh * 64 + jb * 16 + fq * 4); }
        f32x4 o[4]; float sq = 0.f;
#pragma unroll
        for (int jb = 0; jb < 4; ++jb) {
            f32x4 d = {0.f, 0.f, 0.f, 0.f};
#pragma unroll
            for (int ks = 0; ks < 4; ++ks) d = mfma16(sbf[jb][ks], qa[ks], d);
#pragma unroll
            for (int ks = 0; ks < 2; ++ks) d = mfma16(vbf[jb][ks], aa[ks], d);
            o[jb] = d;
            sq += d[0] * d[0] + d[1] * d[1] + d[2] * d[2] + d[3] * d[3];
        }
        sq += __shfl_xor(sq, 16); sq += __shfl_xor(sq, 32);
        if (fq == 0) sPart[chh * 64 + rb * 16 + fr] = sq;
        __syncthreads();
        const float rs = rsqrtf((sPart[rb * 16 + fr] + sPart[64 + rb * 16 + fr]) * (1.0f / 128.0f) + 1e-6f);
#pragma unroll
        for (int jb = 0; jb < 4; ++jb) { const int c0 = chh * 64 + jb * 16 + fq * 4;
            const u32x2 zw = zwf[jb];
            const float zz[4] = {bf2f((bf16_t)(zw.x & 0xffff)), bf2f((bf16_t)(zw.x >> 16)), bf2f((bf16_t)(zw.y & 0xffff)), bf2f((bf16_t)(zw.y >> 16))};
            const f32x4 g4 = *(const f32x4*)(gg + c0);
            u32x2 w; w.x = pack2(o[jb][0] * rs * g4[0] * silu_f(zz[0]), o[jb][1] * rs * g4[1] * silu_f(zz[1])); w.y = pack2(o[jb][2] * rs * g4[2] * silu_f(zz[2]), o[jb][3] * rs * g4[3] * silu_f(zz[3]));
            *(u32x2*)(O + (size_t)tok * 1024 + h * 128 + c0) = w; }
        __syncthreads();
    }
}

__device__ __forceinline__ void phase_attn(const Params& p, unsigned char* lds_) {
    const int tid = opaque_tid(), wave = __builtin_amdgcn_readfirstlane(tid >> 6), lane = tid & 63, fr = lane & 15, fq = lane >> 4;
    LAS unsigned char* lds = (LAS unsigned char*)lds_;
    const bf16_t* Qb = (const bf16_t*)(p.ws + M_Q); const bf16_t* KN = (const bf16_t*)(p.ws + M_KN); const bf16_t* VT = (const bf16_t*)(p.ws + M_VT); const bf16_t* KPE = (const bf16_t*)(p.ws + M_KPE);
    bf16_t* O = (bf16_t*)(p.ws + OFF_HY);
    const float C = 0.07216878364870323f * 1.4426950408889634f;
    const int sw = (fr >> 1) & 7;
    const int kbn = fr * 256 + ((fq ^ fr) << 4);
    const int kbp = 16384 + fr * 128 + ((fq ^ sw) << 4);
    const int vb0 = fr * 128 + (((fq >> 1) ^ sw) << 4) + (fq & 1) * 8;
    for (int u = blockIdx.x; u < 256; u += gridDim.x) {
        const int h = u & 3, x = u >> 2;
        const int blk = (wave < 4) ? x : 127 - x;
        const int rowbase = blk * 128 + (wave & 3) * 32;
        const int cw = rowbase >> 6;
        const int ktmax = 2 * (127 - x) + 1;
        unsigned okn[2], okp, ov[2];
#pragma unroll
        for (int j = 0; j < 2; ++j) { const int key = (wave * 2 + j) * 4 + (lane >> 4); okn[j] = (unsigned)(key * 512 + h * 128 + (((lane & 15) ^ (key & 15)) << 3)); }
        { const int key = wave * 8 + (lane >> 3); okp = (unsigned)(key * 64 + (((lane & 7) ^ ((key >> 1) & 7)) << 3)); }
#pragma unroll
        for (int j = 0; j < 2; ++j) { const int d = (wave * 2 + j) * 8 + (lane >> 3); ov[j] = (unsigned)((h * 128 + d) * SEQ + (((lane & 7) ^ ((d >> 1) & 7)) << 3)); }
        { LAS unsigned* po = (LAS unsigned*)(lds + 122880) + tid; po[0] = okn[0]; po[512] = okn[1]; po[1024] = okp; po[1536] = ov[0]; po[2048] = ov[1]; }
#define ATT_DMA(KT_) do { const int kc_ = (KT_) <= ktmax ? (KT_) : ktmax; LAS unsigned char* b_ = lds + ((KT_) % 3) * 40960; \
        int tq_ = tid; asm volatile("" : "+v"(tq_)); const LAS unsigned* po_ = (const LAS unsigned*)(lds + 122880) + tq_; unsigned okn[2], okp, ov[2]; okn[0] = po_[0]; okn[1] = po_[512]; okp = po_[1024]; ov[0] = po_[1536]; ov[1] = po_[2048]; const bf16_t* kn_ = KN + (size_t)kc_ * 64 * 512; const bf16_t* kq_ = KPE + (size_t)kc_ * 64 * 64; const bf16_t* vt_ = VT + (size_t)kc_ * 64; \
        _Pragma("unroll") for (int j = 0; j < 2; ++j) __builtin_amdgcn_global_load_lds((const unsigned*)(kn_ + okn[j]), (LAS unsigned*)(b_ + (wave * 2 + j) * 1024), 16, 0, 0); \
        __builtin_amdgcn_global_load_lds((const unsigned*)(kq_ + okp), (LAS unsigned*)(b_ + 16384 + wave * 1024), 16, 0, 0); \
        _Pragma("unroll") for (int j = 0; j < 2; ++j) __builtin_amdgcn_global_load_lds((const unsigned*)(vt_ + ov[j]), (LAS unsigned*)(b_ + 24576 + (wave * 2 + j) * 1024), 16, 0, 0); } while (0)
        ATT_DMA(0); ATT_DMA(1);
        bf16x8 qf[2][6];
#pragma unroll
        for (int qs = 0; qs < 2; ++qs) {
            const int row = rowbase + qs * 16 + fr; const bf16_t* qp = Qb + (size_t)row * 768 + h * 192 + fq * 8;
#pragma unroll
            for (int ks = 0; ks < 6; ++ks) qf[qs][ks] = *(const bf16x8*)(qp + ks * 32);
            const int pos = p.pos[row];
#pragma unroll
            for (int i = 0; i < 8; ++i) { float c, s; rope_cs(pos, fq * 8 + i, c, s); const float x1 = bf2f((bf16_t)qf[qs][4][i]), x2 = bf2f((bf16_t)qf[qs][5][i]);
                qf[qs][4][i] = (short)f2bf((x1 * c - x2 * s) * C); qf[qs][5][i] = (short)f2bf((x2 * c + x1 * s) * C); }
#pragma unroll
            for (int ks = 0; ks < 4; ++ks)
#pragma unroll
                for (int i = 0; i < 8; ++i) qf[qs][ks][i] = (short)f2bf(bf2f((bf16_t)qf[qs][ks][i]) * C);
        }
        f32x4 acc[2][8];
#pragma unroll
        for (int qs = 0; qs < 2; ++qs)
#pragma unroll
            for (int db = 0; db < 8; ++db) acc[qs][db] = (f32x4){0.f, 0.f, 0.f, 0.f};
        float mrun[2] = {-1e30f, -1e30f}, lrun[2] = {0.f, 0.f};
#pragma unroll 1
        for (int kt = 0; kt <= ktmax; ++kt) {
            asm volatile("s_waitcnt vmcnt(5) lgkmcnt(0)" ::: "memory");
            __builtin_amdgcn_s_barrier();
            asm volatile("" ::: "memory");
            ATT_DMA(kt + 2);
            if (kt <= cw) {
                LAS unsigned char* Kt = lds + (kt % 3) * 40960; LAS unsigned char* Vt = Kt + 24576;
                f32x4 st[2][4];
                const f32x4 zero4 = {0.f, 0.f, 0.f, 0.f};
#define ATT_KF(ks_, nb_) (((ks_) < 4) ? *(const LAS bf16x8*)(Kt + (kbn ^ ((ks_) << 6)) + (nb_) * 4096) : *(const LAS bf16x8*)(Kt + (kbp ^ (((ks_) - 4) << 6)) + (nb_) * 2048))
                bf16x8 kf[3][2];
#pragma unroll
                for (int hs = 0; hs < 2; ++hs)
#pragma unroll
                    for (int j = 0; j < 2; ++j) kf[hs][j] = ATT_KF(hs >> 1, (hs & 1) * 2 + j);
#pragma unroll
                for (int hs = 0; hs < 12; ++hs) {
                    const int ks = hs >> 1, nb0 = (hs & 1) * 2;
                    if (hs + 2 < 12) {
#pragma unroll
                        for (int j = 0; j < 2; ++j) kf[(hs + 2) % 3][j] = ATT_KF((hs + 2) >> 1, ((hs + 2) & 1) * 2 + j); }
                    __builtin_amdgcn_sched_barrier(0);
#pragma unroll
                    for (int j = 0; j < 2; ++j) { st[0][nb0 + j] = mfma16(kf[hs % 3][j], qf[0][ks], ks == 0 ? zero4 : st[0][nb0 + j]); st[1][nb0 + j] = mfma16(kf[hs % 3][j], qf[1][ks], ks == 0 ? zero4 : st[1][nb0 + j]); }
                    __builtin_amdgcn_sched_barrier(0);
                }
#undef ATT_KF
                bf16x8 bp[2][2];
#pragma unroll
                for (int qs = 0; qs < 2; ++qs) {
                    float mx = -1e30f;
#pragma unroll
                    for (int nb = 0; nb < 4; ++nb)
#pragma unroll
                        for (int i = 0; i < 4; ++i) mx = fmaxf(mx, st[qs][nb][i]);
                    mx = fmaxf(mx, __shfl_xor(mx, 16)); mx = fmaxf(mx, __shfl_xor(mx, 32));
                    const float mnew = fmaxf(mrun[qs], mx); const float alpha = __builtin_amdgcn_exp2f(mrun[qs] - mnew); mrun[qs] = mnew;
                    float ps = 0.f;
#pragma unroll
                    for (int nb = 0; nb < 4; ++nb)
#pragma unroll
                        for (int i = 0; i < 4; ++i) { const float pv = __builtin_amdgcn_exp2f(st[qs][nb][i] - mnew); ps += pv; st[qs][nb][i] = pv; }
                    lrun[qs] = lrun[qs] * alpha + ps;
                    if (__builtin_amdgcn_ballot_w64(alpha != 1.0f) != 0ull) {
#pragma unroll
                        for (int db = 0; db < 8; ++db) acc[qs][db] *= alpha; }
#pragma unroll
                    for (int kk = 0; kk < 2; ++kk) { u32x4 w; w.x = pack2(st[qs][2 * kk][0], st[qs][2 * kk][1]); w.y = pack2(st[qs][2 * kk][2], st[qs][2 * kk][3]);
                        w.z = pack2(st[qs][2 * kk + 1][0], st[qs][2 * kk + 1][1]); w.w = pack2(st[qs][2 * kk + 1][2], st[qs][2 * kk + 1][3]); bp[qs][kk] = __builtin_bit_cast(bf16x8, w); }
                }
#define ATT_VLO(s_) (*(const LAS u32x2*)(Vt + (vb0 ^ ((((s_) >> 3) * 4) << 4)) + ((s_) & 7) * 2048))
#define ATT_VHI(s_) (*(const LAS u32x2*)(Vt + (vb0 ^ ((((s_) >> 3) * 4 + 2) << 4)) + ((s_) & 7) * 2048))
                u32x2 vlo[3], vhi[3];
#pragma unroll
                for (int s = 0; s < 2; ++s) { vlo[s] = ATT_VLO(s); vhi[s] = ATT_VHI(s); }
#pragma unroll
                for (int s = 0; s < 16; ++s) {
                    const int kk = s >> 3, db = s & 7;
                    if (s + 2 < 16) { vlo[(s + 2) % 3] = ATT_VLO(s + 2); vhi[(s + 2) % 3] = ATT_VHI(s + 2); }
                    __builtin_amdgcn_sched_barrier(0);
                    u32x4 w; w.x = vlo[s % 3].x; w.y = vlo[s % 3].y; w.z = vhi[s % 3].x; w.w = vhi[s % 3].y; const bf16x8 a = __builtin_bit_cast(bf16x8, w);
                    acc[0][db] = mfma16(a, bp[0][kk], acc[0][db]); acc[1][db] = mfma16(a, bp[1][kk], acc[1][db]);
                    __builtin_amdgcn_sched_barrier(0);
                }
#undef ATT_VLO
#undef ATT_VHI
            }
        }
#undef ATT_DMA
        asm volatile("s_waitcnt vmcnt(0)" ::: "memory");
#pragma unroll
        for (int qs = 0; qs < 2; ++qs) {
            float l = lrun[qs]; l += __shfl_xor(l, 16); l += __shfl_xor(l, 32); const float inv = 1.0f / l;
            bf16_t* op = O + (size_t)(rowbase + qs * 16 + fr) * 1024 + 512 + h * 128 + fq * 4;
#pragma unroll
            for (int db = 0; db < 8; ++db) { u32x2 w; w.x = pack2(acc[qs][db][0] * inv, acc[qs][db][1] * inv); w.y = pack2(acc[qs][db][2] * inv, acc[qs][db][3] * inv); *(u32x2*)(op + db * 16) = w; }
        }
        __syncthreads();
    }
}

__device__ __forceinline__ void mixer_even(int e, int l, const XcdBarrier& xbar, unsigned char* lds) {
#define LP() const Params p = lds_params(lds)
    _Pragma("unroll 1") for (int rep = 0; rep < (PROBE == 14 ? 2 : 1); ++rep) { LP(); phase_mla_prep(p, e); }
_Pragma("unroll 1") for (int rep = 0; rep < (PROBE == 4 ? 2 : 1); ++rep) { LP(); phase_gdn_intra(p, e, lds); }
    GSYNC();
    if (blockIdx.x < 64 && (blockIdx.x & 7) < 4) { _Pragma("unroll 1") for (int rep = 0; rep < (PROBE == 2 ? 2 : 1); ++rep) { LP(); phase_gdn_scan(p, lds); } }
    else {
        const int Gp = gridDim.x - 32, c = (blockIdx.x < 64) ? (int)(blockIdx.x >> 3) * 4 + (int)(blockIdx.x & 7) - 4 : (int)blockIdx.x - 32;
#pragma unroll 1
        for (int j = 0; j < 3; ++j) {
            LP();
            const bf16_t* CQN = (const bf16_t*)(p.ws + M_CQN); const bf16_t* CKVN = (const bf16_t*)(p.ws + M_CKVN);
            const bf16_t* wuq = (const bf16_t*)(p.ws + W_MIX) + 2816 * 1024 + 1024 * 1024; const bf16_t* wukv = wuq + 768 * 384;
            pg8::Gemm g; bf16_t* Op; int ldc, off;
            if (j == 0) { g = pg8::Gemm{CQN, wuq, SEQ, 768, 384}; Op = (bf16_t*)(p.ws + M_Q); ldc = 768; off = 0; }
            else if (j == 1) { g = pg8::Gemm{CKVN, wukv, SEQ, 512, 256}; Op = (bf16_t*)(p.ws + M_KN); ldc = 512; off = 192 % Gp; }
            else { g = pg8::Gemm{wukv + 512 * 256, CKVN, 512, SEQ, 256}; Op = (bf16_t*)(p.ws + M_VT); ldc = SEQ; off = 320 % Gp; }
            pg8::StaticOrder S; S.init(g.M, g.N, Gp, (c + Gp - off) % Gp); pg8::EpiBf16Plain E{Op, ldc};
            pg8::gemm_phase<pg8::EpiBf16Plain, pg8::StaticOrder, false>((LAS unsigned char*)lds, g, S, E, nullptr);
        }
        { LP(); phase_convert(p, l + 1, (float*)lds, c, Gp); }
    }
    GSYNC();
    _Pragma("unroll 1") for (int rep = 0; rep < (PROBE == 15 ? 2 : 1); ++rep) { LP(); phase_gdn_out(p, e, lds); }
_Pragma("unroll 1") for (int rep = 0; rep < (PROBE == 1 ? 2 : 1); ++rep) { LP(); phase_attn(p, lds); }
    GSYNC();
#undef LP
}

#define SSD_CONV(P_, tok0_, cc_, cwt_, cb_, BODY) do { \
        const float w0_ = (cwt_)[cc_], w1_ = (cwt_)[3072 + (cc_)], w2_ = (cwt_)[6144 + (cc_)], w3_ = (cwt_)[9216 + (cc_)], b_ = (cb_)[cc_]; \
        const bf16_t* src_ = (P_) + (size_t)(tok0_) * OD_N + 2048 + (cc_); \
        float x0_ = 0.f, x1_ = 0.f, x2_ = 0.f; \
        if ((tok0_) > 0) { x0_ = bf2f(src_[-3 * OD_N]); x1_ = bf2f(src_[-2 * OD_N]); x2_ = bf2f(src_[-1 * OD_N]); } \
        _Pragma("unroll") for (int t = 0; t < 64; ++t) { const float x3_ = bf2f(src_[(size_t)t * OD_N]); const float y = silu_f(b_ + w0_ * x0_ + w1_ * x1_ + w2_ * x2_ + w3_ * x3_); BODY; x0_ = x1_; x1_ = x2_; x2_ = x3_; } } while (0)

__device__ __forceinline__ void phase_ssd_states(const Params& p, int o, unsigned char* lds) {
    const int tid = opaque_tid(), wave = tid >> 6, lane = tid & 63, fr = lane & 15, fq = lane >> 4;
    bf16_t* XTS = (bf16_t*)lds; bf16_t* BT = (bf16_t*)(lds + 73728); float* sSc = (float*)(lds + 73728 + 18432);
    const bf16_t* P = (const bf16_t*)(p.ws + OFF_BIG);
    bf16_t* STt = (bf16_t*)(p.ws + OFF_MIX); float* CD = (float*)(p.ws + OFF_CD);
    const float* cwt = p.ssd_conv_w + (size_t)o * 4 * 3072; const float* cb = p.ssd_conv_b + (size_t)o * 3072;
    for (int item = blockIdx.x; item < 1024; item += gridDim.x) {
        const int g = item & 3, n = item >> 2, tok0 = n * 64;
        { const int hh = g * 8 + wave; const float raw = bf2f(P[(size_t)(tok0 + lane) * OD_N + 5120 + hh]); const float dt = softplus_f(raw + p.ssd_dt_bias[o * 32 + hh]);
          const float da = -expf(p.ssd_A_log[o * 32 + hh]) * dt; const float acs = wave_incl_scan(da, lane); const float last = __shfl(acs, 63);
          sSc[wave * 64 + lane] = dt * __expf(last - acs); if (lane == 63) CD[n * 32 + hh] = __expf(acs); }
        __syncthreads();
        if (tid < 256) { const int ch = tid * 2, cc = g * 512 + ch; const float* sc = sSc + (ch >> 6) * 64; bf16_t* dst = XTS + ch * 72;
          CONV_PAIR(P, OD_N, 2048 + cc, tok0, cwt, 3072, cc, cb[cc], cb[cc + 1], { dst[t] = f2bf(y0 * sc[t]); dst[72 + t] = f2bf(y1 * sc[t]); }); }
        else if (tid < 320) { const int ch = (tid - 256) * 2, cc = 2048 + g * 128 + ch; bf16_t* dst = BT + ch * 72;
          CONV_PAIR(P, OD_N, 2048 + cc, tok0, cwt, 3072, cc, cb[cc], cb[cc + 1], { dst[t] = f2bf(y0); dst[72 + t] = f2bf(y1); }); }
        __syncthreads();
        { const int hh = g * 8 + wave;
#pragma unroll 1
          for (int pb = 0; pb < 4; ++pb) {
              bf16x8 xf[2];
#pragma unroll
              for (int ks = 0; ks < 2; ++ks) xf[ks] = *(const bf16x8*)(XTS + (wave * 64 + pb * 16 + fr) * 72 + ks * 32 + fq * 8);
#pragma unroll
              for (int nb = 0; nb < 8; ++nb) { f32x4 d = {0.f, 0.f, 0.f, 0.f};
#pragma unroll
                  for (int ks = 0; ks < 2; ++ks) { const bf16x8 bf = *(const bf16x8*)(BT + (nb * 16 + fr) * 72 + ks * 32 + fq * 8); d = mfma16(bf, xf[ks], d); }
                  u32x2 w; w.x = pack2(d[0], d[1]); w.y = pack2(d[2], d[3]);
                  *(u32x2*)(STt + (((size_t)n * 32 + hh) * 64 + pb * 16 + fr) * 128 + nb * 16 + fq * 4) = w; } } }
        __syncthreads();
    }
}

__device__ __forceinline__ void phase_ssd_scan(const Params& p) {
    unsigned* ST = (unsigned*)(p.ws + OFF_MIX); const float* CD = (const float*)(p.ws + OFF_CD);
    for (size_t e2 = (size_t)blockIdx.x * 512 + opaque_tid(); e2 < 131072; e2 += (size_t)gridDim.x * 512) {
        const int hh = (int)(e2 >> 12); unsigned* ptr = ST + e2; float h0 = 0.f, h1 = 0.f;
#pragma unroll 1
        for (int c0 = 0; c0 < NCH; c0 += 32) {
            unsigned w[32]; float cd[32];
#pragma unroll
            for (int j = 0; j < 32; ++j) { w[j] = ptr[(size_t)(c0 + j) * 131072]; cd[j] = CD[(c0 + j) * 32 + hh]; }
            __builtin_amdgcn_sched_barrier(0);
#pragma unroll
            for (int j = 0; j < 32; ++j) { ptr[(size_t)(c0 + j) * 131072] = pack2(h0, h1); h0 = h0 * cd[j] + bf2f((bf16_t)(w[j] & 0xffff)); h1 = h1 * cd[j] + bf2f((bf16_t)(w[j] >> 16)); }
        }
    }
}

__device__ __forceinline__ void phase_ssd_out(const Params& p, int o, unsigned char* lds) {
    const int tid = opaque_tid(), wave = tid >> 6, lane = tid & 63, fr = lane & 15, fq = lane >> 4;
    bf16_t* Cs = (bf16_t*)lds; bf16_t* Bs = (bf16_t*)(lds + 17408); float* CBm = (float*)(lds + 34816); bf16_t* XT = (bf16_t*)(lds + 52224);
    float* sDt = (float*)(lds + 125952); float* sAcs = sDt + 512; float* sSum = sAcs + 512;
    const bf16_t* P = (const bf16_t*)(p.ws + OFF_BIG); const bf16_t* HS = (const bf16_t*)(p.ws + OFF_MIX); bf16_t* Y = (bf16_t*)(p.ws + OFF_HY);
    const float* cwt = p.ssd_conv_w + (size_t)o * 4 * 3072; const float* cb = p.ssd_conv_b + (size_t)o * 3072;
    for (int item = blockIdx.x; item < 1024; item += gridDim.x) {
        const int g = item & 3, n = item >> 2, tok0 = n * 64;
        const int hh = g * 8 + wave;
        { const float raw = bf2f(P[(size_t)(tok0 + lane) * OD_N + 5120 + hh]); const float dt = softplus_f(raw + p.ssd_dt_bias[o * 32 + hh]);
          const float da = -expf(p.ssd_A_log[o * 32 + hh]) * dt; const float acs = wave_incl_scan(da, lane);
          sDt[wave * 64 + lane] = dt; sAcs[wave * 64 + lane] = acs; if (tid < 64) sSum[tid] = 0.f; }
        _Pragma("unroll 1") for (int rep = 0; rep < (PROBE == 10 ? 2 : 1); ++rep) {
        if (tid < 256) { const int ch = tid * 2, cc = g * 512 + ch; bf16_t* dst = XT + ch * 72;
          CONV_PAIR(P, OD_N, 2048 + cc, tok0, cwt, 3072, cc, cb[cc], cb[cc + 1], { dst[t] = f2bf(y0); dst[72 + t] = f2bf(y1); }); }
        else if (tid < 384) { const int idx = tid - 256; const bool isc = idx >= 64; const int ch = (idx & 63) * 2, cc = 2048 + (isc ? 512 : 0) + g * 128 + ch; bf16_t* dst = (isc ? Cs : Bs) + ch;
          CONV_PAIR(P, OD_N, 2048 + cc, tok0, cwt, 3072, cc, cb[cc], cb[cc + 1], { *(unsigned*)(dst + t * 136) = pack2(y0, y1); }); }
        }
        __syncthreads();
        for (int tI = wave * 2; tI < wave * 2 + 2; ++tI) { const int lb = tI >> 2, sb = tI & 3; f32x4 d = {0.f, 0.f, 0.f, 0.f};
#pragma unroll
            for (int ks = 0; ks < 4; ++ks) { const bf16x8 xb = *(const bf16x8*)(Bs + (sb * 16 + fr) * 136 + ks * 32 + fq * 8), yb = *(const bf16x8*)(Cs + (lb * 16 + fr) * 136 + ks * 32 + fq * 8); d = mfma16(xb, yb, d); }
            *(f32x4*)(CBm + (lb * 16 + fr) * 68 + sb * 16 + fq * 4) = d; }
        __syncthreads();
        _Pragma("unroll 1") for (int rep = 0; rep < (PROBE == 12 ? 2 : 1); ++rep) {
        const float* dts = sDt + wave * 64; const float* acss = sAcs + wave * 64; const float Dh = p.ssd_D[o * 32 + hh];
        bf16x8 hb[4][4];
#pragma unroll
        for (int pb = 0; pb < 4; ++pb)
#pragma unroll
            for (int ks = 0; ks < 4; ++ks) hb[pb][ks] = *(const bf16x8*)(HS + (((size_t)n * 32 + hh) * 64 + pb * 16 + fr) * 128 + ks * 32 + fq * 8);
        u32x2 zwf[4][4];
#pragma unroll
        for (int lb = 0; lb < 4; ++lb)
#pragma unroll
            for (int pb = 0; pb < 4; ++pb) zwf[lb][pb] = *(const u32x2*)(P + (size_t)(tok0 + lb * 16 + fr) * OD_N + hh * 64 + pb * 16 + fq * 4);
#pragma unroll
        for (int lb = 0; lb < 4; ++lb) {
            const int l = lb * 16 + fr; const float al = acss[l]; const float eal = __expf(al);
            bf16x8 ga[2], ca[4];
#pragma unroll
            for (int ks = 0; ks < 2; ++ks) { float gv[8];
#pragma unroll
                for (int i = 0; i < 8; ++i) { const int s = ks * 32 + fq * 8 + i; gv[i] = (s <= l) ? CBm[l * 68 + s] * __expf(al - acss[s]) * dts[s] : 0.f; }
                u32x4 w; w.x = pack2(gv[0], gv[1]); w.y = pack2(gv[2], gv[3]); w.z = pack2(gv[4], gv[5]); w.w = pack2(gv[6], gv[7]); ga[ks] = __builtin_bit_cast(bf16x8, w); }
#pragma unroll
            for (int ks = 0; ks < 4; ++ks) ca[ks] = *(const bf16x8*)(Cs + l * 136 + ks * 32 + fq * 8);
            float sq = 0.f;
#pragma unroll
            for (int pb = 0; pb < 4; ++pb) {
                f32x4 yd = {0.f, 0.f, 0.f, 0.f}, yo = {0.f, 0.f, 0.f, 0.f};
#pragma unroll
                for (int ks = 0; ks < 2; ++ks) { const bf16x8 xb = *(const bf16x8*)(XT + (wave * 64 + pb * 16 + fr) * 72 + ks * 32 + fq * 8); yd = mfma16(xb, ga[ks], yd); }
#pragma unroll
                for (int ks = 0; ks < 4; ++ks) yo = mfma16(hb[pb][ks], ca[ks], yo);
                const u32x2 zw = zwf[lb][pb];
                const float zz[4] = {bf2f((bf16_t)(zw.x & 0xffff)), bf2f((bf16_t)(zw.x >> 16)), bf2f((bf16_t)(zw.y & 0xffff)), bf2f((bf16_t)(zw.y >> 16))};
                float v[4];
#pragma unroll
                for (int i = 0; i < 4; ++i) { const float xv = bf2f(XT[(wave * 64 + pb * 16 + fq * 4 + i) * 72 + l]); v[i] = (yd[i] + eal * yo[i] + Dh * xv) * silu_f(zz[i]); sq += v[i] * v[i]; }
                u32x2 w; w.x = pack2(v[0], v[1]); w.y = pack2(v[2], v[3]);
                *(u32x2*)(Y + (size_t)(tok0 + l) * 2048 + hh * 64 + pb * 16 + fq * 4) = w;
            }
            sq += __shfl_xor(sq, 16); sq += __shfl_xor(sq, 32);
            if (fq == 0 && rep == (PROBE == 12 ? 1 : 0)) atomicAdd(&sSum[l], sq);
        }
        }
        __syncthreads();
        const float* ng = p.ssd_norm_g + (size_t)o * 2048 + hh * 64;
        u32x2 yr[4][4];
#pragma unroll
        for (int lb = 0; lb < 4; ++lb)
#pragma unroll
            for (int pb = 0; pb < 4; ++pb) yr[lb][pb] = *(const u32x2*)(Y + (size_t)(tok0 + lb * 16 + fr) * 2048 + hh * 64 + pb * 16 + fq * 4);
#pragma unroll
        for (int lb = 0; lb < 4; ++lb) { const int l = lb * 16 + fr; const float rs = rsqrtf(sSum[l] * (1.0f / 512.0f) + 1e-6f);
#pragma unroll
            for (int pb = 0; pb < 4; ++pb) { const f32x4 g4 = *(const f32x4*)(ng + pb * 16 + fq * 4);
                u32x2* yp = (u32x2*)(Y + (size_t)(tok0 + l) * 2048 + hh * 64 + pb * 16 + fq * 4); const u32x2 r = yr[lb][pb];
                u32x2 w; w.x = pack2(bf2f((bf16_t)(r.x & 0xffff)) * rs * g4[0], bf2f((bf16_t)(r.x >> 16)) * rs * g4[1]); w.y = pack2(bf2f((bf16_t)(r.y & 0xffff)) * rs * g4[2], bf2f((bf16_t)(r.y >> 16)) * rs * g4[3]);
                *yp = w; } }
        __syncthreads();
    }
}

__device__ __forceinline__ void mixer_odd(int o, const XcdBarrier& xbar, unsigned char* lds) {
#define LP() const Params p = lds_params(lds)
_Pragma("unroll 1") for (int rep = 0; rep < (PROBE == 6 ? 2 : 1); ++rep) { LP(); phase_ssd_states(p, o, lds); }
    GSYNC();
    { LP(); phase_ssd_scan(p); }
    GSYNC();
_Pragma("unroll 1") for (int rep = 0; rep < (PROBE == 5 ? 2 : 1); ++rep) { LP(); phase_ssd_out(p, o, lds); }
    GSYNC();
#undef LP
}

__global__ void __launch_bounds__(512) mega(Params pk) {
    extern __shared__ __attribute__((aligned(16))) unsigned char lds[];
    cg::grid_group grid = cg::this_grid();
    LAS unsigned char* l3 = (LAS unsigned char*)lds;
    float* ldsf = (float*)lds;
    const int G = gridDim.x, bid = blockIdx.x;
    if (threadIdx.x == 0) {
        unsigned long long* dst = (unsigned long long*)(lds + LDS_PARAMS_OFF);
        dst[0] = (unsigned long long)pk.x; dst[1] = (unsigned long long)pk.c; dst[2] = (unsigned long long)pk.pos;
        const float* const* fp = &pk.ada_w;
        for (int i = 0; i < 25; ++i) dst[3 + i] = (unsigned long long)fp[i];
        dst[28] = (unsigned long long)pk.out; dst[29] = (unsigned long long)pk.ws;
    }
    if (threadIdx.x == 1) { ((LAS unsigned*)l3)[147440 / 4] = 0u; ((LAS unsigned*)l3)[147444 / 4] = 0u; }
    __syncthreads();
    if (bid == 0) { unsigned* bw = (unsigned*)(pk.ws + OFF_BAR); for (int i = threadIdx.x; i < 4096; i += 512) bw[i] = 0u; }
#define LP() const Params p = lds_params(lds)
    _Pragma("unroll 1") for (int rep = 0; rep < (PROBE == 13 ? 2 : 1); ++rep) { LP(); phase_ada(p, ldsf); }
    grid.sync();
    XcdBarrier xbar = xcd_barrier_post((unsigned*)(pk.ws + OFF_BAR), (volatile LAS unsigned*)(l3 + 147440));
#pragma unroll 1
    for (int l = 0; l < 4; ++l) {
        const bool even = (l & 1) == 0; const int e = l >> 1;
#pragma unroll 1
        for (int sub = 0; sub < 3; ++sub) {
            if (sub == 0 && even) { _Pragma("unroll 1") for (int rep = 0; rep < (PROBE == 7 ? 2 : 1); ++rep) { LP(); phase_convert(p, l, ldsf, bid, G); } }
            _Pragma("unroll 1") for (int rep = 0; rep < (PROBE == 8 ? 2 : 1); ++rep) { LP(); const float* ml = (const float*)(p.ws + OFF_MOD) + l * 9216 + sub * 3072;
              phase_norm((l == 0 && sub == 0) ? p.x : p.out, (bf16_t*)(p.ws + OFF_HY), p.norm_g + (l * 3 + sub) * 1024, ml, ml + 1024); }
            GSYNC();
            const bf16_t* A2; const bf16_t* B2; int K2; float coef;
            if (sub != 1) {
                _Pragma("unroll 1") for (int rep = 0; rep < (PROBE == 3 ? 2 : 1); ++rep) { LP(); const bf16_t* W13 = (const bf16_t*)(p.ws + (size_t)(l & 1) * W_REGION2 + (sub ? W_13B : W_13A));
                  pg8::Gemm g{(const bf16_t*)(p.ws + OFF_HY), W13, SEQ, 5632, 1024}; pg8::StaticOrder S; S.init(SEQ, 5632, G, bid); pg8::EpiSwiglu E{(bf16_t*)(p.ws + OFF_BIG), DFF};
                  pg8::gemm_phase<pg8::EpiSwiglu, pg8::StaticOrder, false>(l3, g, S, E, nullptr); }
                GSYNC();
                { LP(); A2 = (const bf16_t*)(p.ws + OFF_BIG); B2 = (const bf16_t*)(p.ws + (size_t)(l & 1) * W_REGION2 + (sub ? W_2B : W_2A)); } K2 = DFF; coef = 0.5f;
            } else {
                const int Nin = even ? EV_N : OD_N;
                _Pragma("unroll 1") for (int rep = 0; rep < (PROBE == 17 ? 2 : 1); ++rep) { LP(); pg8::Gemm g{(const bf16_t*)(p.ws + OFF_HY), (const bf16_t*)(p.ws + (size_t)(l & 1) * W_REGION2 + W_MIX), SEQ, Nin, 1024}; pg8::StaticOrder S; S.init(SEQ, Nin, G, bid); pg8::EpiBf16Plain E{(bf16_t*)(p.ws + OFF_BIG), Nin};
                  pg8::gemm_phase<pg8::EpiBf16Plain, pg8::StaticOrder, false>(l3, g, S, E, nullptr); }
                GSYNC();
                if (even) mixer_even(e, l, xbar, lds); else mixer_odd(e, xbar, lds);
                { LP(); A2 = (const bf16_t*)(p.ws + OFF_HY); B2 = (const bf16_t*)(p.ws + (size_t)(l & 1) * W_REGION2 + W_MIX) + (even ? 2816 * 1024 : 5376 * 1024); } K2 = even ? 1024 : 2048;
                coef = 1.0f;
            }
            { LP(); const float* ml = (const float*)(p.ws + OFF_MOD) + l * 9216 + sub * 3072;
              pg8::Gemm g{A2, B2, SEQ, 1024, K2}; pg8::StaticOrder S; S.init(SEQ, 1024, G, bid); pg8::EpiResid E{p.out, (l == 0 && sub == 0) ? p.x : p.out, ml + 2048, coef};
              pg8::gemm_phase<pg8::EpiResid, pg8::StaticOrder, false>(l3, g, S, E, nullptr); }
            GSYNC();
        }
    }
    { LP(); phase_final(p.out, p.final_g); }
}

extern "C" void kernel_launch(void* const* d_in, const int* in_sizes, int n_in, void* d_out, int out_size, void* d_ws, size_t ws_size, hipStream_t stream) {
    static int grid_blocks = 0;
    if (grid_blocks == 0) {
        int dev = 0, cus = 0, per_cu = 0;
        hipGetDevice(&dev);
        hipDeviceGetAttribute(&cus, hipDeviceAttributeMultiprocessorCount, dev);
        if (hipFuncSetAttribute((const void*)mega, hipFuncAttributeMaxDynamicSharedMemorySize, LDS_BYTES) != hipSuccess) { fprintf(stderr, "hipFuncSetAttribute failed\n"); grid_blocks = -1; return; }
        hipOccupancyMaxActiveBlocksPerMultiprocessor(&per_cu, (const void*)mega, 512, LDS_BYTES);
        (void)hipGetLastError();
        if (per_cu < 1) per_cu = 1;
        grid_blocks = cus * per_cu;
        if (ws_size < WS_NEED || n_in != 28) { fprintf(stderr, "kernel_launch: ws %zu < %zu or n_in %d\n", ws_size, (size_t)WS_NEED, n_in); grid_blocks = -1; return; }
    }
    if (grid_blocks < 0) return;
    Params p{};
    p.x = (const float*)d_in[0]; p.c = (const float*)d_in[1]; p.pos = (const int*)d_in[2];
    const float** fp = &p.ada_w;
    for (int i = 0; i < 25; ++i) fp[i] = (const float*)d_in[3 + i];
    p.out = (float*)d_out; p.ws = (unsigned char*)d_ws;
    void* args[] = {&p};
    hipError_t e = hipLaunchCooperativeKernel((const void*)mega, dim3(grid_blocks), dim3(512), args, LDS_BYTES, stream);
    if (e != hipSuccess) fprintf(stderr, "cooperative launch failed: %s (grid %d)\n", hipGetErrorString(e), grid_blocks);
}
```

```cpp
#include <hip/hip_runtime.h>
#include <hip/hip_cooperative_groups.h>
#include <cstdio>
namespace cg = cooperative_groups;

#define LAS __attribute__((address_space(3)))
typedef unsigned short bf16_t;
typedef short bf16x8 __attribute__((ext_vector_type(8)));
typedef float f32x4 __attribute__((ext_vector_type(4)));
typedef unsigned u32x4 __attribute__((ext_vector_type(4)));
typedef unsigned u32x2 __attribute__((ext_vector_type(2)));

constexpr int PROBE = 0;
constexpr int SEQ = 16384, DM = 1024, DFF = 2816, NCH = 256;
constexpr int EV_N = 2816, OD_N = 5376;
constexpr int LDS_BYTES = 147456;
constexpr size_t MiB = 1048576;
constexpr size_t OFF_MOD = 0;
constexpr size_t OFF_EGL = 256 * 1024;
constexpr size_t OFF_CD  = 320 * 1024;
constexpr size_t OFF_W   = 1 * MiB;
constexpr size_t W_13A = OFF_W, W_13B = W_13A + 11534336, W_2A = W_13B + 11534336, W_2B = W_2A + 5767168, W_MIX = W_2B + 5767168;
constexpr size_t OFF_HY  = 53 * MiB;
constexpr size_t OFF_BIG = 117 * MiB;
constexpr size_t OFF_MLA = OFF_BIG + 88 * MiB;
constexpr size_t M_CQN = OFF_MLA, M_CKVN = M_CQN + 12 * MiB, M_KPE = M_CKVN + 8 * MiB, M_Q = M_KPE + 2 * MiB, M_KN = M_Q + 24 * MiB, M_VT = M_KN + 16 * MiB;
constexpr size_t OFF_MIX = 285 * MiB;
constexpr size_t G_U = OFF_MIX, G_W = G_U + 32 * MiB, G_QS = G_W + 16 * MiB, G_KET = G_QS + 16 * MiB, G_ATT = G_KET + 16 * MiB, G_ORAW = G_ATT + 8 * MiB;
constexpr size_t G_SST = G_ORAW, G_VNT = G_SST + 32 * MiB;
constexpr size_t W_REGION2 = 420 * MiB;
constexpr size_t WS_NEED = 473 * MiB;

struct Params {
    const float* x; const float* c; const int* pos;
    const float *ada_w, *ada_b, *norm_g, *w1, *w3, *w2, *ev_w_in, *gdn_conv_w, *gdn_A_log, *gdn_dt_bias, *gdn_norm_g,
        *mla_q_norm_g, *mla_w_uq, *mla_kv_norm_g, *mla_w_ukv, *ev_w_out, *ssd_w_in, *ssd_conv_w, *ssd_conv_b, *ssd_A_log, *ssd_dt_bias,
        *ssd_D, *ssd_norm_g, *ssd_w_out, *final_g;
    float* out; unsigned char* ws;
};

__device__ __forceinline__ float bf2f(bf16_t b) { return __uint_as_float(((unsigned)b) << 16); }
typedef float f32x2_t __attribute__((ext_vector_type(2)));
typedef __bf16 bf16x2_t __attribute__((ext_vector_type(2)));
__device__ __forceinline__ unsigned pack2(float lo, float hi) { const f32x2_t v = {lo, hi}; const bf16x2_t b = __builtin_convertvector(v, bf16x2_t); return __builtin_bit_cast(unsigned, b); }
__device__ __forceinline__ bf16_t f2bf(float f) { return (bf16_t)(pack2(f, 0.f) & 0xffffu); }
__device__ __forceinline__ float silu_f(float x) { return x * __builtin_amdgcn_rcpf(1.0f + __expf(-x)); }
__device__ __forceinline__ float sigmoid_f(float x) { return __builtin_amdgcn_rcpf(1.0f + __expf(-x)); }
__device__ __forceinline__ float softplus_f(float x) { return fmaxf(x, 0.f) + log1pf(__expf(-fabsf(x))); }
__device__ __forceinline__ float wave_sum(float v) {
#pragma unroll
    for (int o = 32; o > 0; o >>= 1) v += __shfl_xor(v, o);
    return v;
}
__device__ __forceinline__ float wave_incl_scan(float v, int lane) {
#pragma unroll
    for (int o = 1; o < 64; o <<= 1) { float t = __shfl_up(v, o); if (lane >= o) v += t; }
    return v;
}
__device__ __forceinline__ f32x4 mfma16(bf16x8 a, bf16x8 b, f32x4 c) { return __builtin_amdgcn_mfma_f32_16x16x32_bf16(a, b, c, 0, 0, 0); }

__constant__ double ROPE_INV_FREQ[32] = {1.0, 0.7498942093324559, 0.5623413251903491, 0.4216965034285822, 0.31622776601683794, 0.23713737056616552, 0.1778279410038923, 0.1333521432163324, 0.1, 0.07498942093324558, 0.05623413251903491, 0.042169650342858224, 0.03162277660168379, 0.023713737056616554, 0.01778279410038923, 0.01333521432163324, 0.01, 0.007498942093324558, 0.005623413251903491, 0.004216965034285823, 0.0031622776601683794, 0.0023713737056616554, 0.0017782794100389228, 0.001333521432163324, 0.001, 0.0007498942093324559, 0.0005623413251903491, 0.00042169650342858224, 0.00031622776601683794, 0.00023713737056616554, 0.00017782794100389227, 0.0001333521432163324};
__device__ __forceinline__ void rope_cs(int pos, int idx, float& c, float& s) {
    double t = (double)pos * ROPE_INV_FREQ[idx] * 0.15915494309189535;
    t -= floor(t);
    float f = (float)t;
    s = __builtin_amdgcn_sinf(f); c = __builtin_amdgcn_cosf(f);
}

__device__ __forceinline__ int opaque_tid() { int t = threadIdx.x; asm volatile("" : "+v"(t)); return t; }

constexpr int LDS_PARAMS_OFF = 147200;
__device__ __forceinline__ Params lds_params(const unsigned char* lds) {
    Params q;
    const LAS unsigned* w = (const LAS unsigned*)(LAS unsigned char*)lds + LDS_PARAMS_OFF / 4;
    unsigned long long v[31];
#pragma unroll
    for (int i = 0; i < 31; ++i) { const unsigned lo = __builtin_amdgcn_readfirstlane(w[2 * i]), hi = __builtin_amdgcn_readfirstlane(w[2 * i + 1]); v[i] = ((unsigned long long)hi << 32) | lo; }
    q.x = (const float*)v[0]; q.c = (const float*)v[1]; q.pos = (const int*)v[2];
    q.ada_w = (const float*)v[3];
    q.ada_b = (const float*)v[4];
    q.norm_g = (const float*)v[5];
    q.w1 = (const float*)v[6];
    q.w3 = (const float*)v[7];
    q.w2 = (const float*)v[8];
    q.ev_w_in = (const float*)v[9];
    q.gdn_conv_w = (const float*)v[10];
    q.gdn_A_log = (const float*)v[11];
    q.gdn_dt_bias = (const float*)v[12];
    q.gdn_norm_g = (const float*)v[13];
    q.mla_q_norm_g = (const float*)v[14];
    q.mla_w_uq = (const float*)v[15];
    q.mla_kv_norm_g = (const float*)v[16];
    q.mla_w_ukv = (const float*)v[17];
    q.ev_w_out = (const float*)v[18];
    q.ssd_w_in = (const float*)v[19];
    q.ssd_conv_w = (const float*)v[20];
    q.ssd_conv_b = (const float*)v[21];
    q.ssd_A_log = (const float*)v[22];
    q.ssd_dt_bias = (const float*)v[23];
    q.ssd_D = (const float*)v[24];
    q.ssd_norm_g = (const float*)v[25];
    q.ssd_w_out = (const float*)v[26];
    q.final_g = (const float*)v[27];
    q.out = (float*)v[28]; q.ws = (unsigned char*)v[29];
    return q;
}

#define XB_TMO      128
#define XB_XCNT(j)  (256  + 64 * (j))
#define XB_XSUB(j)  (1280 + 64 * (j))
#define XB_XGEN(j)  (2304 + 64 * (j))
#define XB_TOP      3328
#define XB_TOPGEN   3392
#define XCD_BAR_WORDS 3456
#define XB_SPIN_CAP (1u << 18)

__device__ __forceinline__ unsigned xb_ld(unsigned* p)              { return __hip_atomic_load(p, __ATOMIC_RELAXED, __HIP_MEMORY_SCOPE_AGENT); }
__device__ __forceinline__ unsigned xb_add(unsigned* p, unsigned v) { return __hip_atomic_fetch_add(p, v, __ATOMIC_RELAXED, __HIP_MEMORY_SCOPE_AGENT); }
__device__ __forceinline__ unsigned xb_xcc_id() { return (unsigned)__builtin_amdgcn_s_getreg((3 << 11) | 20) & 0xFu; }
#define XB_SPIN(cond, bar) do { unsigned _sp = 0; while (cond) { if (_sp < 64u) __builtin_amdgcn_s_sleep(1); else __builtin_amdgcn_s_sleep(32); \
    if ((++_sp & 255u) == 0u) { if (xb_ld(&(bar)[XB_TMO])) break; if (_sp > XB_SPIN_CAP) { atomicAdd(&(bar)[XB_TMO], 1u); break; } } } } while (0)

struct XcdBarrier {
    unsigned* bar; unsigned x;
    volatile LAS unsigned* st;
};

__device__ __forceinline__ XcdBarrier xcd_barrier_post(unsigned* bar, volatile LAS unsigned* st) {
    XcdBarrier b; b.bar = bar; b.x = xb_xcc_id(); b.st = st;
    if (threadIdx.x == 0) (void)xb_add(&bar[XB_XCNT(b.x)], 1u);
    return b;
}
__device__ __forceinline__ void xcd_barrier_complete(unsigned* bar, unsigned x, unsigned& nloc, unsigned& nx) {
    const unsigned G = gridDim.x * gridDim.y * gridDim.z;
    unsigned sum, cnt, mine, sp = 0u;
    for (;;) {
        sum = 0u; cnt = 0u; mine = 0u;
#pragma unroll
        for (unsigned j = 0; j < 16; ++j) { const unsigned c = xb_ld(&bar[XB_XCNT(j)]); sum += c; cnt += (c > 0u) ? 1u : 0u; mine = (j == x) ? c : mine; }
        if (sum == G) break;
        __builtin_amdgcn_s_sleep(1);
        if ((++sp & 255u) == 0u) { if (xb_ld(&bar[XB_TMO])) break; if (sp > XB_SPIN_CAP) { atomicAdd(&bar[XB_TMO], 1u); break; } }
    }
    nloc = mine > 0u ? mine : 1u; nx = cnt > 0u ? cnt : 1u;
}

__device__ __forceinline__ void xcd_barrier(const XcdBarrier& b) {
    asm volatile("s_waitcnt vmcnt(0)" ::: "memory");
    __syncthreads();
    if (threadIdx.x == 0) {
        unsigned* bar = b.bar;
        __builtin_amdgcn_s_waitcnt(0);
        unsigned nloc = b.st[0], nx = b.st[1];
        if (nloc == 0u) { xcd_barrier_complete(bar, b.x, nloc, nx); b.st[0] = nloc; b.st[1] = nx; }
        const unsigned old = xb_add(&bar[XB_XSUB(b.x)], 1u);
        const unsigned gen = old / nloc;
        if (old + 1u == (gen + 1u) * nloc) {
            __builtin_amdgcn_fence(__ATOMIC_RELEASE, "agent");
            asm volatile("s_waitcnt vmcnt(0)" ::: "memory");
            const unsigned og = xb_add(&bar[XB_TOP], 1u);
            const unsigned tg = og / nx;
            if (og + 1u == (tg + 1u) * nx) xb_add(&bar[XB_TOPGEN], 1u);
            else XB_SPIN(xb_ld(&bar[XB_TOPGEN]) == tg, bar);
            __builtin_amdgcn_fence(__ATOMIC_ACQUIRE, "agent");
            xb_add(&bar[XB_XGEN(b.x)], 1u);
            asm volatile("s_waitcnt vmcnt(0)" ::: "memory");
        } else {
            XB_SPIN(xb_ld(&bar[XB_XGEN(b.x)]) == gen, bar);
            __builtin_amdgcn_fence(__ATOMIC_ACQUIRE, "agent");
            asm volatile("s_waitcnt vmcnt(0)" ::: "memory");
        }
    }
    __syncthreads();
}


#define GSYNC() do { xcd_barrier(xbar); if (PROBE == 9) xcd_barrier(xbar); } while (0)
constexpr size_t OFF_BAR = 384 * 1024;

#define CONV_PAIR(P_, pitch_, col_, tok0_, w_, wstride_, cc_, b0_, b1_, BODY) do { \
        const unsigned* src_ = (const unsigned*)((P_) + (size_t)(tok0_) * (pitch_) + (col_)); \
        unsigned raw_[67]; \
        _Pragma("unroll") for (int t = 0; t < 67; ++t) raw_[t] = ((t >= 3) || (tok0_) > 0) ? src_[((long)t - 3) * ((pitch_) / 2)] : 0u; \
        const float wa0_ = (w_)[cc_], wa1_ = (w_)[(wstride_) + (cc_)], wa2_ = (w_)[2 * (wstride_) + (cc_)], wa3_ = (w_)[3 * (wstride_) + (cc_)]; \
        const float wb0_ = (w_)[(cc_) + 1], wb1_ = (w_)[(wstride_) + (cc_) + 1], wb2_ = (w_)[2 * (wstride_) + (cc_) + 1], wb3_ = (w_)[3 * (wstride_) + (cc_) + 1]; \
        __builtin_amdgcn_sched_barrier(0); \
        _Pragma("unroll") for (int t = 0; t < 64; ++t) { \
            const float y0 = silu_f((b0_) + wa0_ * __uint_as_float(raw_[t] << 16) + wa1_ * __uint_as_float(raw_[t + 1] << 16) + wa2_ * __uint_as_float(raw_[t + 2] << 16) + wa3_ * __uint_as_float(raw_[t + 3] << 16)); \
            const float y1 = silu_f((b1_) + wb0_ * __uint_as_float(raw_[t] & 0xffff0000u) + wb1_ * __uint_as_float(raw_[t + 1] & 0xffff0000u) + wb2_ * __uint_as_float(raw_[t + 2] & 0xffff0000u) + wb3_ * __uint_as_float(raw_[t + 3] & 0xffff0000u)); \
            BODY; } } while (0)
namespace pg8 {
#define PG8_LAS __attribute__((address_space(3)))
typedef unsigned short bf16_t;
typedef short bf16x8 __attribute__((ext_vector_type(8)));
typedef float f32x4 __attribute__((ext_vector_type(4)));
typedef unsigned u32x4 __attribute__((ext_vector_type(4)));
constexpr int BM = 256, BK = 64, HALF = 128, HTB = HALF * BK * 2  , STAGE_BYTES = 8 * HTB, NXCD = 8, WGM = 8;

__host__ __device__ __forceinline__ int lds_byte(int r, int c) { const int st = (r >> 4) * 2 + (c >> 5), rr = r & 15, cc = c & 31, ob = rr * 64 + cc * 2; return st * 1024 + (ob ^ (((ob >> 9) & 1) << 5)); }
__host__ __device__ __forceinline__ void stage_rc(int b, int& R, int& C) { const int st = b / 1024, sb = b % 1024, swz = sb ^ (((sb >> 9) & 1) << 5); R = (st >> 1) * 16 + swz / 64; C = (st & 1) * 32 + (swz % 64) / 2; }
__host__ __device__ __forceinline__ int perm32(int rho) { const int n = rho >> 4, i = rho & 15; return 8 * (i >> 2) + 4 * n + (i & 3); }

struct Unit { int pm, pn; };
struct Gemm { const bf16_t* A; const bf16_t* Bt; int M, N, K; };

struct StaticOrder {
    int nM, nN, nwg, G, c;
    __host__ __device__ void init(int M, int N, int G_, int c_) { nM = M / BM; nN = N / BM; nwg = nM * nN; G = G_; c = c_; }
    __host__ __device__ bool next(int i, Unit& u) const {
        const long L = (long)i * G + c; if (L >= nwg) return false;
        int wgid = (int)L; { const int q = nwg / NXCD, r = nwg % NXCD, xcd = wgid % NXCD, off = wgid / NXCD; wgid = (xcd < r ? xcd * (q + 1) : r * (q + 1) + (xcd - r) * q) + off; }
        const int nig = WGM * nN, gid = wgid / nig, fm = gid * WGM, gsz = (nM - fm) < WGM ? (nM - fm) : WGM;
        u.pm = fm + ((wgid % nig) % gsz); u.pn = (wgid % nig) / gsz; return true;
    }
    __device__ __forceinline__ void a_ready(const Unit&) const {}
    __device__ __forceinline__ void done(const Unit&) const {}
};
__device__ __forceinline__ unsigned cvt_pk_bf16(float lo, float hi) { unsigned r; asm volatile("v_cvt_pk_bf16_f32 %0, %1, %2" : "=v"(r) : "v"(lo), "v"(hi)); return r; }
struct EpiBf16Plain {
    static constexpr bool PERM = true, AFTER_DRAIN = false;
    bf16_t* O; int ldc;
    __device__ __forceinline__ void operator()(const f32x4 (&acc)[2][2][4][2], const Unit& u, int wr, int wc, int fr, int fq) const {
        const int row0 = u.pm * BM + wr * 64 + fr; const int col0 = u.pn * BM + wc * 32 + 8 * fq;
#pragma unroll
        for (int ai = 0; ai < 2; ++ai)
#pragma unroll
            for (int m = 0; m < 4; ++m) { bf16_t* rowp = O + (size_t)(row0 + ai * HALF + m * 16) * ldc + col0;
#pragma unroll
                for (int bj = 0; bj < 2; ++bj) { const f32x4 v0 = acc[ai][bj][m][0], v1 = acc[ai][bj][m][1];
                    u32x4 w; w.x = cvt_pk_bf16(v0[0], v0[1]); w.y = cvt_pk_bf16(v0[2], v0[3]); w.z = cvt_pk_bf16(v1[0], v1[1]); w.w = cvt_pk_bf16(v1[2], v1[3]);
                    *(u32x4*)(rowp + bj * HALF) = w; } }
    }
};
struct EpiSwiglu {
    static constexpr bool PERM = true, AFTER_DRAIN = false;
    bf16_t* U; int ldc;
    __device__ __forceinline__ void operator()(const f32x4 (&acc)[2][2][4][2], const Unit& u, int wr, int wc, int fr, int fq) const {
        const int row0 = u.pm * BM + wr * 64 + fr; const int col0 = u.pn * HALF + wc * 32 + 8 * fq;
#pragma unroll
        for (int ai = 0; ai < 2; ++ai)
#pragma unroll
            for (int m = 0; m < 4; ++m) { bf16_t* rowp = U + (size_t)(row0 + ai * HALF + m * 16) * ldc + col0;
                float r[8];
#pragma unroll
                for (int n = 0; n < 2; ++n)
#pragma unroll
                    for (int j = 0; j < 4; ++j) { const float a = acc[ai][0][m][n][j], b = acc[ai][1][m][n][j]; r[n * 4 + j] = a * __builtin_amdgcn_rcpf(1.0f + __expf(-a)) * b; }
                u32x4 w; w.x = cvt_pk_bf16(r[0], r[1]); w.y = cvt_pk_bf16(r[2], r[3]); w.z = cvt_pk_bf16(r[4], r[5]); w.w = cvt_pk_bf16(r[6], r[7]);
                *(u32x4*)rowp = w; }
    }
};
struct EpiResid {
    static constexpr bool PERM = false, AFTER_DRAIN = false;
    float* X; const float* Xin; const float* gate; float coef;
    __device__ __forceinline__ void operator()(const f32x4 (&acc)[2][2][4][2], const Unit& u, int wr, int wc, int fr, int fq) const {
        const int row0 = u.pm * BM + wr * 64 + fr, col0 = u.pn * BM + wc * 32 + 4 * fq;
        f32x4 gv[2][2];
#pragma unroll
        for (int bj = 0; bj < 2; ++bj)
#pragma unroll
            for (int n = 0; n < 2; ++n) gv[bj][n] = *(const f32x4*)(gate + col0 + bj * HALF + n * 16) * coef;
#pragma unroll
        for (int am = 0; am < 4; ++am) {
            const int ai = am >> 1, m0 = (am & 1) * 2;
            f32x4 xv[2][2][2];
#pragma unroll
            for (int mm = 0; mm < 2; ++mm) { const float* rowp = Xin + (size_t)(row0 + ai * HALF + (m0 + mm) * 16) * 1024 + col0;
#pragma unroll
                for (int bj = 0; bj < 2; ++bj)
#pragma unroll
                    for (int n = 0; n < 2; ++n) xv[mm][bj][n] = *(const f32x4*)(rowp + bj * HALF + n * 16); }
#pragma unroll
            for (int mm = 0; mm < 2; ++mm) { float* rowp = X + (size_t)(row0 + ai * HALF + (m0 + mm) * 16) * 1024 + col0;
#pragma unroll
                for (int bj = 0; bj < 2; ++bj)
#pragma unroll
                    for (int n = 0; n < 2; ++n) *(f32x4*)(rowp + bj * HALF + n * 16) = xv[mm][bj][n] + gv[bj][n] * acc[ai][bj][m0 + mm][n]; }
            asm volatile("" ::: "memory");
        }
    }
};
template <class Epi, class Sched, bool STAMP = false>
__device__ __forceinline__ void gemm_phase(PG8_LAS unsigned char* lds, const Gemm g, const Sched& S, const Epi& E, unsigned long long* stamps) {
    int tid_ = threadIdx.x; asm volatile("" : "+v"(tid_)); const int tid = tid_, wid = __builtin_amdgcn_readfirstlane(tid >> 6), lane = tid & 63, wr = wid >> 2, wc = wid & 3, fr = lane & 15, fq = lane >> 4;
    const int K = g.K, nt = K / BK;
    int ts_lo = 0, ts_hi = 0, nts = 0; const unsigned long long rt_entry = STAMP ? (unsigned long long)wall_clock64() : 0ull;
#define PG8_STAMP() do { if (STAMP && wid == 0 && nts < 64) { const unsigned long long _c = (unsigned long long)clock64(); \
        ts_lo = (lane == nts) ? (int)(unsigned)_c : ts_lo; ts_hi = (lane == nts) ? (int)(unsigned)(_c >> 32) : ts_hi; ++nts; } } while (0)
    PG8_STAMP();
    unsigned voffA[2], voffB[2];
#pragma unroll
    for (int i = 0; i < 2; ++i) { int R, C; stage_rc(tid * 16 + i * 8192, R, C); const int Rb = Epi::PERM ? ((R & ~31) + perm32(R & 31)) : R;
        voffA[i] = (unsigned)(R * K + C) * 2u; voffB[i] = (unsigned)(Rb * K + C) * 2u; }
    const size_t kstep = (size_t)(BK * 2);
    const size_t hstep = (size_t)HALF * K * 2;
    const size_t tstep = 2 * hstep;
    const unsigned ldsw = (unsigned)wid * 1024u;
    const int aoff = lds_byte(wr * 64 + fr, fq * 8), boff = lds_byte(wc * 32 + fr, fq * 8);
#define PG8_SA(b, h) (((b) * 2 + (h)) * HTB)
#define PG8_SB(b, h) ((4 + (b) * 2 + (h)) * HTB)
#define PG8_STAGE(bufoff, gbase, voff) do { _Pragma("unroll") for (int _i = 0; _i < 2; ++_i) \
        __builtin_amdgcn_global_load_lds((const unsigned*)((const char*)(gbase) + (voff)[_i]), (PG8_LAS unsigned*)(lds + (bufoff) + ldsw + _i * 8192), 16, 0, 0); } while (0)
#define PG8_LDA(dst, b, h) do { _Pragma("unroll") for (int m = 0; m < 4; ++m) _Pragma("unroll") for (int k = 0; k < 2; ++k) dst[m][k] = *(const PG8_LAS bf16x8*)(lds + PG8_SA(b, h) + aoff + m * 2048 + k * 1024); } while (0)
#define PG8_LDB(dst, b, h) do { _Pragma("unroll") for (int n = 0; n < 2; ++n) _Pragma("unroll") for (int k = 0; k < 2; ++k) dst[n][k] = *(const PG8_LAS bf16x8*)(lds + PG8_SB(b, h) + boff + n * 2048 + k * 1024); } while (0)
#define PG8_MMA(ai, bj, At, Bt) do { __builtin_amdgcn_s_setprio(1); _Pragma("unroll") for (int m = 0; m < 4; ++m) _Pragma("unroll") for (int n = 0; n < 2; ++n) _Pragma("unroll") for (int k = 0; k < 2; ++k) \
        acc[ai][bj][m][n] = __builtin_amdgcn_mfma_f32_16x16x32_bf16(Bt[n][k], At[m][k], acc[ai][bj][m][n], 0, 0, 0); __builtin_amdgcn_s_setprio(0); } while (0)
#define PG8_WAIT_V(n) asm volatile("s_waitcnt vmcnt(" #n ")" ::: "memory")
#define PG8_WAIT_L(n) asm volatile("s_waitcnt lgkmcnt(" #n ")" ::: "memory")
#define PG8_BAR __builtin_amdgcn_s_barrier()
#define PG8_SCHED __builtin_amdgcn_sched_barrier(0)
    Unit cur, nxt; int ui = 0;
    if (!S.next(0, cur)) return;
    f32x4 acc[2][2][4][2];
#pragma unroll
    for (int a = 0; a < 2; ++a)
#pragma unroll
        for (int b = 0; b < 2; ++b)
#pragma unroll
            for (int m = 0; m < 4; ++m)
#pragma unroll
                for (int n = 0; n < 2; ++n) acc[a][b][m][n] = (f32x4){0.f, 0.f, 0.f, 0.f};
    bf16x8 At[4][2], B0[2][2], B1[2][2];
    const char* cA = (const char*)g.A + (size_t)cur.pm * tstep; const char* cB = (const char*)g.Bt + (size_t)cur.pn * tstep;
    S.a_ready(cur);
    PG8_STAGE(PG8_SB(0, 0), cB, voffB); PG8_STAGE(PG8_SA(0, 0), cA, voffA); PG8_STAGE(PG8_SB(0, 1), cB + hstep, voffB); PG8_STAGE(PG8_SA(0, 1), cA + hstep, voffA);
    if (wr == 1) PG8_BAR;
    PG8_WAIT_V(4); PG8_BAR;
    PG8_STAGE(PG8_SB(1, 0), cB + kstep, voffB); PG8_STAGE(PG8_SA(1, 0), cA + kstep, voffA); PG8_STAGE(PG8_SB(1, 1), cB + hstep + kstep, voffB);
    PG8_WAIT_V(6); PG8_BAR;
    PG8_STAMP();
    for (;;) {
        const bool has_next = S.next(ui + 1, nxt);
        const char* nA = has_next ? (const char*)g.A + (size_t)nxt.pm * tstep : cA; const char* nB = has_next ? (const char*)g.Bt + (size_t)nxt.pn * tstep : cB;
        for (int t = 0; t < nt; t += 2) {
            const bool last = (t == nt - 2);
            const char* a1 = cA + (size_t)(t + 1) * kstep;
            const char* a2 = last ? nA : cA + (size_t)(t + 2) * kstep; const char* b2 = last ? nB : cB + (size_t)(t + 2) * kstep;
            const char* a3 = a2 + kstep; const char* b3 = b2 + kstep;
            if (last && has_next) S.a_ready(nxt);
            PG8_LDB(B0, 0, 0); PG8_SCHED; PG8_LDA(At, 0, 0); PG8_STAGE(PG8_SA(1, 1), a1 + hstep, voffA);
            PG8_WAIT_L(8); PG8_BAR; PG8_WAIT_L(0); PG8_MMA(0, 0, At, B0); PG8_BAR; PG8_SCHED;
            PG8_LDB(B1, 0, 1); PG8_STAGE(PG8_SB(0, 0), b2, voffB);
            PG8_BAR; PG8_WAIT_L(0); PG8_MMA(0, 1, At, B1); PG8_BAR;
            PG8_LDA(At, 0, 1); PG8_STAGE(PG8_SA(0, 0), a2, voffA);
            PG8_BAR; PG8_WAIT_L(0); PG8_MMA(1, 0, At, B0); PG8_BAR; PG8_SCHED;
            PG8_STAGE(PG8_SB(0, 1), b2 + hstep, voffB);
            PG8_WAIT_V(6); PG8_BAR; PG8_MMA(1, 1, At, B1); PG8_BAR;
            PG8_LDB(B0, 1, 0); PG8_SCHED; PG8_LDA(At, 1, 0); PG8_STAGE(PG8_SA(0, 1), a2 + hstep, voffA);
            PG8_WAIT_L(8); PG8_BAR; PG8_WAIT_L(0); PG8_MMA(0, 0, At, B0); PG8_BAR; PG8_SCHED;
            PG8_LDB(B1, 1, 1); PG8_STAGE(PG8_SB(1, 0), b3, voffB);
            PG8_BAR; PG8_WAIT_L(0); PG8_MMA(0, 1, At, B1); PG8_BAR;
            PG8_LDA(At, 1, 1); PG8_STAGE(PG8_SA(1, 0), a3, voffA);
            PG8_BAR; PG8_WAIT_L(0); PG8_MMA(1, 0, At, B0); PG8_BAR; PG8_SCHED;
            PG8_STAGE(PG8_SB(1, 1), b3 + hstep, voffB);
            PG8_WAIT_V(6); PG8_BAR; PG8_MMA(1, 1, At, B1); PG8_BAR;
        }
        PG8_STAMP();
        if constexpr (!Epi::AFTER_DRAIN) { E(acc, cur, wr, wc, fr, fq); S.done(cur); }
        PG8_STAMP();
        if (!has_next) break;
#pragma unroll
        for (int a = 0; a < 2; ++a)
#pragma unroll
            for (int b = 0; b < 2; ++b)
#pragma unroll
                for (int m = 0; m < 4; ++m)
#pragma unroll
                    for (int n = 0; n < 2; ++n) acc[a][b][m][n] = (f32x4){0.f, 0.f, 0.f, 0.f};
        cur = nxt; cA = nA; cB = nB; ++ui;
    }
    PG8_WAIT_V(0);
    if (wr == 0) PG8_BAR;
    PG8_BAR;
    if constexpr (Epi::AFTER_DRAIN) { E.fused(acc, cur, wr, wc, fr, fq, lds, wid, lane); S.done(cur); }
    PG8_STAMP();
    if (STAMP && wid == 0) { stamps[lane] = lane < nts ? (((unsigned long long)(unsigned)ts_hi << 32) | (unsigned)ts_lo) : 0ull;
        if (lane == 62) stamps[62] = rt_entry; if (lane == 63) stamps[63] = (unsigned long long)wall_clock64(); }
#undef PG8_STAMP
#undef PG8_SA
#undef PG8_SB
#undef PG8_STAGE
#undef PG8_LDA
#undef PG8_LDB
#undef PG8_MMA
#undef PG8_WAIT_V
#undef PG8_WAIT_L
#undef PG8_BAR
#undef PG8_SCHED
}
}

__device__ __forceinline__ void phase_ada(const Params& p, float* ldsf, int t0, int t1, int vb, int VG) {
    const int tid = opaque_tid();
    float* mod = (float*)(p.ws + OFF_MOD);
    const int cq = tid & 15, ks = tid >> 4;
    for (int t = t0 + vb; t < t1; t += VG) {
        const int l = t / 144, cgi = t % 144; const int col = cgi * 64 + cq * 4;
        const float* W = p.ada_w + (size_t)l * 1024 * 9216 + col;
        f32x4 acc = {0.f, 0.f, 0.f, 0.f};
        f32x4 wv[32];
#pragma unroll
        for (int i = 0; i < 32; ++i) wv[i] = __builtin_nontemporal_load((const f32x4*)(W + (size_t)(ks * 32 + i) * 9216));
        __builtin_amdgcn_sched_barrier(0);
#pragma unroll
        for (int i = 0; i < 32; ++i) { const float cv = p.c[ks * 32 + i]; const float ca = cv / (1.0f + expf(-cv)); acc += wv[i] * ca; }
        *(f32x4*)(ldsf + (ks * 16 + cq) * 4) = acc;
        __syncthreads();
        if (tid < 64) { const int cqq = tid >> 2, j = tid & 3; float s = 0.f; for (int k2 = 0; k2 < 32; ++k2) s += ldsf[(k2 * 16 + cqq) * 4 + j];
            const int o = l * 9216 + cgi * 64 + cqq * 4 + j; mod[o] = s + p.ada_b[o]; }
        __syncthreads();
    }
}

__device__ __forceinline__ int conv_col(int mode, int r, int& which) {
    which = 0;
    if (mode == 1) { const int pn = r >> 8, w = r & 255; which = (w >= 128) ? 1 : 0; return pn * 128 + (w & 127); }
    if (mode == 2) { if (r < 512) return (r >> 7) * 256 + (r & 127); const int rr = r - 512; return (rr >> 7) * 256 + 128 + (rr & 127); }
    return r;
}
__device__ __forceinline__ void convT(bf16_t* dst, const float* src0, const float* src1, int K, int ldsrc, int Nsrc, int Ndst, int mode, int& tbase, float* tile, int vb, int VG) {
    const int tid = opaque_tid();
    const int nkt = K >> 7, ntiles = nkt * (Ndst >> 6);
    const int first = (vb + VG - (tbase % VG)) % VG;
    for (int t = first; t < ntiles; t += VG) {
        const int nt_ = t / nkt, kt = t % nkt; const int r0 = nt_ * 64, k0 = kt * 128;
        { const int n = tid & 63, kk = tid >> 6; int which; const int col = conv_col(mode, r0 + n, which); const bool valid = col < Nsrc;
          const float* src = (which ? src1 : src0) + (size_t)k0 * ldsrc + col;
          float v[16];
#pragma unroll
          for (int it = 0; it < 16; ++it) v[it] = valid ? __builtin_nontemporal_load(src + (size_t)(kk + it * 8) * ldsrc) : 0.f;
#pragma unroll
          for (int it = 0; it < 16; ++it) tile[(kk + it * 8) * 65 + n] = v[it]; }
        __syncthreads();
        { const int kp = tid & 63, n = tid >> 6;
#pragma unroll
          for (int it = 0; it < 8; ++it) { const int nn = n + it * 8; const float v0 = tile[(2 * kp) * 65 + nn], v1 = tile[(2 * kp + 1) * 65 + nn];
              *(unsigned*)(dst + (size_t)(r0 + nn) * K + k0 + 2 * kp) = pack2(v0, v1); } }
        __syncthreads();
    }
    tbase += ntiles;
}
__device__ __forceinline__ void phase_convert(const Params& p, int l, float* tile, int vb, int VG) {
    int tb = 0;
    unsigned char* wsw = p.ws + (size_t)(l & 1) * W_REGION2;
    for (int f = 0; f < 2; ++f) {
        const size_t wo = (size_t)(l * 2 + f) * 1024 * 2816;
        convT((bf16_t*)(wsw + (f ? W_13B : W_13A)), p.w1 + wo, p.w3 + wo, 1024, 2816, 2816, 5632, 1, tb, tile, vb, VG);
        convT((bf16_t*)(wsw + (f ? W_2B : W_2A)), p.w2 + wo, nullptr, 2816, 1024, 1024, 1024, 0, tb, tile, vb, VG);
    }
    const int e = l >> 1;
    if ((l & 1) == 0) {
        bf16_t* wi = (bf16_t*)(wsw + W_MIX); bf16_t* wout = wi + 2816 * 1024; bf16_t* wuq = wout + 1024 * 1024; bf16_t* wukv = wuq + 768 * 384;
        convT(wi, p.ev_w_in + (size_t)e * 1024 * 2760, nullptr, 1024, 2760, 2760, 2816, 0, tb, tile, vb, VG);
        convT(wout, p.ev_w_out + (size_t)e * 1024 * 1024, nullptr, 1024, 1024, 1024, 1024, 0, tb, tile, vb, VG);
        convT(wuq, p.mla_w_uq + (size_t)e * 384 * 768, nullptr, 384, 768, 768, 768, 0, tb, tile, vb, VG);
        convT(wukv, p.mla_w_ukv + (size_t)e * 256 * 1024, nullptr, 256, 1024, 1024, 1024, 2, tb, tile, vb, VG);
    } else {
        bf16_t* wi = (bf16_t*)(wsw + W_MIX); bf16_t* wout = wi + 5376 * 1024;
        convT(wi, p.ssd_w_in + (size_t)e * 1024 * 5152, nullptr, 1024, 5152, 5152, 5376, 0, tb, tile, vb, VG);
        convT(wout, p.ssd_w_out + (size_t)e * 2048 * 1024, nullptr, 2048, 1024, 1024, 1024, 0, tb, tile, vb, VG);
    }
}

__device__ __forceinline__ void phase_norm(const float* X, bf16_t* H, const float* g, const float* shift, const float* scale) {
    const int tid = opaque_tid(), wave = tid >> 6, lane = tid & 63;
    for (int row = (blockIdx.x * 8 + wave) * 2; row < SEQ; row += gridDim.x * 16) {
        const f32x4* xr = (const f32x4*)(X + (size_t)row * 1024);
        f32x4 v[2][4]; float ss[2] = {0.f, 0.f};
#pragma unroll
        for (int r = 0; r < 2; ++r)
#pragma unroll
            for (int i = 0; i < 4; ++i) v[r][i] = xr[r * 256 + lane + 64 * i];
#pragma unroll
        for (int r = 0; r < 2; ++r) {
#pragma unroll
            for (int i = 0; i < 4; ++i) ss[r] += v[r][i][0] * v[r][i][0] + v[r][i][1] * v[r][i][1] + v[r][i][2] * v[r][i][2] + v[r][i][3] * v[r][i][3];
            ss[r] = wave_sum(ss[r]); }
#pragma unroll
        for (int i = 0; i < 4; ++i) { const int col = (lane + 64 * i) * 4;
            const f32x4 g4 = *(const f32x4*)(g + col), sc = *(const f32x4*)(scale + col), sh = *(const f32x4*)(shift + col);
#pragma unroll
            for (int r = 0; r < 2; ++r) { const float rstd = rsqrtf(ss[r] * (1.0f / 1024.0f) + 1e-6f);
                float y[4];
#pragma unroll
                for (int j = 0; j < 4; ++j) y[j] = (v[r][i][j] * rstd * g4[j]) * (1.0f + sc[j]) + sh[j];
                u32x2 w; w.x = pack2(y[0], y[1]); w.y = pack2(y[2], y[3]);
                *(u32x2*)(H + (size_t)(row + r) * 1024 + col) = w; } }
    }
}
__device__ __forceinline__ void phase_final(float* X, const float* g) {
    const int tid = opaque_tid(), wave = tid >> 6, lane = tid & 63;
    for (int row = (blockIdx.x * 8 + wave) * 2; row < SEQ; row += gridDim.x * 16) {
        f32x4* xr = (f32x4*)(X + (size_t)row * 1024);
        f32x4 v[2][4]; float ss[2] = {0.f, 0.f};
#pragma unroll
        for (int r = 0; r < 2; ++r)
#pragma unroll
            for (int i = 0; i < 4; ++i) v[r][i] = xr[r * 256 + lane + 64 * i];
#pragma unroll
        for (int r = 0; r < 2; ++r) {
#pragma unroll
            for (int i = 0; i < 4; ++i) ss[r] += v[r][i][0] * v[r][i][0] + v[r][i][1] * v[r][i][1] + v[r][i][2] * v[r][i][2] + v[r][i][3] * v[r][i][3];
            ss[r] = wave_sum(ss[r]); }
#pragma unroll
        for (int i = 0; i < 4; ++i) { const f32x4 g4 = *(const f32x4*)(g + (lane + 64 * i) * 4);
#pragma unroll
            for (int r = 0; r < 2; ++r) xr[r * 256 + lane + 64 * i] = v[r][i] * rsqrtf(ss[r] * (1.0f / 1024.0f) + 1e-6f) * g4; }
    }
}

__device__ __forceinline__ void phase_mla_prep(const Params& p, int e) {
    const int tid = opaque_tid(), wave = tid >> 6, lane = tid & 63;
    const bf16_t* P = (const bf16_t*)(p.ws + OFF_BIG);
    bf16_t* CQN = (bf16_t*)(p.ws + M_CQN); bf16_t* CKVN = (bf16_t*)(p.ws + M_CKVN); bf16_t* KPE = (bf16_t*)(p.ws + M_KPE);
    const float* gq = p.mla_q_norm_g + e * 384; const float* gkv = p.mla_kv_norm_g + e * 256;
    for (int tok = blockIdx.x * 8 + wave; tok < SEQ; tok += gridDim.x * 8) {
        const bf16_t* pr = P + (size_t)tok * EV_N;
        { float q[6]; float ss = 0.f;
#pragma unroll
          for (int i = 0; i < 3; ++i) { const unsigned w = *(const unsigned*)(pr + 2056 + lane * 2 + 128 * i); q[2 * i] = bf2f((bf16_t)(w & 0xffff)); q[2 * i + 1] = bf2f((bf16_t)(w >> 16)); ss += q[2 * i] * q[2 * i] + q[2 * i + 1] * q[2 * i + 1]; }
          ss = wave_sum(ss); const float r = rsqrtf(ss * (1.0f / 384.0f) + 1e-6f);
#pragma unroll
          for (int i = 0; i < 3; ++i) { const int col = lane * 2 + 128 * i; *(unsigned*)(CQN + (size_t)tok * 384 + col) = pack2(q[2 * i] * r * gq[col], q[2 * i + 1] * r * gq[col + 1]); } }
        { const u32x2 w = *(const u32x2*)(pr + 2440 + lane * 4); float v[4] = {bf2f((bf16_t)(w.x & 0xffff)), bf2f((bf16_t)(w.x >> 16)), bf2f((bf16_t)(w.y & 0xffff)), bf2f((bf16_t)(w.y >> 16))};
          float ss = v[0] * v[0] + v[1] * v[1] + v[2] * v[2] + v[3] * v[3]; ss = wave_sum(ss); const float r = rsqrtf(ss * (1.0f / 256.0f) + 1e-6f);
          const int col = lane * 4; u32x2 o; o.x = pack2(v[0] * r * gkv[col], v[1] * r * gkv[col + 1]); o.y = pack2(v[2] * r * gkv[col + 2], v[3] * r * gkv[col + 3]);
          *(u32x2*)(CKVN + (size_t)tok * 256 + col) = o; }
        { const float v = bf2f(pr[2696 + lane]); const float pa = __shfl_xor(v, 32); float c, s; rope_cs(p.pos[tok], lane & 31, c, s);
          KPE[(size_t)tok * 64 + lane] = f2bf(lane < 32 ? v * c - pa * s : v * c + pa * s); }
    }
}

__device__ __forceinline__ void phase_gdn_intra(const Params& p, int e, unsigned char* lds) {
    const int tid = opaque_tid(), wave = tid >> 6, lane = tid & 63, fr = lane & 15, fq = lane >> 4;
    float* R0 = (float*)lds; float* R1 = (float*)(lds + 33792); float* R2 = (float*)(lds + 67584);
    bf16_t* QB = (bf16_t*)(lds + 101376); bf16_t* KB = (bf16_t*)(lds + 118784);
    float* sBeta = (float*)(lds + 136192); float* sGc = sBeta + 64;
    const bf16_t* P = (const bf16_t*)(p.ws + OFF_BIG);
    float* U = (float*)(p.ws + G_U); bf16_t* Wb = (bf16_t*)(p.ws + G_W); bf16_t* QS = (bf16_t*)(p.ws + G_QS); bf16_t* KET = (bf16_t*)(p.ws + G_KET); bf16_t* ATT = (bf16_t*)(p.ws + G_ATT);
    float* EGL = (float*)(p.ws + OFF_EGL);
    const float* cw = p.gdn_conv_w + (size_t)e * 4 * 1536;
    for (int item = blockIdx.x; item < 1024; item += gridDim.x) {
        const int h = item & 3, n = item >> 2, tok0 = n * 64;
        if (tid < 192) {
            const int part = tid >> 6, c2 = (tid & 63) * 2, ch = part * 512 + h * 128 + c2;
            float* dst = (part == 0 ? R0 : (part == 1 ? R1 : R2)) + c2;
            CONV_PAIR(P, EV_N, ch, tok0, cw, 1536, ch, 0.f, 0.f, { dst[t * 132] = y0; dst[t * 132 + 1] = y1; });
        } else if (tid >= 384 && tid < 448) {
            const int t = tid - 384; const bf16_t* pr = P + (size_t)(tok0 + t) * EV_N;
            const float bl = bf2f(pr[2048 + h]), a = bf2f(pr[2052 + h]);
            sBeta[t] = sigmoid_f(bl);
            float g = -expf(p.gdn_A_log[e * 4 + h]) * softplus_f(a + p.gdn_dt_bias[e * 4 + h]);
            g = wave_incl_scan(g, lane);
            sGc[t] = g;
        }
        __syncthreads();
        for (int i = 0; i < 16; ++i) {
            const int r = wave * 16 + i; const bool isq = r < 64; const int t = r & 63; float* row = (isq ? R0 : R1) + t * 132;
            float a = row[lane], b = row[lane + 64]; const float ss = wave_sum(a * a + b * b); const float sc = rsqrtf(ss + 1e-6f) * (isq ? 0.08838834764831845f : 1.0f);
            a *= sc; b *= sc;
            bf16_t* brow = (isq ? QB : KB) + t * 136; brow[lane] = f2bf(a); brow[lane + 64] = f2bf(b);
            if (!isq) { row[lane] = a; row[lane + 64] = b; }
            else { const float eg = __expf(sGc[t]); bf16_t* qo = QS + (size_t)(tok0 + t) * 512 + h * 128; qo[lane] = f2bf(a * eg); qo[lane + 64] = f2bf(b * eg); }
        }
        __syncthreads();
        {
            float* Amat = R0;
            const int m = wave >> 2, ib = wave & 3; const bf16_t* Y = m ? QB : KB;
            bf16x8 yf[4];
#pragma unroll
            for (int ks = 0; ks < 4; ++ks) yf[ks] = *(const bf16x8*)(Y + (ib * 16 + fr) * 136 + ks * 32 + fq * 8);
            const int irow = ib * 16 + fr; const float gi = sGc[irow], bi = sBeta[irow];
#pragma unroll
            for (int jb = 0; jb < 4; ++jb) {
                f32x4 d = {0.f, 0.f, 0.f, 0.f};
#pragma unroll
                for (int ks = 0; ks < 4; ++ks) { const bf16x8 xf = *(const bf16x8*)(KB + (jb * 16 + fr) * 136 + ks * 32 + fq * 8); d = mfma16(xf, yf[ks], d); }
                float v[4];
#pragma unroll
                for (int i = 0; i < 4; ++i) { const int j = jb * 16 + fq * 4 + i; const bool keep = m ? (j <= irow) : (j < irow); const float dec = keep ? __expf(gi - sGc[j]) : 0.f; v[i] = d[i] * dec * (m ? 1.0f : bi); }
                if (m == 0) { f32x4 o = {v[0], v[1], v[2], v[3]}; *(f32x4*)(Amat + irow * 64 + jb * 16 + fq * 4) = o; }
                else { u32x2 o; o.x = pack2(v[0], v[1]); o.y = pack2(v[2], v[3]); *(u32x2*)(ATT + ((size_t)(h * 256 + n) * 64 + irow) * 64 + jb * 16 + fq * 4) = o; }
            }
            const float gl = sGc[63];
            { const int t = tid & 63; const float ek = __expf(gl - sGc[t]);
#pragma unroll 4
              for (int it = 0; it < 16; ++it) { const int k = (tid >> 6) + 8 * it; KET[((size_t)(h * 256 + n) * 128 + k) * 64 + t] = f2bf(R1[t * 132 + k] * ek); } }
            if (tid == 0) EGL[h * 256 + n] = __expf(gl);
        }
        __syncthreads();
        if (tid < 256) {
            const float* Amat = R0;
            const int c = tid & 127; const bool isw = tid >= 128;
            float s[64];
#pragma unroll
            for (int i = 0; i < 64; ++i) s[i] = 0.f;
#pragma unroll
            for (int i = 0; i < 64; ++i) {
                float rhs = isw ? R1[i * 132 + c] * sBeta[i] * __expf(sGc[i]) : R2[i * 132 + c] * sBeta[i];
#pragma unroll
                for (int j4 = 0; j4 < (i + 3) / 4; ++j4) { const f32x4 a = *(const f32x4*)(Amat + i * 64 + j4 * 4);
                    rhs -= a[0] * s[j4 * 4 + 0]; rhs -= a[1] * s[j4 * 4 + 1]; rhs -= a[2] * s[j4 * 4 + 2]; rhs -= a[3] * s[j4 * 4 + 3]; }
                s[i] = rhs;
                if (isw) Wb[(size_t)(tok0 + i) * 512 + h * 128 + c] = f2bf(rhs); else U[(size_t)(tok0 + i) * 512 + h * 128 + c] = rhs;
            }
        }
        __syncthreads();
    }
}

__device__ __forceinline__ void phase_gdn_scan(const Params& p, unsigned char* lds_) {
    const int tid = opaque_tid(), wave = __builtin_amdgcn_readfirstlane(tid >> 6), lane = tid & 63, fr = lane & 15, fq = lane >> 4;
    const int h = blockIdx.x & 7, slice = blockIdx.x >> 3, j0 = slice * 16;
    LAS bf16_t* ST = (LAS bf16_t*)lds_; LAS bf16_t* VN = ST + 16 * 136;
    for (int i = tid; i < 16 * 136 / 2; i += 512) ((LAS unsigned*)ST)[i] = 0u;
    const float* U = (const float*)(p.ws + G_U); const bf16_t* Wb = (const bf16_t*)(p.ws + G_W);
    const bf16_t* KET = (const bf16_t*)(p.ws + G_KET); const float* EG = (const float*)(p.ws + OFF_EGL) + h * 256;
    bf16_t* SST = (bf16_t*)(p.ws + G_SST) + (size_t)(h * 256) * 16384 + (size_t)(j0 + fr) * 128 + wave * 16 + fq * 4;
    bf16_t* VNT = (bf16_t*)(p.ws + G_VNT) + (size_t)(h * 256) * 8192 + (size_t)(j0 + fr) * 64 + (wave & 3) * 16 + fq * 4;
    { u32x2 z; z.x = 0u; z.y = 0u; *(u32x2*)(SST) = z; }
    __syncthreads();
    const bool lo = wave < 4; const int rb = wave & 3;
    const bf16_t* A1 = Wb + (size_t)(rb * 16 + fr) * 512 + h * 128 + fq * 8;
    const size_t uoff = (size_t)(rb * 16 + fq * 4) * 512 + h * 128 + j0 + fr;
    const bf16_t* KEp = KET + ((size_t)(h * 256) * 128 + wave * 16 + fr) * 64 + fq * 8;
    const float* tch; size_t tstep;
    { const int L = slice * 32 + (wave & 3) * 8 + (lane & 7);
      if (L < 128) { tch = (const float*)(Wb + (size_t)(L >> 1) * 512 + h * 128 + (L & 1) * 64); tstep = 64 * 512 / 2; }
      else         { tch = (const float*)(KET + (size_t)(h * 256) * 8192 + (L - 128) * 64); tstep = 8192 / 2; } }
#define GLD128(dst, ptr) asm volatile("global_load_dwordx4 %0, %1, off" : "=v"(dst) : "v"(ptr))
#define GLD32(dst, ptr) asm volatile("global_load_dword %0, %1, off" : "=v"(dst) : "v"(ptr))
#define GDN_LOAD(LO_, N_, a1_, ka_, uu_, eg_, td_) do { const size_t tb_ = (size_t)(N_) * 64 * 512; \
        if (LO_) { _Pragma("unroll") for (int ks = 0; ks < 4; ++ks) GLD128(a1_[ks], A1 + tb_ + ks * 32); \
                  _Pragma("unroll") for (int i = 0; i < 4; ++i) GLD32(uu_[i], U + tb_ + uoff + (size_t)i * 512); } \
        _Pragma("unroll") for (int ks = 0; ks < 2; ++ks) GLD128(ka_[ks], KEp + (size_t)(N_) * 8192 + ks * 32); \
        GLD32(eg_, EG + (N_)); \
        if (!(LO_)) { GLD32(td_, tch + (size_t)GDN_CL((N_) + 5) * tstep); } } while (0)
#define GDN_WAIT(LO_, a1_, ka_, uu_, eg_, td_) do { if (LO_) asm volatile("s_waitcnt vmcnt(33)" : "+v"(a1_[0]), "+v"(a1_[1]), "+v"(a1_[2]), "+v"(a1_[3]), "+v"(ka_[0]), "+v"(ka_[1]), \
            "+v"(uu_[0]), "+v"(uu_[1]), "+v"(uu_[2]), "+v"(uu_[3]), "+v"(eg_)); \
        else asm volatile("s_waitcnt vmcnt(12)" : "+v"(ka_[0]), "+v"(ka_[1]), "+v"(eg_), "+v"(td_)); } while (0)
#define LDS_BAR() do { asm volatile("s_waitcnt lgkmcnt(0)" ::: "memory"); __builtin_amdgcn_s_barrier(); asm volatile("" ::: "memory"); } while (0)
#define GDN_STEP(LO_, N_, a1_, ka_, uu_, eg_) do { \
        if (LO_) { bf16x8 sb[4]; \
            _Pragma("unroll") for (int ks = 0; ks < 4; ++ks) sb[ks] = *(const LAS bf16x8*)(ST + fr * 136 + ks * 32 + fq * 8); \
            f32x4 acc1 = {0.f, 0.f, 0.f, 0.f}; \
            _Pragma("unroll") for (int ks = 0; ks < 4; ++ks) acc1 = mfma16(a1_[ks], sb[ks], acc1); \
            u32x2 w; w.x = pack2(uu_[0] - acc1[0], uu_[1] - acc1[1]); w.y = pack2(uu_[2] - acc1[2], uu_[3] - acc1[3]); \
            *(LAS u32x2*)(VN + fr * 72 + rb * 16 + fq * 4) = w; *(u32x2*)(VNT + (size_t)(N_) * 8192) = w; } \
        LDS_BAR(); \
        bf16x8 vb[2]; \
        _Pragma("unroll") for (int ks = 0; ks < 2; ++ks) vb[ks] = *(const LAS bf16x8*)(VN + fr * 72 + ks * 32 + fq * 8); \
        f32x4 sacc = Sreg * eg_; \
        _Pragma("unroll") for (int ks = 0; ks < 2; ++ks) sacc = mfma16(ka_[ks], vb[ks], sacc); \
        Sreg = sacc; \
        { u32x2 w; w.x = pack2(Sreg[0], Sreg[1]); w.y = pack2(Sreg[2], Sreg[3]); *(LAS u32x2*)(ST + fr * 136 + wave * 16 + fq * 4) = w; \
          if ((N_) + 1 < NCH) *(u32x2*)(SST + (size_t)((N_) + 1) * 16384) = w; } \
        LDS_BAR(); } while (0)
#define GDN_CL(x) ((x) < NCH ? (x) : NCH - 1)
#define GDN_RUN(LO_) do { \
    f32x4 Sreg = {0.f, 0.f, 0.f, 0.f}; \
    bf16x8 a1[4], ka[2]; float uu[4]; float eg; float td = 0.f, tdb = 0.f, tdc = 0.f, tdd = 0.f; \
    bf16x8 a1b[4], kab[2]; float uub[4]; float egb; \
    bf16x8 a1c[4], kac[2]; float uuc[4]; float egc; \
    bf16x8 a1d[4], kad[2]; float uud[4]; float egd; \
    GDN_LOAD(LO_, 0, a1, ka, uu, eg, td); GDN_LOAD(LO_, 1, a1b, kab, uub, egb, tdb); GDN_LOAD(LO_, 2, a1c, kac, uuc, egc, tdc); \
    _Pragma("unroll 1") for (int n = 0; n < NCH; n += 4) { \
        GDN_LOAD(LO_, GDN_CL(n + 3), a1d, kad, uud, egd, tdd); \
        GDN_WAIT(LO_, a1, ka, uu, eg, td); \
        GDN_STEP(LO_, n, a1, ka, uu, eg); \
        GDN_LOAD(LO_, GDN_CL(n + 4), a1, ka, uu, eg, td); \
        GDN_WAIT(LO_, a1b, kab, uub, egb, tdb); \
        GDN_STEP(LO_, n + 1, a1b, kab, uub, egb); \
        GDN_LOAD(LO_, GDN_CL(n + 5), a1b, kab, uub, egb, tdb); \
        GDN_WAIT(LO_, a1c, kac, uuc, egc, tdc); \
        GDN_STEP(LO_, n + 2, a1c, kac, uuc, egc); \
        GDN_LOAD(LO_, GDN_CL(n + 6), a1c, kac, uuc, egc, tdc); \
        GDN_WAIT(LO_, a1d, kad, uud, egd, tdd); \
        GDN_STEP(LO_, n + 3, a1d, kad, uud, egd); \
    } \
    asm volatile("s_waitcnt vmcnt(0)" ::: "memory"); } while (0)
    if (lo) GDN_RUN(true); else GDN_RUN(false);
#undef GDN_RUN
#undef GDN_CL
#undef GDN_STEP
#undef GDN_LOAD
#undef GDN_WAIT
#undef GLD128
#undef GLD32
}

__device__ __forceinline__ void phase_gdn_out(const Params& p, int e, unsigned char* lds) {
    const int tid = opaque_tid(), wave = tid >> 6, lane = tid & 63, fr = lane & 15, fq = lane >> 4;
    float* sPart = (float*)lds;
    const bf16_t* QS = (const bf16_t*)(p.ws + G_QS); const bf16_t* ATT = (const bf16_t*)(p.ws + G_ATT);
    const bf16_t* SST = (const bf16_t*)(p.ws + G_SST); const bf16_t* VNT = (const bf16_t*)(p.ws + G_VNT);
    const bf16_t* P = (const bf16_t*)(p.ws + OFF_BIG); bf16_t* O = (bf16_t*)(p.ws + OFF_HY);
    const float* gg = p.gdn_norm_g + e * 128;
    const int rb = wave & 3, chh = wave >> 2;
    for (int item = blockIdx.x; item < 1024; item += gridDim.x) {
        const int h = item & 3, n = item >> 2, tok = n * 64 + rb * 16 + fr;
        bf16x8 qa[4], aa[2];
#pragma unroll
        for (int ks = 0; ks < 4; ++ks) qa[ks] = *(const bf16x8*)(QS + (size_t)tok * 512 + h * 128 + ks * 32 + fq * 8);
#pragma unroll
        for (int ks = 0; ks < 2; ++ks) aa[ks] = *(const bf16x8*)(ATT + ((size_t)(h * 256 + n) * 64 + rb * 16 + fr) * 64 + ks * 32 + fq * 8);
        bf16x8 sbf[4][4], vbf[4][2]; u32x2 zwf[4];
#pragma unroll
        for (int jb = 0; jb < 4; ++jb) { const int j = chh * 64 + jb * 16 + fr;
#pragma unroll
            for (int ks = 0; ks < 4; ++ks) sbf[jb][ks] = *(const bf16x8*)(SST + ((size_t)(h * 256 + n) * 128 + j) * 128 + ks * 32 + fq * 8);
#pragma unroll
            for (int ks = 0; ks < 2; ++ks) vbf[jb][ks] = *(const bf16x8*)(VNT + ((size_t)(h * 256 + n) * 128 + j) * 64 + ks * 32 + fq * 8);
            zwf[jb] = *(const u32x2*)(P + (size_t)tok * EV_N + 1536 + h * 128 + chh * 64 + jb * 16 + fq * 4); }
        f32x4 o[4]; float sq = 0.f;
#pragma unroll
        for (int jb = 0; jb < 4; ++jb) {
            f32x4 d = {0.f, 0.f, 0.f, 0.f};
#pragma unroll
            for (int ks = 0; ks < 4; ++ks) d = mfma16(sbf[jb][ks], qa[ks], d);
#pragma unroll
            for (int ks = 0; ks < 2; ++ks) d = mfma16(vbf[jb][ks], aa[ks], d);
            o[jb] = d;
            sq += d[0] * d[0] + d[1] * d[1] + d[2] * d[2] + d[3] * d[3];
        }
        sq += __shfl_xor(sq, 16); sq += __shfl_xor(sq, 32);
        if (fq == 0) sPart[chh * 64 + rb * 16 + fr] = sq;
        __syncthreads();
        const float rs = rsqrtf((sPart[rb * 16 + fr] + sPart[64 + rb * 16 + fr]) * (1.0f / 128.0f) + 1e-6f);
#pragma unroll
        for (int jb = 0; jb < 4; ++jb) { const int c0 = chh * 64 + jb * 16 + fq * 4;
            const u32x2 zw = zwf[jb];
            const float zz[4] = {bf2f((bf16_t)(zw.x & 0xffff)), bf2f((bf16_t)(zw.x >> 16)), bf2f((bf16_t)(zw.y & 0xffff)), bf2f((bf16_t)(zw.y >> 16))};
            const f32x4 g4 = *(const f32x4*)(gg + c0);
            u32x2 w; w.x = pack2(o[jb][0] * rs * g4[0] * silu_f(zz[0]), o[jb][1] * rs * g4[1] * silu_f(zz[1])); w.y = pack2(o[jb][2] * rs * g4[2] * silu_f(zz[2]), o[jb][3] * rs * g4[3] * silu_f(zz[3]));
            *(u32x2*)(O + (size_t)tok * 1024 + h * 128 + c0) = w; }
        __syncthreads();
    }
}

__device__ __forceinline__ void phase_attn(const Params& p, unsigned char* lds_) {
    const int tid = opaque_tid(), wave = __builtin_amdgcn_readfirstlane(tid >> 6), lane = tid & 63, fr = lane & 15, fq = lane >> 4;
    LAS unsigned char* lds = (LAS unsigned char*)lds_;
    const bf16_t* Qb = (const bf16_t*)(p.ws + M_Q); const bf16_t* KN = (const bf16_t*)(p.ws + M_KN); const bf16_t* VT = (const bf16_t*)(p.ws + M_VT); const bf16_t* KPE = (const bf16_t*)(p.ws + M_KPE);
    bf16_t* O = (bf16_t*)(p.ws + OFF_HY);
    const float C = 0.07216878364870323f * 1.4426950408889634f;
    const int sw = (fr >> 1) & 7;
    const int kbn = fr * 256 + ((fq ^ fr) << 4);
    const int kbp = 16384 + fr * 128 + ((fq ^ sw) << 4);
    const int vb0 = fr * 128 + (((fq >> 1) ^ sw) << 4) + (fq & 1) * 8;
    for (int u = blockIdx.x; u < 256; u += gridDim.x) {
        const int h = u & 3, x = u >> 2;
        const int blk = (wave < 4) ? x : 127 - x;
        const int rowbase = blk * 128 + (wave & 3) * 32;
        const int cw = rowbase >> 6;
        const int ktmax = 2 * (127 - x) + 1;
        unsigned okn[2], okp, ov[2];
#pragma unroll
        for (int j = 0; j < 2; ++j) { const int key = (wave * 2 + j) * 4 + (lane >> 4); okn[j] = (unsigned)(key * 512 + h * 128 + (((lane & 15) ^ (key & 15)) << 3)); }
        { const int key = wave * 8 + (lane >> 3); okp = (unsigned)(key * 64 + (((lane & 7) ^ ((key >> 1) & 7)) << 3)); }
#pragma unroll
        for (int j = 0; j < 2; ++j) { const int d = (wave * 2 + j) * 8 + (lane >> 3); ov[j] = (unsigned)((h * 128 + d) * SEQ + (((lane & 7) ^ ((d >> 1) & 7)) << 3)); }
        { LAS unsigned* po = (LAS unsigned*)(lds + 122880) + tid; po[0] = okn[0]; po[512] = okn[1]; po[1024] = okp; po[1536] = ov[0]; po[2048] = ov[1]; }
#define ATT_DMA(KT_) do { const int kc_ = (KT_) <= ktmax ? (KT_) : ktmax; LAS unsigned char* b_ = lds + ((KT_) % 3) * 40960; \
        int tq_ = tid; asm volatile("" : "+v"(tq_)); const LAS unsigned* po_ = (const LAS unsigned*)(lds + 122880) + tq_; unsigned okn[2], okp, ov[2]; okn[0] = po_[0]; okn[1] = po_[512]; okp = po_[1024]; ov[0] = po_[1536]; ov[1] = po_[2048]; const bf16_t* kn_ = KN + (size_t)kc_ * 64 * 512; const bf16_t* kq_ = KPE + (size_t)kc_ * 64 * 64; const bf16_t* vt_ = VT + (size_t)kc_ * 64; \
        _Pragma("unroll") for (int j = 0; j < 2; ++j) __builtin_amdgcn_global_load_lds((const unsigned*)(kn_ + okn[j]), (LAS unsigned*)(b_ + (wave * 2 + j) * 1024), 16, 0, 0); \
        __builtin_amdgcn_global_load_lds((const unsigned*)(kq_ + okp), (LAS unsigned*)(b_ + 16384 + wave * 1024), 16, 0, 0); \
        _Pragma("unroll") for (int j = 0; j < 2; ++j) __builtin_amdgcn_global_load_lds((const unsigned*)(vt_ + ov[j]), (LAS unsigned*)(b_ + 24576 + (wave * 2 + j) * 1024), 16, 0, 0); } while (0)
        ATT_DMA(0); ATT_DMA(1);
        bf16x8 qf[2][6];
#pragma unroll
        for (int qs = 0; qs < 2; ++qs) {
            const int row = rowbase + qs * 16 + fr; const bf16_t* qp = Qb + (size_t)row * 768 + h * 192 + fq * 8;
#pragma unroll
            for (int ks = 0; ks < 6; ++ks) qf[qs][ks] = *(const bf16x8*)(qp + ks * 32);
            const int pos = p.pos[row];
#pragma unroll
            for (int i = 0; i < 8; ++i) { float c, s; rope_cs(pos, fq * 8 + i, c, s); const float x1 = bf2f((bf16_t)qf[qs][4][i]), x2 = bf2f((bf16_t)qf[qs][5][i]);
                qf[qs][4][i] = (short)f2bf((x1 * c - x2 * s) * C); qf[qs][5][i] = (short)f2bf((x2 * c + x1 * s) * C); }
#pragma unroll
            for (int ks = 0; ks < 4; ++ks)
#pragma unroll
                for (int i = 0; i < 8; ++i) qf[qs][ks][i] = (short)f2bf(bf2f((bf16_t)qf[qs][ks][i]) * C);
        }
        f32x4 acc[2][8];
#pragma unroll
        for (int qs = 0; qs < 2; ++qs)
#pragma unroll
            for (int db = 0; db < 8; ++db) acc[qs][db] = (f32x4){0.f, 0.f, 0.f, 0.f};
        float mrun[2] = {-1e30f, -1e30f}, lrun[2] = {0.f, 0.f};
#pragma unroll 1
        for (int kt = 0; kt <= ktmax; ++kt) {
            asm volatile("s_waitcnt vmcnt(5) lgkmcnt(0)" ::: "memory");
            __builtin_amdgcn_s_barrier();
            asm volatile("" ::: "memory");
            ATT_DMA(kt + 2);
            if (kt <= cw) {
                LAS unsigned char* Kt = lds + (kt % 3) * 40960; LAS unsigned char* Vt = Kt + 24576;
                f32x4 st[2][4];
                const f32x4 zero4 = {0.f, 0.f, 0.f, 0.f};
#define ATT_KF(ks_, nb_) (((ks_) < 4) ? *(const LAS bf16x8*)(Kt + (kbn ^ ((ks_) << 6)) + (nb_) * 4096) : *(const LAS bf16x8*)(Kt + (kbp ^ (((ks_) - 4) << 6)) + (nb_) * 2048))
                bf16x8 kf[3][2];
#pragma unroll
                for (int hs = 0; hs < 2; ++hs)
#pragma unroll
                    for (int j = 0; j < 2; ++j) kf[hs][j] = ATT_KF(hs >> 1, (hs & 1) * 2 + j);
#pragma unroll
                for (int hs = 0; hs < 12; ++hs) {
                    const int ks = hs >> 1, nb0 = (hs & 1) * 2;
                    if (hs + 2 < 12) {
#pragma unroll
                        for (int j = 0; j < 2; ++j) kf[(hs + 2) % 3][j] = ATT_KF((hs + 2) >> 1, ((hs + 2) & 1) * 2 + j); }
                    __builtin_amdgcn_sched_barrier(0);
#pragma unroll
                    for (int j = 0; j < 2; ++j) { st[0][nb0 + j] = mfma16(kf[hs % 3][j], qf[0][ks], ks == 0 ? zero4 : st[0][nb0 + j]); st[1][nb0 + j] = mfma16(kf[hs % 3][j], qf[1][ks], ks == 0 ? zero4 : st[1][nb0 + j]); }
                    __builtin_amdgcn_sched_barrier(0);
                }
#undef ATT_KF
                bf16x8 bp[2][2];
#pragma unroll
                for (int qs = 0; qs < 2; ++qs) {
                    float mx = -1e30f;
#pragma unroll
                    for (int nb = 0; nb < 4; ++nb)
#pragma unroll
                        for (int i = 0; i < 4; ++i) mx = fmaxf(mx, st[qs][nb][i]);
                    mx = fmaxf(mx, __shfl_xor(mx, 16)); mx = fmaxf(mx, __shfl_xor(mx, 32));
                    const float mnew = fmaxf(mrun[qs], mx); const float alpha = __builtin_amdgcn_exp2f(mrun[qs] - mnew); mrun[qs] = mnew;
                    float ps = 0.f;
#pragma unroll
                    for (int nb = 0; nb < 4; ++nb)
#pragma unroll
                        for (int i = 0; i < 4; ++i) { const float pv = __builtin_amdgcn_exp2f(st[qs][nb][i] - mnew); ps += pv; st[qs][nb][i] = pv; }
                    lrun[qs] = lrun[qs] * alpha + ps;
                    if (__builtin_amdgcn_ballot_w64(alpha != 1.0f) != 0ull) {
#pragma unroll
                        for (int db = 0; db < 8; ++db) acc[qs][db] *= alpha; }
#pragma unroll
                    for (int kk = 0; kk < 2; ++kk) { u32x4 w; w.x = pack2(st[qs][2 * kk][0], st[qs][2 * kk][1]); w.y = pack2(st[qs][2 * kk][2], st[qs][2 * kk][3]);
                        w.z = pack2(st[qs][2 * kk + 1][0], st[qs][2 * kk + 1][1]); w.w = pack2(st[qs][2 * kk + 1][2], st[qs][2 * kk + 1][3]); bp[qs][kk] = __builtin_bit_cast(bf16x8, w); }
                }
#define ATT_VLO(s_) (*(const LAS u32x2*)(Vt + (vb0 ^ ((((s_) >> 3) * 4) << 4)) + ((s_) & 7) * 2048))
#define ATT_VHI(s_) (*(const LAS u32x2*)(Vt + (vb0 ^ ((((s_) >> 3) * 4 + 2) << 4)) + ((s_) & 7) * 2048))
                u32x2 vlo[3], vhi[3];
#pragma unroll
                for (int s = 0; s < 2; ++s) { vlo[s] = ATT_VLO(s); vhi[s] = ATT_VHI(s); }
#pragma unroll
                for (int s = 0; s < 16; ++s) {
                    const int kk = s >> 3, db = s & 7;
                    if (s + 2 < 16) { vlo[(s + 2) % 3] = ATT_VLO(s + 2); vhi[(s + 2) % 3] = ATT_VHI(s + 2); }
                    __builtin_amdgcn_sched_barrier(0);
                    u32x4 w; w.x = vlo[s % 3].x; w.y = vlo[s % 3].y; w.z = vhi[s % 3].x; w.w = vhi[s % 3].y; const bf16x8 a = __builtin_bit_cast(bf16x8, w);
                    acc[0][db] = mfma16(a, bp[0][kk], acc[0][db]); acc[1][db] = mfma16(a, bp[1][kk], acc[1][db]);
                    __builtin_amdgcn_sched_barrier(0);
                }
#undef ATT_VLO
#undef ATT_VHI
            }
        }
#undef ATT_DMA
        asm volatile("s_waitcnt vmcnt(0)" ::: "memory");
#pragma unroll
        for (int qs = 0; qs < 2; ++qs) {
            float l = lrun[qs]; l += __shfl_xor(l, 16); l += __shfl_xor(l, 32); const float inv = 1.0f / l;
            bf16_t* op = O + (size_t)(rowbase + qs * 16 + fr) * 1024 + 512 + h * 128 + fq * 4;
#pragma unroll
            for (int db = 0; db < 8; ++db) { u32x2 w; w.x = pack2(acc[qs][db][0] * inv, acc[qs][db][1] * inv); w.y = pack2(acc[qs][db][2] * inv, acc[qs][db][3] * inv); *(u32x2*)(op + db * 16) = w; }
        }
        __syncthreads();
    }
}

__device__ __forceinline__ void mixer_even(int e, int l, const XcdBarrier& xbar, unsigned char* lds) {
#define LP() const Params p = lds_params(lds)
    _Pragma("unroll 1") for (int rep = 0; rep < (PROBE == 14 ? 2 : 1); ++rep) { LP(); phase_mla_prep(p, e); }
_Pragma("unroll 1") for (int rep = 0; rep < (PROBE == 4 ? 2 : 1); ++rep) { LP(); phase_gdn_intra(p, e, lds); }
    GSYNC();
    if (blockIdx.x < 64 && (blockIdx.x & 7) < 4) { _Pragma("unroll 1") for (int rep = 0; rep < (PROBE == 2 ? 2 : 1); ++rep) { LP(); phase_gdn_scan(p, lds); } }
    else {
        const int Gp = gridDim.x - 32, c = (blockIdx.x < 64) ? (int)(blockIdx.x >> 3) * 4 + (int)(blockIdx.x & 7) - 4 : (int)blockIdx.x - 32;
#pragma unroll 1
        for (int j = 0; j < 3; ++j) {
            LP();
            const bf16_t* CQN = (const bf16_t*)(p.ws + M_CQN); const bf16_t* CKVN = (const bf16_t*)(p.ws + M_CKVN);
            const bf16_t* wuq = (const bf16_t*)(p.ws + W_MIX) + 2816 * 1024 + 1024 * 1024; const bf16_t* wukv = wuq + 768 * 384;
            pg8::Gemm g; bf16_t* Op; int ldc, off;
            if (j == 0) { g = pg8::Gemm{CQN, wuq, SEQ, 768, 384}; Op = (bf16_t*)(p.ws + M_Q); ldc = 768; off = 0; }
            else if (j == 1) { g = pg8::Gemm{CKVN, wukv, SEQ, 512, 256}; Op = (bf16_t*)(p.ws + M_KN); ldc = 512; off = 192 % Gp; }
            else { g = pg8::Gemm{wukv + 512 * 256, CKVN, 512, SEQ, 256}; Op = (bf16_t*)(p.ws + M_VT); ldc = SEQ; off = 320 % Gp; }
            pg8::StaticOrder S; S.init(g.M, g.N, Gp, (c + Gp - off) % Gp); pg8::EpiBf16Plain E{Op, ldc};
            pg8::gemm_phase<pg8::EpiBf16Plain, pg8::StaticOrder, false>((LAS unsigned char*)lds, g, S, E, nullptr);
        }
        { LP(); phase_convert(p, l + 1, (float*)lds, c, Gp); }
        if (l == 0) { LP(); phase_ada(p, (float*)lds, 144, 576, c, Gp); }
    }
    GSYNC();
    _Pragma("unroll 1") for (int rep = 0; rep < (PROBE == 15 ? 2 : 1); ++rep) { LP(); phase_gdn_out(p, e, lds); }
_Pragma("unroll 1") for (int rep = 0; rep < (PROBE == 1 ? 2 : 1); ++rep) { LP(); phase_attn(p, lds); }
    GSYNC();
#undef LP
}

#define SSD_CONV(P_, tok0_, cc_, cwt_, cb_, BODY) do { \
        const float w0_ = (cwt_)[cc_], w1_ = (cwt_)[3072 + (cc_)], w2_ = (cwt_)[6144 + (cc_)], w3_ = (cwt_)[9216 + (cc_)], b_ = (cb_)[cc_]; \
        const bf16_t* src_ = (P_) + (size_t)(tok0_) * OD_N + 2048 + (cc_); \
        float x0_ = 0.f, x1_ = 0.f, x2_ = 0.f; \
        if ((tok0_) > 0) { x0_ = bf2f(src_[-3 * OD_N]); x1_ = bf2f(src_[-2 * OD_N]); x2_ = bf2f(src_[-1 * OD_N]); } \
        _Pragma("unroll") for (int t = 0; t < 64; ++t) { const float x3_ = bf2f(src_[(size_t)t * OD_N]); const float y = silu_f(b_ + w0_ * x0_ + w1_ * x1_ + w2_ * x2_ + w3_ * x3_); BODY; x0_ = x1_; x1_ = x2_; x2_ = x3_; } } while (0)

__device__ __forceinline__ void phase_ssd_states(const Params& p, int o, unsigned char* lds) {
    const int tid = opaque_tid(), wave = tid >> 6, lane = tid & 63, fr = lane & 15, fq = lane >> 4;
    bf16_t* XTS = (bf16_t*)lds; bf16_t* BT = (bf16_t*)(lds + 73728); float* sSc = (float*)(lds + 73728 + 18432);
    const bf16_t* P = (const bf16_t*)(p.ws + OFF_BIG);
    bf16_t* STt = (bf16_t*)(p.ws + OFF_MIX); float* CD = (float*)(p.ws + OFF_CD);
    const float* cwt = p.ssd_conv_w + (size_t)o * 4 * 3072; const float* cb = p.ssd_conv_b + (size_t)o * 3072;
    for (int item = blockIdx.x; item < 1024; item += gridDim.x) {
        const int g = item & 3, n = item >> 2, tok0 = n * 64;
        { const int hh = g * 8 + wave; const float raw = bf2f(P[(size_t)(tok0 + lane) * OD_N + 5120 + hh]); const float dt = softplus_f(raw + p.ssd_dt_bias[o * 32 + hh]);
          const float da = -expf(p.ssd_A_log[o * 32 + hh]) * dt; const float acs = wave_incl_scan(da, lane); const float last = __shfl(acs, 63);
          sSc[wave * 64 + lane] = dt * __expf(last - acs); if (lane == 63) CD[n * 32 + hh] = __expf(acs); }
        __syncthreads();
        if (tid < 256) { const int ch = tid * 2, cc = g * 512 + ch; const float* sc = sSc + (ch >> 6) * 64; bf16_t* dst = XTS + ch * 72;
          CONV_PAIR(P, OD_N, 2048 + cc, tok0, cwt, 3072, cc, cb[cc], cb[cc + 1], { dst[t] = f2bf(y0 * sc[t]); dst[72 + t] = f2bf(y1 * sc[t]); }); }
        else if (tid < 320) { const int ch = (tid - 256) * 2, cc = 2048 + g * 128 + ch; bf16_t* dst = BT + ch * 72;
          CONV_PAIR(P, OD_N, 2048 + cc, tok0, cwt, 3072, cc, cb[cc], cb[cc + 1], { dst[t] = f2bf(y0); dst[72 + t] = f2bf(y1); }); }
        __syncthreads();
        { const int hh = g * 8 + wave;
#pragma unroll 1
          for (int pb = 0; pb < 4; ++pb) {
              bf16x8 xf[2];
#pragma unroll
              for (int ks = 0; ks < 2; ++ks) xf[ks] = *(const bf16x8*)(XTS + (wave * 64 + pb * 16 + fr) * 72 + ks * 32 + fq * 8);
#pragma unroll
              for (int nb = 0; nb < 8; ++nb) { f32x4 d = {0.f, 0.f, 0.f, 0.f};
#pragma unroll
                  for (int ks = 0; ks < 2; ++ks) { const bf16x8 bf = *(const bf16x8*)(BT + (nb * 16 + fr) * 72 + ks * 32 + fq * 8); d = mfma16(bf, xf[ks], d); }
                  u32x2 w; w.x = pack2(d[0], d[1]); w.y = pack2(d[2], d[3]);
                  *(u32x2*)(STt + (((size_t)n * 32 + hh) * 64 + pb * 16 + fr) * 128 + nb * 16 + fq * 4) = w; } } }
        __syncthreads();
    }
}

__device__ __forceinline__ void phase_ssd_scan(const Params& p) {
    unsigned* ST = (unsigned*)(p.ws + OFF_MIX); const float* CD = (const float*)(p.ws + OFF_CD);
    for (size_t e2 = (size_t)blockIdx.x * 512 + opaque_tid(); e2 < 131072; e2 += (size_t)gridDim.x * 512) {
        const int hh = (int)(e2 >> 12); unsigned* ptr = ST + e2; float h0 = 0.f, h1 = 0.f;
#pragma unroll 1
        for (int c0 = 0; c0 < NCH; c0 += 32) {
            unsigned w[32]; float cd[32];
#pragma unroll
            for (int j = 0; j < 32; ++j) { w[j] = ptr[(size_t)(c0 + j) * 131072]; cd[j] = CD[(c0 + j) * 32 + hh]; }
            __builtin_amdgcn_sched_barrier(0);
#pragma unroll
            for (int j = 0; j < 32; ++j) { ptr[(size_t)(c0 + j) * 131072] = pack2(h0, h1); h0 = h0 * cd[j] + bf2f((bf16_t)(w[j] & 0xffff)); h1 = h1 * cd[j] + bf2f((bf16_t)(w[j] >> 16)); }
        }
    }
}

__device__ __forceinline__ void phase_ssd_out(const Params& p, int o, unsigned char* lds) {
    const int tid = opaque_tid(), wave = tid >> 6, lane = tid & 63, fr = lane & 15, fq = lane >> 4;
    bf16_t* Cs = (bf16_t*)lds; bf16_t* Bs = (bf16_t*)(lds + 17408); float* CBm = (float*)(lds + 34816); bf16_t* XT = (bf16_t*)(lds + 52224);
    float* sDt = (float*)(lds + 125952); float* sAcs = sDt + 512; float* sSum = sAcs + 512;
    const bf16_t* P = (const bf16_t*)(p.ws + OFF_BIG); const bf16_t* HS = (const bf16_t*)(p.ws + OFF_MIX); bf16_t* Y = (bf16_t*)(p.ws + OFF_HY);
    const float* cwt = p.ssd_conv_w + (size_t)o * 4 * 3072; const float* cb = p.ssd_conv_b + (size_t)o * 3072;
    for (int item = blockIdx.x; item < 1024; item += gridDim.x) {
        const int g = item & 3, n = item >> 2, tok0 = n * 64;
        const int hh = g * 8 + wave;
        { const float raw = bf2f(P[(size_t)(tok0 + lane) * OD_N + 5120 + hh]); const float dt = softplus_f(raw + p.ssd_dt_bias[o * 32 + hh]);
          const float da = -expf(p.ssd_A_log[o * 32 + hh]) * dt; const float acs = wave_incl_scan(da, lane);
          sDt[wave * 64 + lane] = dt; sAcs[wave * 64 + lane] = acs; if (tid < 64) sSum[tid] = 0.f; }
        _Pragma("unroll 1") for (int rep = 0; rep < (PROBE == 10 ? 2 : 1); ++rep) {
        if (tid < 256) { const int ch = tid * 2, cc = g * 512 + ch; bf16_t* dst = XT + ch * 72;
          CONV_PAIR(P, OD_N, 2048 + cc, tok0, cwt, 3072, cc, cb[cc], cb[cc + 1], { dst[t] = f2bf(y0); dst[72 + t] = f2bf(y1); }); }
        else if (tid < 384) { const int idx = tid - 256; const bool isc = idx >= 64; const int ch = (idx & 63) * 2, cc = 2048 + (isc ? 512 : 0) + g * 128 + ch; bf16_t* dst = (isc ? Cs : Bs) + ch;
          CONV_PAIR(P, OD_N, 2048 + cc, tok0, cwt, 3072, cc, cb[cc], cb[cc + 1], { *(unsigned*)(dst + t * 136) = pack2(y0, y1); }); }
        }
        __syncthreads();
        for (int tI = wave * 2; tI < wave * 2 + 2; ++tI) { const int lb = tI >> 2, sb = tI & 3; f32x4 d = {0.f, 0.f, 0.f, 0.f};
#pragma unroll
            for (int ks = 0; ks < 4; ++ks) { const bf16x8 xb = *(const bf16x8*)(Bs + (sb * 16 + fr) * 136 + ks * 32 + fq * 8), yb = *(const bf16x8*)(Cs + (lb * 16 + fr) * 136 + ks * 32 + fq * 8); d = mfma16(xb, yb, d); }
            *(f32x4*)(CBm + (lb * 16 + fr) * 68 + sb * 16 + fq * 4) = d; }
        __syncthreads();
        _Pragma("unroll 1") for (int rep = 0; rep < (PROBE == 12 ? 2 : 1); ++rep) {
        const float* dts = sDt + wave * 64; const float* acss = sAcs + wave * 64; const float Dh = p.ssd_D[o * 32 + hh];
        bf16x8 hb[4][4];
#pragma unroll
        for (int pb = 0; pb < 4; ++pb)
#pragma unroll
            for (int ks = 0; ks < 4; ++ks) hb[pb][ks] = *(const bf16x8*)(HS + (((size_t)n * 32 + hh) * 64 + pb * 16 + fr) * 128 + ks * 32 + fq * 8);
        u32x2 zwf[4][4];
#pragma unroll
        for (int lb = 0; lb < 4; ++lb)
#pragma unroll
            for (int pb = 0; pb < 4; ++pb) zwf[lb][pb] = *(const u32x2*)(P + (size_t)(tok0 + lb * 16 + fr) * OD_N + hh * 64 + pb * 16 + fq * 4);
#pragma unroll
        for (int lb = 0; lb < 4; ++lb) {
            const int l = lb * 16 + fr; const float al = acss[l]; const float eal = __expf(al);
            bf16x8 ga[2], ca[4];
#pragma unroll
            for (int ks = 0; ks < 2; ++ks) { float gv[8];
#pragma unroll
                for (int i = 0; i < 8; ++i) { const int s = ks * 32 + fq * 8 + i; gv[i] = (s <= l) ? CBm[l * 68 + s] * __expf(al - acss[s]) * dts[s] : 0.f; }
                u32x4 w; w.x = pack2(gv[0], gv[1]); w.y = pack2(gv[2], gv[3]); w.z = pack2(gv[4], gv[5]); w.w = pack2(gv[6], gv[7]); ga[ks] = __builtin_bit_cast(bf16x8, w); }
#pragma unroll
            for (int ks = 0; ks < 4; ++ks) ca[ks] = *(const bf16x8*)(Cs + l * 136 + ks * 32 + fq * 8);
            float sq = 0.f;
#pragma unroll
            for (int pb = 0; pb < 4; ++pb) {
                f32x4 yd = {0.f, 0.f, 0.f, 0.f}, yo = {0.f, 0.f, 0.f, 0.f};
#pragma unroll
                for (int ks = 0; ks < 2; ++ks) { const bf16x8 xb = *(const bf16x8*)(XT + (wave * 64 + pb * 16 + fr) * 72 + ks * 32 + fq * 8); yd = mfma16(xb, ga[ks], yd); }
#pragma unroll
                for (int ks = 0; ks < 4; ++ks) yo = mfma16(hb[pb][ks], ca[ks], yo);
                const u32x2 zw = zwf[lb][pb];
                const float zz[4] = {bf2f((bf16_t)(zw.x & 0xffff)), bf2f((bf16_t)(zw.x >> 16)), bf2f((bf16_t)(zw.y & 0xffff)), bf2f((bf16_t)(zw.y >> 16))};
                float v[4];
#pragma unroll
                for (int i = 0; i < 4; ++i) { const float xv = bf2f(XT[(wave * 64 + pb * 16 + fq * 4 + i) * 72 + l]); v[i] = (yd[i] + eal * yo[i] + Dh * xv) * silu_f(zz[i]); sq += v[i] * v[i]; }
                u32x2 w; w.x = pack2(v[0], v[1]); w.y = pack2(v[2], v[3]);
                *(u32x2*)(Y + (size_t)(tok0 + l) * 2048 + hh * 64 + pb * 16 + fq * 4) = w;
            }
            sq += __shfl_xor(sq, 16); sq += __shfl_xor(sq, 32);
            if (fq == 0 && rep == (PROBE == 12 ? 1 : 0)) atomicAdd(&sSum[l], sq);
        }
        }
        __syncthreads();
        const float* ng = p.ssd_norm_g + (size_t)o * 2048 + hh * 64;
        u32x2 yr[4][4];
#pragma unroll
        for (int lb = 0; lb < 4; ++lb)
#pragma unroll
            for (int pb = 0; pb < 4; ++pb) yr[lb][pb] = *(const u32x2*)(Y + (size_t)(tok0 + lb * 16 + fr) * 2048 + hh * 64 + pb * 16 + fq * 4);
#pragma unroll
        for (int lb = 0; lb < 4; ++lb) { const int l = lb * 16 + fr; const float rs = rsqrtf(sSum[l] * (1.0f / 512.0f) + 1e-6f);
#pragma unroll
            for (int pb = 0; pb < 4; ++pb) { const f32x4 g4 = *(const f32x4*)(ng + pb * 16 + fq * 4);
                u32x2* yp = (u32x2*)(Y + (size_t)(tok0 + l) * 2048 + hh * 64 + pb * 16 + fq * 4); const u32x2 r = yr[lb][pb];
                u32x2 w; w.x = pack2(bf2f((bf16_t)(r.x & 0xffff)) * rs * g4[0], bf2f((bf16_t)(r.x >> 16)) * rs * g4[1]); w.y = pack2(bf2f((bf16_t)(r.y & 0xffff)) * rs * g4[2], bf2f((bf16_t)(r.y >> 16)) * rs * g4[3]);
                *yp = w; } }
        __syncthreads();
    }
}

__device__ __forceinline__ void mixer_odd(int o, const XcdBarrier& xbar, unsigned char* lds) {
#define LP() const Params p = lds_params(lds)
_Pragma("unroll 1") for (int rep = 0; rep < (PROBE == 6 ? 2 : 1); ++rep) { LP(); phase_ssd_states(p, o, lds); }
    GSYNC();
    { LP(); phase_ssd_scan(p); }
    GSYNC();
_Pragma("unroll 1") for (int rep = 0; rep < (PROBE == 5 ? 2 : 1); ++rep) { LP(); phase_ssd_out(p, o, lds); }
    GSYNC();
#undef LP
}

__global__ void __launch_bounds__(512) mega(Params pk) {
    extern __shared__ __attribute__((aligned(16))) unsigned char lds[];
    cg::grid_group grid = cg::this_grid();
    LAS unsigned char* l3 = (LAS unsigned char*)lds;
    float* ldsf = (float*)lds;
    const int G = gridDim.x, bid = blockIdx.x;
    if (threadIdx.x == 0) {
        unsigned long long* dst = (unsigned long long*)(lds + LDS_PARAMS_OFF);
        dst[0] = (unsigned long long)pk.x; dst[1] = (unsigned long long)pk.c; dst[2] = (unsigned long long)pk.pos;
        const float* const* fp = &pk.ada_w;
        for (int i = 0; i < 25; ++i) dst[3 + i] = (unsigned long long)fp[i];
        dst[28] = (unsigned long long)pk.out; dst[29] = (unsigned long long)pk.ws;
    }
    if (threadIdx.x == 1) { ((LAS unsigned*)l3)[147440 / 4] = 0u; ((LAS unsigned*)l3)[147444 / 4] = 0u; }
    __syncthreads();
    if (bid == 0) { unsigned* bw = (unsigned*)(pk.ws + OFF_BAR); for (int i = threadIdx.x; i < 4096; i += 512) bw[i] = 0u; }
#define LP() const Params p = lds_params(lds)
    _Pragma("unroll 1") for (int rep = 0; rep < (PROBE == 13 ? 2 : 1); ++rep) { LP(); phase_ada(p, ldsf, 0, 144, bid, G); }
    grid.sync();
    XcdBarrier xbar = xcd_barrier_post((unsigned*)(pk.ws + OFF_BAR), (volatile LAS unsigned*)(l3 + 147440));
#pragma unroll 1
    for (int l = 0; l < 4; ++l) {
        const bool even = (l & 1) == 0; const int e = l >> 1;
#pragma unroll 1
        for (int sub = 0; sub < 3; ++sub) {
            if (sub == 0 && even) { _Pragma("unroll 1") for (int rep = 0; rep < (PROBE == 7 ? 2 : 1); ++rep) { LP(); phase_convert(p, l, ldsf, bid, G); } }
            _Pragma("unroll 1") for (int rep = 0; rep < (PROBE == 8 ? 2 : 1); ++rep) { LP(); const float* ml = (const float*)(p.ws + OFF_MOD) + l * 9216 + sub * 3072;
              phase_norm((l == 0 && sub == 0) ? p.x : p.out, (bf16_t*)(p.ws + OFF_HY), p.norm_g + (l * 3 + sub) * 1024, ml, ml + 1024); }
            GSYNC();
            const bf16_t* A2; const bf16_t* B2; int K2; float coef;
            if (sub != 1) {
                _Pragma("unroll 1") for (int rep = 0; rep < (PROBE == 3 ? 2 : 1); ++rep) { LP(); const bf16_t* W13 = (const bf16_t*)(p.ws + (size_t)(l & 1) * W_REGION2 + (sub ? W_13B : W_13A));
                  pg8::Gemm g{(const bf16_t*)(p.ws + OFF_HY), W13, SEQ, 5632, 1024}; pg8::StaticOrder S; S.init(SEQ, 5632, G, bid); pg8::EpiSwiglu E{(bf16_t*)(p.ws + OFF_BIG), DFF};
                  pg8::gemm_phase<pg8::EpiSwiglu, pg8::StaticOrder, false>(l3, g, S, E, nullptr); }
                GSYNC();
                { LP(); A2 = (const bf16_t*)(p.ws + OFF_BIG); B2 = (const bf16_t*)(p.ws + (size_t)(l & 1) * W_REGION2 + (sub ? W_2B : W_2A)); } K2 = DFF; coef = 0.5f;
            } else {
                const int Nin = even ? EV_N : OD_N;
                _Pragma("unroll 1") for (int rep = 0; rep < (PROBE == 17 ? 2 : 1); ++rep) { LP(); pg8::Gemm g{(const bf16_t*)(p.ws + OFF_HY), (const bf16_t*)(p.ws + (size_t)(l & 1) * W_REGION2 + W_MIX), SEQ, Nin, 1024}; pg8::StaticOrder S; S.init(SEQ, Nin, G, bid); pg8::EpiBf16Plain E{(bf16_t*)(p.ws + OFF_BIG), Nin};
                  pg8::gemm_phase<pg8::EpiBf16Plain, pg8::StaticOrder, false>(l3, g, S, E, nullptr); }
                GSYNC();
                if (even) mixer_even(e, l, xbar, lds); else mixer_odd(e, xbar, lds);
                { LP(); A2 = (const bf16_t*)(p.ws + OFF_HY); B2 = (const bf16_t*)(p.ws + (size_t)(l & 1) * W_REGION2 + W_MIX) + (even ? 2816 * 1024 : 5376 * 1024); } K2 = even ? 1024 : 2048;
                coef = 1.0f;
            }
            { LP(); const float* ml = (const float*)(p.ws + OFF_MOD) + l * 9216 + sub * 3072;
              pg8::Gemm g{A2, B2, SEQ, 1024, K2}; pg8::StaticOrder S; S.init(SEQ, 1024, G, bid); pg8::EpiResid E{p.out, (l == 0 && sub == 0) ? p.x : p.out, ml + 2048, coef};
              pg8::gemm_phase<pg8::EpiResid, pg8::StaticOrder, false>(l3, g, S, E, nullptr); }
            GSYNC();
        }
    }
    { LP(); phase_final(p.out, p.final_g); }
}

extern "C" void kernel_launch(void* const* d_in, const int* in_sizes, int n_in, void* d_out, int out_size, void* d_ws, size_t ws_size, hipStream_t stream) {
    static int grid_blocks = 0;
    if (grid_blocks == 0) {
        int dev = 0, cus = 0, per_cu = 0;
        hipGetDevice(&dev);
        hipDeviceGetAttribute(&cus, hipDeviceAttributeMultiprocessorCount, dev);
        if (hipFuncSetAttribute((const void*)mega, hipFuncAttributeMaxDynamicSharedMemorySize, LDS_BYTES) != hipSuccess) { fprintf(stderr, "hipFuncSetAttribute failed\n"); grid_blocks = -1; return; }
        hipOccupancyMaxActiveBlocksPerMultiprocessor(&per_cu, (const void*)mega, 512, LDS_BYTES);
        (void)hipGetLastError();
        if (per_cu < 1) per_cu = 1;
        grid_blocks = cus * per_cu;
        if (ws_size < WS_NEED || n_in != 28) { fprintf(stderr, "kernel_launch: ws %zu < %zu or n_in %d\n", ws_size, (size_t)WS_NEED, n_in); grid_blocks = -1; return; }
    }
    if (grid_blocks < 0) return;
    Params p{};
    p.x = (const float*)d_in[0]; p.c = (const float*)d_in[1]; p.pos = (const int*)d_in[2];
    const float** fp = &p.ada_w;
    for (int i = 0; i < 25; ++i) fp[i] = (const float*)d_in[3 + i];
    p.out = (float*)d_out; p.ws = (unsigned char*)d_ws;
    void* args[] = {&p};
    hipError_t e = hipLaunchCooperativeKernel((const void*)mega, dim3(grid_blocks), dim3(512), args, LDS_BYTES, stream);
    if (e != hipSuccess) fprintf(stderr, "cooperative launch failed: %s (grid %d)\n", hipGetErrorString(e), grid_blocks);
}
```

```cpp
#include <hip/hip_runtime.h>
#include <hip/hip_cooperative_groups.h>
#include <cstdio>
namespace cg = cooperative_groups;

#define LAS __attribute__((address_space(3)))
typedef unsigned short bf16_t;
typedef short bf16x8 __attribute__((ext_vector_type(8)));
typedef float f32x4 __attribute__((ext_vector_type(4)));
typedef unsigned u32x4 __attribute__((ext_vector_type(4)));
typedef unsigned u32x2 __attribute__((ext_vector_type(2)));

constexpr int PROBE = 0;
constexpr int SEQ = 16384, DM = 1024, DFF = 2816, NCH = 256;
constexpr int EV_N = 2816, OD_N = 5376;
constexpr int LDS_BYTES = 147456;
constexpr size_t MiB = 1048576;
constexpr size_t OFF_MOD = 0;
constexpr size_t OFF_EGL = 256 * 1024;
constexpr size_t OFF_CD  = 320 * 1024;
constexpr size_t OFF_W   = 1 * MiB;
constexpr size_t W_13A = OFF_W, W_13B = W_13A + 11534336, W_2A = W_13B + 11534336, W_2B = W_2A + 5767168, W_MIX = W_2B + 5767168;
constexpr size_t OFF_HY  = 53 * MiB;
constexpr size_t OFF_BIG = 117 * MiB;
constexpr size_t OFF_MLA = OFF_BIG + 88 * MiB;
constexpr size_t M_CQN = OFF_MLA, M_CKVN = M_CQN + 12 * MiB, M_KPE = M_CKVN + 8 * MiB, M_Q = M_KPE + 2 * MiB, M_KN = M_Q + 24 * MiB, M_VT = M_KN + 16 * MiB;
constexpr size_t OFF_MIX = 285 * MiB;
constexpr size_t G_U = OFF_MIX, G_W = G_U + 32 * MiB, G_QS = G_W + 16 * MiB, G_KET = G_QS + 16 * MiB, G_ATT = G_KET + 16 * MiB, G_ORAW = G_ATT + 8 * MiB;
constexpr size_t G_SST = G_ORAW, G_VNT = G_SST + 32 * MiB;
constexpr size_t W_REGION2 = 420 * MiB;
constexpr size_t WS_NEED = 473 * MiB;

struct Params {
    const float* x; const float* c; const int* pos;
    const float *ada_w, *ada_b, *norm_g, *w1, *w3, *w2, *ev_w_in, *gdn_conv_w, *gdn_A_log, *gdn_dt_bias, *gdn_norm_g,
        *mla_q_norm_g, *mla_w_uq, *mla_kv_norm_g, *mla_w_ukv, *ev_w_out, *ssd_w_in, *ssd_conv_w, *ssd_conv_b, *ssd_A_log, *ssd_dt_bias,
        *ssd_D, *ssd_norm_g, *ssd_w_out, *final_g;
    float* out; unsigned char* ws;
};

__device__ __forceinline__ float bf2f(bf16_t b) { return __uint_as_float(((unsigned)b) << 16); }
typedef float f32x2_t __attribute__((ext_vector_type(2)));
typedef __bf16 bf16x2_t __attribute__((ext_vector_type(2)));
__device__ __forceinline__ unsigned pack2(float lo, float hi) { const f32x2_t v = {lo, hi}; const bf16x2_t b = __builtin_convertvector(v, bf16x2_t); return __builtin_bit_cast(unsigned, b); }
__device__ __forceinline__ bf16_t f2bf(float f) { return (bf16_t)(pack2(f, 0.f) & 0xffffu); }
__device__ __forceinline__ float silu_f(float x) { return x * __builtin_amdgcn_rcpf(1.0f + __expf(-x)); }
__device__ __forceinline__ float sigmoid_f(float x) { return __builtin_amdgcn_rcpf(1.0f + __expf(-x)); }
__device__ __forceinline__ float softplus_f(float x) { return fmaxf(x, 0.f) + log1pf(__expf(-fabsf(x))); }
__device__ __forceinline__ float wave_sum(float v) {
#pragma unroll
    for (int o = 32; o > 0; o >>= 1) v += __shfl_xor(v, o);
    return v;
}
__device__ __forceinline__ float wave_incl_scan(float v, int lane) {
#pragma unroll
    for (int o = 1; o < 64; o <<= 1) { float t = __shfl_up(v, o); if (lane >= o) v += t; }
    return v;
}
__device__ __forceinline__ f32x4 mfma16(bf16x8 a, bf16x8 b, f32x4 c) { return __builtin_amdgcn_mfma_f32_16x16x32_bf16(a, b, c, 0, 0, 0); }

__constant__ double ROPE_INV_FREQ[32] = {1.0, 0.7498942093324559, 0.5623413251903491, 0.4216965034285822, 0.31622776601683794, 0.23713737056616552, 0.1778279410038923, 0.1333521432163324, 0.1, 0.07498942093324558, 0.05623413251903491, 0.042169650342858224, 0.03162277660168379, 0.023713737056616554, 0.01778279410038923, 0.01333521432163324, 0.01, 0.007498942093324558, 0.005623413251903491, 0.004216965034285823, 0.0031622776601683794, 0.0023713737056616554, 0.0017782794100389228, 0.001333521432163324, 0.001, 0.0007498942093324559, 0.0005623413251903491, 0.00042169650342858224, 0.00031622776601683794, 0.00023713737056616554, 0.00017782794100389227, 0.0001333521432163324};
__device__ __forceinline__ void rope_cs(int pos, int idx, float& c, float& s) {
    double t = (double)pos * ROPE_INV_FREQ[idx] * 0.15915494309189535;
    t -= floor(t);
    float f = (float)t;
    s = __builtin_amdgcn_sinf(f); c = __builtin_amdgcn_cosf(f);
}

__device__ __forceinline__ int opaque_tid() { int t = threadIdx.x; asm volatile("" : "+v"(t)); return t; }

constexpr int LDS_PARAMS_OFF = 147200;
__device__ __forceinline__ Params lds_params(const unsigned char* lds) {
    Params q;
    const LAS unsigned* w = (const LAS unsigned*)(LAS unsigned char*)lds + LDS_PARAMS_OFF / 4;
    unsigned long long v[31];
#pragma unroll
    for (int i = 0; i < 31; ++i) { const unsigned lo = __builtin_amdgcn_readfirstlane(w[2 * i]), hi = __builtin_amdgcn_readfirstlane(w[2 * i + 1]); v[i] = ((unsigned long long)hi << 32) | lo; }
    q.x = (const float*)v[0]; q.c = (const float*)v[1]; q.pos = (const int*)v[2];
    q.ada_w = (const float*)v[3];
    q.ada_b = (const float*)v[4];
    q.norm_g = (const float*)v[5];
    q.w1 = (const float*)v[6];
    q.w3 = (const float*)v[7];
    q.w2 = (const float*)v[8];
    q.ev_w_in = (const float*)v[9];
    q.gdn_conv_w = (const float*)v[10];
    q.gdn_A_log = (const float*)v[11];
    q.gdn_dt_bias = (const float*)v[12];
    q.gdn_norm_g = (const float*)v[13];
    q.mla_q_norm_g = (const float*)v[14];
    q.mla_w_uq = (const float*)v[15];
    q.mla_kv_norm_g = (const float*)v[16];
    q.mla_w_ukv = (const float*)v[17];
    q.ev_w_out = (const float*)v[18];
    q.ssd_w_in = (const float*)v[19];
    q.ssd_conv_w = (const float*)v[20];
    q.ssd_conv_b = (const float*)v[21];
    q.ssd_A_log = (const float*)v[22];
    q.ssd_dt_bias = (const float*)v[23];
    q.ssd_D = (const float*)v[24];
    q.ssd_norm_g = (const float*)v[25];
    q.ssd_w_out = (const float*)v[26];
    q.final_g = (const float*)v[27];
    q.out = (float*)v[28]; q.ws = (unsigned char*)v[29];
    return q;
}

#define XB_TMO      128
#define XB_XCNT(j)  (256  + 64 * (j))
#define XB_XSUB(j)  (1280 + 64 * (j))
#define XB_XGEN(j)  (2304 + 64 * (j))
#define XB_TOP      3328
#define XB_TOPGEN   3392
#define XCD_BAR_WORDS 3456
#define XB_SPIN_CAP (1u << 18)

__device__ __forceinline__ unsigned xb_ld(unsigned* p)              { return __hip_atomic_load(p, __ATOMIC_RELAXED, __HIP_MEMORY_SCOPE_AGENT); }
__device__ __forceinline__ unsigned xb_add(unsigned* p, unsigned v) { return __hip_atomic_fetch_add(p, v, __ATOMIC_RELAXED, __HIP_MEMORY_SCOPE_AGENT); }
__device__ __forceinline__ unsigned xb_xcc_id() { return (unsigned)__builtin_amdgcn_s_getreg((3 << 11) | 20) & 0xFu; }
#define XB_SPIN(cond, bar) do { unsigned _sp = 0; while (cond) { if (_sp < 64u) __builtin_amdgcn_s_sleep(1); else __builtin_amdgcn_s_sleep(32); \
    if ((++_sp & 255u) == 0u) { if (xb_ld(&(bar)[XB_TMO])) break; if (_sp > XB_SPIN_CAP) { atomicAdd(&(bar)[XB_TMO], 1u); break; } } } } while (0)

struct XcdBarrier {
    unsigned* bar; unsigned x;
    volatile LAS unsigned* st;
};

__device__ __forceinline__ XcdBarrier xcd_barrier_post(unsigned* bar, volatile LAS unsigned* st) {
    XcdBarrier b; b.bar = bar; b.x = xb_xcc_id(); b.st = st;
    if (threadIdx.x == 0) (void)xb_add(&bar[XB_XCNT(b.x)], 1u);
    return b;
}
__device__ __forceinline__ void xcd_barrier_complete(unsigned* bar, unsigned x, unsigned& nloc, unsigned& nx) {
    const unsigned G = gridDim.x * gridDim.y * gridDim.z;
    unsigned sum, cnt, mine, sp = 0u;
    for (;;) {
        sum = 0u; cnt = 0u; mine = 0u;
#pragma unroll
        for (unsigned j = 0; j < 16; ++j) { const unsigned c = xb_ld(&bar[XB_XCNT(j)]); sum += c; cnt += (c > 0u) ? 1u : 0u; mine = (j == x) ? c : mine; }
        if (sum == G) break;
        __builtin_amdgcn_s_sleep(1);
        if ((++sp & 255u) == 0u) { if (xb_ld(&bar[XB_TMO])) break; if (sp > XB_SPIN_CAP) { atomicAdd(&bar[XB_TMO], 1u); break; } }
    }
    nloc = mine > 0u ? mine : 1u; nx = cnt > 0u ? cnt : 1u;
}

__device__ __forceinline__ void xcd_barrier(const XcdBarrier& b) {
    asm volatile("s_waitcnt vmcnt(0)" ::: "memory");
    __syncthreads();
    if (threadIdx.x == 0) {
        unsigned* bar = b.bar;
        __builtin_amdgcn_s_waitcnt(0);
        unsigned nloc = b.st[0], nx = b.st[1];
        if (nloc == 0u) { xcd_barrier_complete(bar, b.x, nloc, nx); b.st[0] = nloc; b.st[1] = nx; }
        const unsigned old = xb_add(&bar[XB_XSUB(b.x)], 1u);
        const unsigned gen = old / nloc;
        if (old + 1u == (gen + 1u) * nloc) {
            __builtin_amdgcn_fence(__ATOMIC_RELEASE, "agent");
            asm volatile("s_waitcnt vmcnt(0)" ::: "memory");
            const unsigned og = xb_add(&bar[XB_TOP], 1u);
            const unsigned tg = og / nx;
            if (og + 1u == (tg + 1u) * nx) xb_add(&bar[XB_TOPGEN], 1u);
            else XB_SPIN(xb_ld(&bar[XB_TOPGEN]) == tg, bar);
            __builtin_amdgcn_fence(__ATOMIC_ACQUIRE, "agent");
            xb_add(&bar[XB_XGEN(b.x)], 1u);
            asm volatile("s_waitcnt vmcnt(0)" ::: "memory");
        } else {
            XB_SPIN(xb_ld(&bar[XB_XGEN(b.x)]) == gen, bar);
            __builtin_amdgcn_fence(__ATOMIC_ACQUIRE, "agent");
            asm volatile("s_waitcnt vmcnt(0)" ::: "memory");
        }
    }
    __syncthreads();
}


#define GSYNC() do { xcd_barrier(xbar); if (PROBE == 9) xcd_barrier(xbar); } while (0)
constexpr size_t OFF_BAR = 384 * 1024;

#define CONV_PAIR(P_, pitch_, col_, tok0_, w_, wstride_, cc_, b0_, b1_, BODY) do { \
        const unsigned* src_ = (const unsigned*)((P_) + (size_t)(tok0_) * (pitch_) + (col_)); \
        unsigned raw_[67]; \
        _Pragma("unroll") for (int t = 0; t < 67; ++t) raw_[t] = ((t >= 3) || (tok0_) > 0) ? src_[((long)t - 3) * ((pitch_) / 2)] : 0u; \
        const float wa0_ = (w_)[cc_], wa1_ = (w_)[(wstride_) + (cc_)], wa2_ = (w_)[2 * (wstride_) + (cc_)], wa3_ = (w_)[3 * (wstride_) + (cc_)]; \
        const float wb0_ = (w_)[(cc_) + 1], wb1_ = (w_)[(wstride_) + (cc_) + 1], wb2_ = (w_)[2 * (wstride_) + (cc_) + 1], wb3_ = (w_)[3 * (wstride_) + (cc_) + 1]; \
        __builtin_amdgcn_sched_barrier(0); \
        _Pragma("unroll") for (int t = 0; t < 64; ++t) { \
            const float y0 = silu_f((b0_) + wa0_ * __uint_as_float(raw_[t] << 16) + wa1_ * __uint_as_float(raw_[t + 1] << 16) + wa2_ * __uint_as_float(raw_[t + 2] << 16) + wa3_ * __uint_as_float(raw_[t + 3] << 16)); \
            const float y1 = silu_f((b1_) + wb0_ * __uint_as_float(raw_[t] & 0xffff0000u) + wb1_ * __uint_as_float(raw_[t + 1] & 0xffff0000u) + wb2_ * __uint_as_float(raw_[t + 2] & 0xffff0000u) + wb3_ * __uint_as_float(raw_[t + 3] & 0xffff0000u)); \
            BODY; } } while (0)
namespace pg8 {
#define PG8_LAS __attribute__((address_space(3)))
typedef unsigned short bf16_t;
typedef short bf16x8 __attribute__((ext_vector_type(8)));
typedef float f32x4 __attribute__((ext_vector_type(4)));
typedef unsigned u32x4 __attribute__((ext_vector_type(4)));
constexpr int BM = 256, BK = 64, HALF = 128, HTB = HALF * BK * 2  , STAGE_BYTES = 8 * HTB, NXCD = 8, WGM = 8;

__host__ __device__ __forceinline__ int lds_byte(int r, int c) { const int st = (r >> 4) * 2 + (c >> 5), rr = r & 15, cc = c & 31, ob = rr * 64 + cc * 2; return st * 1024 + (ob ^ (((ob >> 9) & 1) << 5)); }
__host__ __device__ __forceinline__ void stage_rc(int b, int& R, int& C) { const int st = b / 1024, sb = b % 1024, swz = sb ^ (((sb >> 9) & 1) << 5); R = (st >> 1) * 16 + swz / 64; C = (st & 1) * 32 + (swz % 64) / 2; }
__host__ __device__ __forceinline__ int perm32(int rho) { const int n = rho >> 4, i = rho & 15; return 8 * (i >> 2) + 4 * n + (i & 3); }

struct Unit { int pm, pn; };
struct Gemm { const bf16_t* A; const bf16_t* Bt; int M, N, K; };

struct StaticOrder {
    int nM, nN, nwg, G, c;
    __host__ __device__ void init(int M, int N, int G_, int c_) { nM = M / BM; nN = N / BM; nwg = nM * nN; G = G_; c = c_; }
    __host__ __device__ bool next(int i, Unit& u) const {
        const long L = (long)i * G + c; if (L >= nwg) return false;
        int wgid = (int)L; { const int q = nwg / NXCD, r = nwg % NXCD, xcd = wgid % NXCD, off = wgid / NXCD; wgid = (xcd < r ? xcd * (q + 1) : r * (q + 1) + (xcd - r) * q) + off; }
        const int nig = WGM * nN, gid = wgid / nig, fm = gid * WGM, gsz = (nM - fm) < WGM ? (nM - fm) : WGM;
        u.pm = fm + ((wgid % nig) % gsz); u.pn = (wgid % nig) / gsz; return true;
    }
    __device__ __forceinline__ void a_ready(const Unit&) const {}
    __device__ __forceinline__ void done(const Unit&) const {}
};
__device__ __forceinline__ unsigned cvt_pk_bf16(float lo, float hi) { unsigned r; asm volatile("v_cvt_pk_bf16_f32 %0, %1, %2" : "=v"(r) : "v"(lo), "v"(hi)); return r; }
struct EpiBf16Plain {
    static constexpr bool PERM = true, AFTER_DRAIN = false;
    bf16_t* O; int ldc;
    __device__ __forceinline__ void operator()(const f32x4 (&acc)[2][2][4][2], const Unit& u, int wr, int wc, int fr, int fq) const {
        const int row0 = u.pm * BM + wr * 64 + fr; const int col0 = u.pn * BM + wc * 32 + 8 * fq;
#pragma unroll
        for (int ai = 0; ai < 2; ++ai)
#pragma unroll
            for (int m = 0; m < 4; ++m) { bf16_t* rowp = O + (size_t)(row0 + ai * HALF + m * 16) * ldc + col0;
#pragma unroll
                for (int bj = 0; bj < 2; ++bj) { const f32x4 v0 = acc[ai][bj][m][0], v1 = acc[ai][bj][m][1];
                    u32x4 w; w.x = cvt_pk_bf16(v0[0], v0[1]); w.y = cvt_pk_bf16(v0[2], v0[3]); w.z = cvt_pk_bf16(v1[0], v1[1]); w.w = cvt_pk_bf16(v1[2], v1[3]);
                    *(u32x4*)(rowp + bj * HALF) = w; } }
    }
};
struct EpiSwiglu {
    static constexpr bool PERM = true, AFTER_DRAIN = false;
    bf16_t* U; int ldc;
    __device__ __forceinline__ void operator()(const f32x4 (&acc)[2][2][4][2], const Unit& u, int wr, int wc, int fr, int fq) const {
        const int row0 = u.pm * BM + wr * 64 + fr; const int col0 = u.pn * HALF + wc * 32 + 8 * fq;
#pragma unroll
        for (int ai = 0; ai < 2; ++ai)
#pragma unroll
            for (int m = 0; m < 4; ++m) { bf16_t* rowp = U + (size_t)(row0 + ai * HALF + m * 16) * ldc + col0;
                float r[8];
#pragma unroll
                for (int n = 0; n < 2; ++n)
#pragma unroll
                    for (int j = 0; j < 4; ++j) { const float a = acc[ai][0][m][n][j], b = acc[ai][1][m][n][j]; r[n * 4 + j] = a * __builtin_amdgcn_rcpf(1.0f + __expf(-a)) * b; }
                u32x4 w; w.x = cvt_pk_bf16(r[0], r[1]); w.y = cvt_pk_bf16(r[2], r[3]); w.z = cvt_pk_bf16(r[4], r[5]); w.w = cvt_pk_bf16(r[6], r[7]);
                *(u32x4*)rowp = w; }
    }
};
struct EpiResid {
    static constexpr bool PERM = false, AFTER_DRAIN = false;
    float* X; const float* Xin; const float* gate; float coef;
    __device__ __forceinline__ void operator()(const f32x4 (&acc)[2][2][4][2], const Unit& u, int wr, int wc, int fr, int fq) const {
        const int row0 = u.pm * BM + wr * 64 + fr, col0 = u.pn * BM + wc * 32 + 4 * fq;
        f32x4 gv[2][2];
#pragma unroll
        for (int bj = 0; bj < 2; ++bj)
#pragma unroll
            for (int n = 0; n < 2; ++n) gv[bj][n] = *(const f32x4*)(gate + col0 + bj * HALF + n * 16) * coef;
#pragma unroll
        for (int am = 0; am < 4; ++am) {
            const int ai = am >> 1, m0 = (am & 1) * 2;
            f32x4 xv[2][2][2];
#pragma unroll
            for (int mm = 0; mm < 2; ++mm) { const float* rowp = Xin + (size_t)(row0 + ai * HALF + (m0 + mm) * 16) * 1024 + col0;
#pragma unroll
                for (int bj = 0; bj < 2; ++bj)
#pragma unroll
                    for (int n = 0; n < 2; ++n) xv[mm][bj][n] = *(const f32x4*)(rowp + bj * HALF + n * 16); }
#pragma unroll
            for (int mm = 0; mm < 2; ++mm) { float* rowp = X + (size_t)(row0 + ai * HALF + (m0 + mm) * 16) * 1024 + col0;
#pragma unroll
                for (int bj = 0; bj < 2; ++bj)
#pragma unroll
                    for (int n = 0; n < 2; ++n) *(f32x4*)(rowp + bj * HALF + n * 16) = xv[mm][bj][n] + gv[bj][n] * acc[ai][bj][m0 + mm][n]; }
            asm volatile("" ::: "memory");
        }
    }
};
template <class Epi, class Sched, bool STAMP = false>
__device__ __forceinline__ void gemm_phase(PG8_LAS unsigned char* lds, const Gemm g, const Sched& S, const Epi& E, unsigned long long* stamps) {
    int tid_ = threadIdx.x; asm volatile("" : "+v"(tid_)); const int tid = tid_, wid = __builtin_amdgcn_readfirstlane(tid >> 6), lane = tid & 63, wr = wid >> 2, wc = wid & 3, fr = lane & 15, fq = lane >> 4;
    const int K = g.K, nt = K / BK;
    int ts_lo = 0, ts_hi = 0, nts = 0; const unsigned long long rt_entry = STAMP ? (unsigned long long)wall_clock64() : 0ull;
#define PG8_STAMP() do { if (STAMP && wid == 0 && nts < 64) { const unsigned long long _c = (unsigned long long)clock64(); \
        ts_lo = (lane == nts) ? (int)(unsigned)_c : ts_lo; ts_hi = (lane == nts) ? (int)(unsigned)(_c >> 32) : ts_hi; ++nts; } } while (0)
    PG8_STAMP();
    unsigned voffA[2], voffB[2];
#pragma unroll
    for (int i = 0; i < 2; ++i) { int R, C; stage_rc(tid * 16 + i * 8192, R, C); const int Rb = Epi::PERM ? ((R & ~31) + perm32(R & 31)) : R;
        voffA[i] = (unsigned)(R * K + C) * 2u; voffB[i] = (unsigned)(Rb * K + C) * 2u; }
    const size_t kstep = (size_t)(BK * 2);
    const size_t hstep = (size_t)HALF * K * 2;
    const size_t tstep = 2 * hstep;
    const unsigned ldsw = (unsigned)wid * 1024u;
    const int aoff = lds_byte(wr * 64 + fr, fq * 8), boff = lds_byte(wc * 32 + fr, fq * 8);
#define PG8_SA(b, h) (((b) * 2 + (h)) * HTB)
#define PG8_SB(b, h) ((4 + (b) * 2 + (h)) * HTB)
#define PG8_STAGE(bufoff, gbase, voff) do { _Pragma("unroll") for (int _i = 0; _i < 2; ++_i) \
        __builtin_amdgcn_global_load_lds((const unsigned*)((const char*)(gbase) + (voff)[_i]), (PG8_LAS unsigned*)(lds + (bufoff) + ldsw + _i * 8192), 16, 0, 0); } while (0)
#define PG8_LDA(dst, b, h) do { _Pragma("unroll") for (int m = 0; m < 4; ++m) _Pragma("unroll") for (int k = 0; k < 2; ++k) dst[m][k] = *(const PG8_LAS bf16x8*)(lds + PG8_SA(b, h) + aoff + m * 2048 + k * 1024); } while (0)
#define PG8_LDB(dst, b, h) do { _Pragma("unroll") for (int n = 0; n < 2; ++n) _Pragma("unroll") for (int k = 0; k < 2; ++k) dst[n][k] = *(const PG8_LAS bf16x8*)(lds + PG8_SB(b, h) + boff + n * 2048 + k * 1024); } while (0)
#define PG8_MMA(ai, bj, At, Bt) do { __builtin_amdgcn_s_setprio(1); _Pragma("unroll") for (int m = 0; m < 4; ++m) _Pragma("unroll") for (int n = 0; n < 2; ++n) _Pragma("unroll") for (int k = 0; k < 2; ++k) \
        acc[ai][bj][m][n] = __builtin_amdgcn_mfma_f32_16x16x32_bf16(Bt[n][k], At[m][k], acc[ai][bj][m][n], 0, 0, 0); __builtin_amdgcn_s_setprio(0); } while (0)
#define PG8_WAIT_V(n) asm volatile("s_waitcnt vmcnt(" #n ")" ::: "memory")
#define PG8_WAIT_L(n) asm volatile("s_waitcnt lgkmcnt(" #n ")" ::: "memory")
#define PG8_BAR __builtin_amdgcn_s_barrier()
#define PG8_SCHED __builtin_amdgcn_sched_barrier(0)
    Unit cur, nxt; int ui = 0;
    if (!S.next(0, cur)) return;
    f32x4 acc[2][2][4][2];
#pragma unroll
    for (int a = 0; a < 2; ++a)
#pragma unroll
        for (int b = 0; b < 2; ++b)
#pragma unroll
            for (int m = 0; m < 4; ++m)
#pragma unroll
                for (int n = 0; n < 2; ++n) acc[a][b][m][n] = (f32x4){0.f, 0.f, 0.f, 0.f};
    bf16x8 At[4][2], B0[2][2], B1[2][2];
    const char* cA = (const char*)g.A + (size_t)cur.pm * tstep; const char* cB = (const char*)g.Bt + (size_t)cur.pn * tstep;
    S.a_ready(cur);
    PG8_STAGE(PG8_SB(0, 0), cB, voffB); PG8_STAGE(PG8_SA(0, 0), cA, voffA); PG8_STAGE(PG8_SB(0, 1), cB + hstep, voffB); PG8_STAGE(PG8_SA(0, 1), cA + hstep, voffA);
    if (wr == 1) PG8_BAR;
    PG8_WAIT_V(4); PG8_BAR;
    PG8_STAGE(PG8_SB(1, 0), cB + kstep, voffB); PG8_STAGE(PG8_SA(1, 0), cA + kstep, voffA); PG8_STAGE(PG8_SB(1, 1), cB + hstep + kstep, voffB);
    PG8_WAIT_V(6); PG8_BAR;
    PG8_STAMP();
    for (;;) {
        const bool has_next = S.next(ui + 1, nxt);
        const char* nA = has_next ? (const char*)g.A + (size_t)nxt.pm * tstep : cA; const char* nB = has_next ? (const char*)g.Bt + (size_t)nxt.pn * tstep : cB;
        for (int t = 0; t < nt; t += 2) {
            const bool last = (t == nt - 2);
            const char* a1 = cA + (size_t)(t + 1) * kstep;
            const char* a2 = last ? nA : cA + (size_t)(t + 2) * kstep; const char* b2 = last ? nB : cB + (size_t)(t + 2) * kstep;
            const char* a3 = a2 + kstep; const char* b3 = b2 + kstep;
            if (last && has_next) S.a_ready(nxt);
            PG8_LDB(B0, 0, 0); PG8_SCHED; PG8_LDA(At, 0, 0); PG8_STAGE(PG8_SA(1, 1), a1 + hstep, voffA);
            PG8_WAIT_L(8); PG8_BAR; PG8_WAIT_L(0); PG8_MMA(0, 0, At, B0); PG8_BAR; PG8_SCHED;
            PG8_LDB(B1, 0, 1); PG8_STAGE(PG8_SB(0, 0), b2, voffB);
            PG8_BAR; PG8_WAIT_L(0); PG8_MMA(0, 1, At, B1); PG8_BAR;
            PG8_LDA(At, 0, 1); PG8_STAGE(PG8_SA(0, 0), a2, voffA);
            PG8_BAR; PG8_WAIT_L(0); PG8_MMA(1, 0, At, B0); PG8_BAR; PG8_SCHED;
            PG8_STAGE(PG8_SB(0, 1), b2 + hstep, voffB);
            PG8_WAIT_V(6); PG8_BAR; PG8_MMA(1, 1, At, B1); PG8_BAR;
            PG8_LDB(B0, 1, 0); PG8_SCHED; PG8_LDA(At, 1, 0); PG8_STAGE(PG8_SA(0, 1), a2 + hstep, voffA);
            PG8_WAIT_L(8); PG8_BAR; PG8_WAIT_L(0); PG8_MMA(0, 0, At, B0); PG8_BAR; PG8_SCHED;
            PG8_LDB(B1, 1, 1); PG8_STAGE(PG8_SB(1, 0), b3, voffB);
            PG8_BAR; PG8_WAIT_L(0); PG8_MMA(0, 1, At, B1); PG8_BAR;
            PG8_LDA(At, 1, 1); PG8_STAGE(PG8_SA(1, 0), a3, voffA);
            PG8_BAR; PG8_WAIT_L(0); PG8_MMA(1, 0, At, B0); PG8_BAR; PG8_SCHED;
            PG8_STAGE(PG8_SB(1, 1), b3 + hstep, voffB);
            PG8_WAIT_V(6); PG8_BAR; PG8_MMA(1, 1, At, B1); PG8_BAR;
        }
        PG8_STAMP();
        if constexpr (!Epi::AFTER_DRAIN) { E(acc, cur, wr, wc, fr, fq); S.done(cur); }
        PG8_STAMP();
        if (!has_next) break;
#pragma unroll
        for (int a = 0; a < 2; ++a)
#pragma unroll
            for (int b = 0; b < 2; ++b)
#pragma unroll
                for (int m = 0; m < 4; ++m)
#pragma unroll
                    for (int n = 0; n < 2; ++n) acc[a][b][m][n] = (f32x4){0.f, 0.f, 0.f, 0.f};
        cur = nxt; cA = nA; cB = nB; ++ui;
    }
    PG8_WAIT_V(0);
    if (wr == 0) PG8_BAR;
    PG8_BAR;
    if constexpr (Epi::AFTER_DRAIN) { E.fused(acc, cur, wr, wc, fr, fq, lds, wid, lane); S.done(cur); }
    PG8_STAMP();
    if (STAMP && wid == 0) { stamps[lane] = lane < nts ? (((unsigned long long)(unsigned)ts_hi << 32) | (unsigned)ts_lo) : 0ull;
        if (lane == 62) stamps[62] = rt_entry; if (lane == 63) stamps[63] = (unsigned long long)wall_clock64(); }
#undef PG8_STAMP
#undef PG8_SA
#undef PG8_SB
#undef PG8_STAGE
#undef PG8_LDA
#undef PG8_LDB
#undef PG8_MMA
#undef PG8_WAIT_V
#undef PG8_WAIT_L
#undef PG8_BAR
#undef PG8_SCHED
}
}

__device__ __forceinline__ void phase_ada(const Params& p, float* ldsf, int t0, int t1, int vb, int VG) {
    const int tid = opaque_tid();
    float* mod = (float*)(p.ws + OFF_MOD);
    const int cq = tid & 15, ks = tid >> 4;
    for (int t = t0 + vb; t < t1; t += VG) {
        const int l = t / 144, cgi = t % 144; const int col = cgi * 64 + cq * 4;
        const float* W = p.ada_w + (size_t)l * 1024 * 9216 + col;
        f32x4 acc = {0.f, 0.f, 0.f, 0.f};
        f32x4 wv[32];
#pragma unroll
        for (int i = 0; i < 32; ++i) wv[i] = __builtin_nontemporal_load((const f32x4*)(W + (size_t)(ks * 32 + i) * 9216));
        __builtin_amdgcn_sched_barrier(0);
#pragma unroll
        for (int i = 0; i < 32; ++i) { const float cv = p.c[ks * 32 + i]; const float ca = cv / (1.0f + expf(-cv)); acc += wv[i] * ca; }
        *(f32x4*)(ldsf + (ks * 16 + cq) * 4) = acc;
        __syncthreads();
        if (tid < 64) { const int cqq = tid >> 2, j = tid & 3; float s = 0.f; for (int k2 = 0; k2 < 32; ++k2) s += ldsf[(k2 * 16 + cqq) * 4 + j];
            const int o = l * 9216 + cgi * 64 + cqq * 4 + j; mod[o] = s + p.ada_b[o]; }
        __syncthreads();
    }
}

__device__ __forceinline__ int conv_col(int mode, int r, int& which) {
    which = 0;
    if (mode == 1) { const int pn = r >> 8, w = r & 255; which = (w >= 128) ? 1 : 0; return pn * 128 + (w & 127); }
    if (mode == 2) { if (r < 512) return (r >> 7) * 256 + (r & 127); const int rr = r - 512; return (rr >> 7) * 256 + 128 + (rr & 127); }
    return r;
}
__device__ __forceinline__ void convT(bf16_t* dst, const float* src0, const float* src1, int K, int ldsrc, int Nsrc, int Ndst, int mode, int& tbase, float* tile, int vb, int VG) {
    const int tid = opaque_tid();
    const int nkt = K >> 7, ntiles = nkt * (Ndst >> 6);
    const int first = (vb + VG - (tbase % VG)) % VG;
    for (int t = first; t < ntiles; t += VG) {
        const int nt_ = t / nkt, kt = t % nkt; const int r0 = nt_ * 64, k0 = kt * 128;
        { const int n = tid & 63, kk = tid >> 6; int which; const int col = conv_col(mode, r0 + n, which); const bool valid = col < Nsrc;
          const float* src = (which ? src1 : src0) + (size_t)k0 * ldsrc + col;
          float v[16];
#pragma unroll
          for (int it = 0; it < 16; ++it) v[it] = valid ? __builtin_nontemporal_load(src + (size_t)(kk + it * 8) * ldsrc) : 0.f;
#pragma unroll
          for (int it = 0; it < 16; ++it) tile[(kk + it * 8) * 65 + n] = v[it]; }
        __syncthreads();
        { const int kp = tid & 63, n = tid >> 6;
#pragma unroll
          for (int it = 0; it < 8; ++it) { const int nn = n + it * 8; const float v0 = tile[(2 * kp) * 65 + nn], v1 = tile[(2 * kp + 1) * 65 + nn];
              *(unsigned*)(dst + (size_t)(r0 + nn) * K + k0 + 2 * kp) = pack2(v0, v1); } }
        __syncthreads();
    }
    tbase += ntiles;
}
__device__ __forceinline__ void phase_convert(const Params& p, int l, float* tile, int vb, int VG) {
    int tb = 0;
    unsigned char* wsw = p.ws + (size_t)(l & 1) * W_REGION2;
    for (int f = 0; f < 2; ++f) {
        const size_t wo = (size_t)(l * 2 + f) * 1024 * 2816;
        convT((bf16_t*)(wsw + (f ? W_13B : W_13A)), p.w1 + wo, p.w3 + wo, 1024, 2816, 2816, 5632, 1, tb, tile, vb, VG);
        convT((bf16_t*)(wsw + (f ? W_2B : W_2A)), p.w2 + wo, nullptr, 2816, 1024, 1024, 1024, 0, tb, tile, vb, VG);
    }
    const int e = l >> 1;
    if ((l & 1) == 0) {
        bf16_t* wi = (bf16_t*)(wsw + W_MIX); bf16_t* wout = wi + 2816 * 1024; bf16_t* wuq = wout + 1024 * 1024; bf16_t* wukv = wuq + 768 * 384;
        convT(wi, p.ev_w_in + (size_t)e * 1024 * 2760, nullptr, 1024, 2760, 2760, 2816, 0, tb, tile, vb, VG);
        convT(wout, p.ev_w_out + (size_t)e * 1024 * 1024, nullptr, 1024, 1024, 1024, 1024, 0, tb, tile, vb, VG);
        convT(wuq, p.mla_w_uq + (size_t)e * 384 * 768, nullptr, 384, 768, 768, 768, 0, tb, tile, vb, VG);
        convT(wukv, p.mla_w_ukv + (size_t)e * 256 * 1024, nullptr, 256, 1024, 1024, 1024, 2, tb, tile, vb, VG);
    } else {
        bf16_t* wi = (bf16_t*)(wsw + W_MIX); bf16_t* wout = wi + 5376 * 1024;
        convT(wi, p.ssd_w_in + (size_t)e * 1024 * 5152, nullptr, 1024, 5152, 5152, 5376, 0, tb, tile, vb, VG);
        convT(wout, p.ssd_w_out + (size_t)e * 2048 * 1024, nullptr, 2048, 1024, 1024, 1024, 0, tb, tile, vb, VG);
    }
}

__device__ __forceinline__ void phase_norm(const float* X, bf16_t* H, const float* g, const float* shift, const float* scale) {
    const int tid = opaque_tid(), wave = tid >> 6, lane = tid & 63;
    for (int row = (blockIdx.x * 8 + wave) * 2; row < SEQ; row += gridDim.x * 16) {
        const f32x4* xr = (const f32x4*)(X + (size_t)row * 1024);
        f32x4 v[2][4]; float ss[2] = {0.f, 0.f};
#pragma unroll
        for (int r = 0; r < 2; ++r)
#pragma unroll
            for (int i = 0; i < 4; ++i) v[r][i] = xr[r * 256 + lane + 64 * i];
#pragma unroll
        for (int r = 0; r < 2; ++r) {
#pragma unroll
            for (int i = 0; i < 4; ++i) ss[r] += v[r][i][0] * v[r][i][0] + v[r][i][1] * v[r][i][1] + v[r][i][2] * v[r][i][2] + v[r][i][3] * v[r][i][3];
            ss[r] = wave_sum(ss[r]); }
#pragma unroll
        for (int i = 0; i < 4; ++i) { const int col = (lane + 64 * i) * 4;
            const f32x4 g4 = *(const f32x4*)(g + col), sc = *(const f32x4*)(scale + col), sh = *(const f32x4*)(shift + col);
#pragma unroll
            for (int r = 0; r < 2; ++r) { const float rstd = rsqrtf(ss[r] * (1.0f / 1024.0f) + 1e-6f);
                float y[4];
#pragma unroll
                for (int j = 0; j < 4; ++j) y[j] = (v[r][i][j] * rstd * g4[j]) * (1.0f + sc[j]) + sh[j];
                u32x2 w; w.x = pack2(y[0], y[1]); w.y = pack2(y[2], y[3]);
                *(u32x2*)(H + (size_t)(row + r) * 1024 + col) = w; } }
    }
}
__device__ __forceinline__ void phase_final(float* X, const float* g) {
    const int tid = opaque_tid(), wave = tid >> 6, lane = tid & 63;
    for (int row = (blockIdx.x * 8 + wave) * 2; row < SEQ; row += gridDim.x * 16) {
        f32x4* xr = (f32x4*)(X + (size_t)row * 1024);
        f32x4 v[2][4]; float ss[2] = {0.f, 0.f};
#pragma unroll
        for (int r = 0; r < 2; ++r)
#pragma unroll
            for (int i = 0; i < 4; ++i) v[r][i] = xr[r * 256 + lane + 64 * i];
#pragma unroll
        for (int r = 0; r < 2; ++r) {
#pragma unroll
            for (int i = 0; i < 4; ++i) ss[r] += v[r][i][0] * v[r][i][0] + v[r][i][1] * v[r][i][1] + v[r][i][2] * v[r][i][2] + v[r][i][3] * v[r][i][3];
            ss[r] = wave_sum(ss[r]); }
#pragma unroll
        for (int i = 0; i < 4; ++i) { const f32x4 g4 = *(const f32x4*)(g + (lane + 64 * i) * 4);
#pragma unroll
            for (int r = 0; r < 2; ++r) xr[r * 256 + lane + 64 * i] = v[r][i] * rsqrtf(ss[r] * (1.0f / 1024.0f) + 1e-6f) * g4; }
    }
}

__device__ __forceinline__ void phase_mla_prep(const Params& p, int e) {
    const int tid = opaque_tid(), wave = tid >> 6, lane = tid & 63;
    const bf16_t* P = (const bf16_t*)(p.ws + OFF_BIG);
    bf16_t* CQN = (bf16_t*)(p.ws + M_CQN); bf16_t* CKVN = (bf16_t*)(p.ws + M_CKVN); bf16_t* KPE = (bf16_t*)(p.ws + M_KPE);
    const float* gq = p.mla_q_norm_g + e * 384; const float* gkv = p.mla_kv_norm_g + e * 256;
    for (int tok = blockIdx.x * 8 + wave; tok < SEQ; tok += gridDim.x * 8) {
        const bf16_t* pr = P + (size_t)tok * EV_N;
        { float q[6]; float ss = 0.f;
#pragma unroll
          for (int i = 0; i < 3; ++i) { const unsigned w = *(const unsigned*)(pr + 2056 + lane * 2 + 128 * i); q[2 * i] = bf2f((bf16_t)(w & 0xffff)); q[2 * i + 1] = bf2f((bf16_t)(w >> 16)); ss += q[2 * i] * q[2 * i] + q[2 * i + 1] * q[2 * i + 1]; }
          ss = wave_sum(ss); const float r = rsqrtf(ss * (1.0f / 384.0f) + 1e-6f);
#pragma unroll
          for (int i = 0; i < 3; ++i) { const int col = lane * 2 + 128 * i; *(unsigned*)(CQN + (size_t)tok * 384 + col) = pack2(q[2 * i] * r * gq[col], q[2 * i + 1] * r * gq[col + 1]); } }
        { const u32x2 w = *(const u32x2*)(pr + 2440 + lane * 4); float v[4] = {bf2f((bf16_t)(w.x & 0xffff)), bf2f((bf16_t)(w.x >> 16)), bf2f((bf16_t)(w.y & 0xffff)), bf2f((bf16_t)(w.y >> 16))};
          float ss = v[0] * v[0] + v[1] * v[1] + v[2] * v[2] + v[3] * v[3]; ss = wave_sum(ss); const float r = rsqrtf(ss * (1.0f / 256.0f) + 1e-6f);
          const int col = lane * 4; u32x2 o; o.x = pack2(v[0] * r * gkv[col], v[1] * r * gkv[col + 1]); o.y = pack2(v[2] * r * gkv[col + 2], v[3] * r * gkv[col + 3]);
          *(u32x2*)(CKVN + (size_t)tok * 256 + col) = o; }
        { const float v = bf2f(pr[2696 + lane]); const float pa = __shfl_xor(v, 32); float c, s; rope_cs(p.pos[tok], lane & 31, c, s);
          KPE[(size_t)tok * 64 + lane] = f2bf(lane < 32 ? v * c - pa * s : v * c + pa * s); }
    }
}

__device__ __forceinline__ void phase_gdn_intra(const Params& p, int e, unsigned char* lds) {
    const int tid = opaque_tid(), wave = tid >> 6, lane = tid & 63, fr = lane & 15, fq = lane >> 4;
    float* R0 = (float*)lds; float* R1 = (float*)(lds + 33792); float* R2 = (float*)(lds + 67584);
    bf16_t* QB = (bf16_t*)(lds + 101376); bf16_t* KB = (bf16_t*)(lds + 118784);
    float* sBeta = (float*)(lds + 136192); float* sGc = sBeta + 64;
    const bf16_t* P = (const bf16_t*)(p.ws + OFF_BIG);
    float* U = (float*)(p.ws + G_U); bf16_t* Wb = (bf16_t*)(p.ws + G_W); bf16_t* QS = (bf16_t*)(p.ws + G_QS); bf16_t* KET = (bf16_t*)(p.ws + G_KET); bf16_t* ATT = (bf16_t*)(p.ws + G_ATT);
    float* EGL = (float*)(p.ws + OFF_EGL);
    const float* cw = p.gdn_conv_w + (size_t)e * 4 * 1536;
    for (int item = blockIdx.x; item < 1024; item += gridDim.x) {
        const int h = item & 3, n = item >> 2, tok0 = n * 64;
        if (tid < 192) {
            const int part = tid >> 6, c2 = (tid & 63) * 2, ch = part * 512 + h * 128 + c2;
            float* dst = (part == 0 ? R0 : (part == 1 ? R1 : R2)) + c2;
            CONV_PAIR(P, EV_N, ch, tok0, cw, 1536, ch, 0.f, 0.f, { dst[t * 132] = y0; dst[t * 132 + 1] = y1; });
        } else if (tid >= 384 && tid < 448) {
            const int t = tid - 384; const bf16_t* pr = P + (size_t)(tok0 + t) * EV_N;
            const float bl = bf2f(pr[2048 + h]), a = bf2f(pr[2052 + h]);
            sBeta[t] = sigmoid_f(bl);
            float g = -expf(p.gdn_A_log[e * 4 + h]) * softplus_f(a + p.gdn_dt_bias[e * 4 + h]);
            g = wave_incl_scan(g, lane);
            sGc[t] = g;
        }
        __syncthreads();
        for (int i4 = 0; i4 < 4; ++i4) {
            const bool isq = wave < 4;
            float* rowb = (isq ? R0 : R1) + ((wave & 3) * 16 + i4 * 4) * 132;
            float a[4], b[4], ss[4];
#pragma unroll
            for (int r = 0; r < 4; ++r) { a[r] = rowb[r * 132 + lane]; b[r] = rowb[r * 132 + lane + 64]; ss[r] = a[r] * a[r] + b[r] * b[r]; }
#pragma unroll
            for (int o = 32; o > 0; o >>= 1)
#pragma unroll
                for (int r = 0; r < 4; ++r) ss[r] += __shfl_xor(ss[r], o);
#pragma unroll
            for (int r = 0; r < 4; ++r) {
                const int t = (wave & 3) * 16 + i4 * 4 + r; float* row = rowb + r * 132;
                const float sc = rsqrtf(ss[r] + 1e-6f) * (isq ? 0.08838834764831845f : 1.0f);
                const float av = a[r] * sc, bv = b[r] * sc;
                bf16_t* brow = (isq ? QB : KB) + t * 136; brow[lane] = f2bf(av); brow[lane + 64] = f2bf(bv);
                if (!isq) { row[lane] = av; row[lane + 64] = bv; }
                else { const float eg = __expf(sGc[t]); bf16_t* qo = QS + (size_t)(tok0 + t) * 512 + h * 128; qo[lane] = f2bf(av * eg); qo[lane + 64] = f2bf(bv * eg); }
            }
        }
        __syncthreads();
        {
            float* Amat = R0;
            const int m = wave >> 2, ib = wave & 3; const bf16_t* Y = m ? QB : KB;
            bf16x8 yf[4];
#pragma unroll
            for (int ks = 0; ks < 4; ++ks) yf[ks] = *(const bf16x8*)(Y + (ib * 16 + fr) * 136 + ks * 32 + fq * 8);
            const int irow = ib * 16 + fr; const float gi = sGc[irow], bi = sBeta[irow];
#pragma unroll
            for (int jb = 0; jb < 4; ++jb) {
                f32x4 d = {0.f, 0.f, 0.f, 0.f};
#pragma unroll
                for (int ks = 0; ks < 4; ++ks) { const bf16x8 xf = *(const bf16x8*)(KB + (jb * 16 + fr) * 136 + ks * 32 + fq * 8); d = mfma16(xf, yf[ks], d); }
                float v[4];
#pragma unroll
                for (int i = 0; i < 4; ++i) { const int j = jb * 16 + fq * 4 + i; const bool keep = m ? (j <= irow) : (j < irow); const float dec = keep ? __expf(gi - sGc[j]) : 0.f; v[i] = d[i] * dec * (m ? 1.0f : bi); }
                if (m == 0) { f32x4 o = {v[0], v[1], v[2], v[3]}; *(f32x4*)(Amat + irow * 64 + jb * 16 + fq * 4) = o; }
                else { u32x2 o; o.x = pack2(v[0], v[1]); o.y = pack2(v[2], v[3]); *(u32x2*)(ATT + ((size_t)(h * 256 + n) * 64 + irow) * 64 + jb * 16 + fq * 4) = o; }
            }
            const float gl = sGc[63];
            { const int t = tid & 63; const float ek = __expf(gl - sGc[t]);
#pragma unroll 4
              for (int it = 0; it < 16; ++it) { const int k = (tid >> 6) + 8 * it; KET[((size_t)(h * 256 + n) * 128 + k) * 64 + t] = f2bf(R1[t * 132 + k] * ek); } }
            if (tid == 0) EGL[h * 256 + n] = __expf(gl);
        }
        __syncthreads();
        if (tid < 256) {
            const float* Amat = R0;
            const int c = tid & 127; const bool isw = tid >= 128;
            float s[64];
#pragma unroll
            for (int i = 0; i < 64; ++i) s[i] = 0.f;
#pragma unroll
            for (int i = 0; i < 64; ++i) {
                float rhs = isw ? R1[i * 132 + c] * sBeta[i] * __expf(sGc[i]) : R2[i * 132 + c] * sBeta[i];
#pragma unroll
                for (int j4 = 0; j4 < (i + 3) / 4; ++j4) { const f32x4 a = *(const f32x4*)(Amat + i * 64 + j4 * 4);
                    rhs -= a[0] * s[j4 * 4 + 0]; rhs -= a[1] * s[j4 * 4 + 1]; rhs -= a[2] * s[j4 * 4 + 2]; rhs -= a[3] * s[j4 * 4 + 3]; }
                s[i] = rhs;
                if (isw) Wb[(size_t)(tok0 + i) * 512 + h * 128 + c] = f2bf(rhs); else U[(size_t)(tok0 + i) * 512 + h * 128 + c] = rhs;
            }
        }
        __syncthreads();
    }
}

__device__ __forceinline__ void phase_gdn_scan(const Params& p, unsigned char* lds_) {
    const int tid = opaque_tid(), wave = __builtin_amdgcn_readfirstlane(tid >> 6), lane = tid & 63, fr = lane & 15, fq = lane >> 4;
    const int h = blockIdx.x & 7, slice = blockIdx.x >> 3, j0 = slice * 16;
    LAS bf16_t* ST = (LAS bf16_t*)lds_; LAS bf16_t* VN = ST + 16 * 136;
    for (int i = tid; i < 16 * 136 / 2; i += 512) ((LAS unsigned*)ST)[i] = 0u;
    const float* U = (const float*)(p.ws + G_U); const bf16_t* Wb = (const bf16_t*)(p.ws + G_W);
    const bf16_t* KET = (const bf16_t*)(p.ws + G_KET); const float* EG = (const float*)(p.ws + OFF_EGL) + h * 256;
    bf16_t* SST = (bf16_t*)(p.ws + G_SST) + (size_t)(h * 256) * 16384 + (size_t)(j0 + fr) * 128 + wave * 16 + fq * 4;
    bf16_t* VNT = (bf16_t*)(p.ws + G_VNT) + (size_t)(h * 256) * 8192 + (size_t)(j0 + fr) * 64 + (wave & 3) * 16 + fq * 4;
    { u32x2 z; z.x = 0u; z.y = 0u; *(u32x2*)(SST) = z; }
    __syncthreads();
    const bool lo = wave < 4; const int rb = wave & 3;
    const bf16_t* A1 = Wb + (size_t)(rb * 16 + fr) * 512 + h * 128 + fq * 8;
    const size_t uoff = (size_t)(rb * 16 + fq * 4) * 512 + h * 128 + j0 + fr;
    const bf16_t* KEp = KET + ((size_t)(h * 256) * 128 + wave * 16 + fr) * 64 + fq * 8;
    const float* tch; size_t tstep;
    { const int L = slice * 32 + (wave & 3) * 8 + (lane & 7);
      if (L < 128) { tch = (const float*)(Wb + (size_t)(L >> 1) * 512 + h * 128 + (L & 1) * 64); tstep = 64 * 512 / 2; }
      else         { tch = (const float*)(KET + (size_t)(h * 256) * 8192 + (L - 128) * 64); tstep = 8192 / 2; } }
#define GLD128(dst, ptr) asm volatile("global_load_dwordx4 %0, %1, off" : "=v"(dst) : "v"(ptr))
#define GLD32(dst, ptr) asm volatile("global_load_dword %0, %1, off" : "=v"(dst) : "v"(ptr))
#define GDN_LOAD(LO_, N_, a1_, ka_, uu_, eg_, td_) do { const size_t tb_ = (size_t)(N_) * 64 * 512; \
        if (LO_) { _Pragma("unroll") for (int ks = 0; ks < 4; ++ks) GLD128(a1_[ks], A1 + tb_ + ks * 32); \
                  _Pragma("unroll") for (int i = 0; i < 4; ++i) GLD32(uu_[i], U + tb_ + uoff + (size_t)i * 512); } \
        _Pragma("unroll") for (int ks = 0; ks < 2; ++ks) GLD128(ka_[ks], KEp + (size_t)(N_) * 8192 + ks * 32); \
        GLD32(eg_, EG + (N_)); \
        if (!(LO_)) { GLD32(td_, tch + (size_t)GDN_CL((N_) + 5) * tstep); } } while (0)
#define GDN_WAIT(LO_, a1_, ka_, uu_, eg_, td_) do { if (LO_) asm volatile("s_waitcnt vmcnt(33)" : "+v"(a1_[0]), "+v"(a1_[1]), "+v"(a1_[2]), "+v"(a1_[3]), "+v"(ka_[0]), "+v"(ka_[1]), \
            "+v"(uu_[0]), "+v"(uu_[1]), "+v"(uu_[2]), "+v"(uu_[3]), "+v"(eg_)); \
        else asm volatile("s_waitcnt vmcnt(12)" : "+v"(ka_[0]), "+v"(ka_[1]), "+v"(eg_), "+v"(td_)); } while (0)
#define LDS_BAR() do { asm volatile("s_waitcnt lgkmcnt(0)" ::: "memory"); __builtin_amdgcn_s_barrier(); asm volatile("" ::: "memory"); } while (0)
#define GDN_STEP(LO_, N_, a1_, ka_, uu_, eg_) do { \
        if (LO_) { bf16x8 sb[4]; \
            _Pragma("unroll") for (int ks = 0; ks < 4; ++ks) sb[ks] = *(const LAS bf16x8*)(ST + fr * 136 + ks * 32 + fq * 8); \
            f32x4 acc1 = {0.f, 0.f, 0.f, 0.f}; \
            _Pragma("unroll") for (int ks = 0; ks < 4; ++ks) acc1 = mfma16(a1_[ks], sb[ks], acc1); \
            u32x2 w; w.x = pack2(uu_[0] - acc1[0], uu_[1] - acc1[1]); w.y = pack2(uu_[2] - acc1[2], uu_[3] - acc1[3]); \
            *(LAS u32x2*)(VN + fr * 72 + rb * 16 + fq * 4) = w; *(u32x2*)(VNT + (size_t)(N_) * 8192) = w; } \
        LDS_BAR(); \
        bf16x8 vb[2]; \
        _Pragma("unroll") for (int ks = 0; ks < 2; ++ks) vb[ks] = *(const LAS bf16x8*)(VN + fr * 72 + ks * 32 + fq * 8); \
        f32x4 sacc = Sreg * eg_; \
        _Pragma("unroll") for (int ks = 0; ks < 2; ++ks) sacc = mfma16(ka_[ks], vb[ks], sacc); \
        Sreg = sacc; \
        { u32x2 w; w.x = pack2(Sreg[0], Sreg[1]); w.y = pack2(Sreg[2], Sreg[3]); *(LAS u32x2*)(ST + fr * 136 + wave * 16 + fq * 4) = w; \
          if ((N_) + 1 < NCH) *(u32x2*)(SST + (size_t)((N_) + 1) * 16384) = w; } \
        LDS_BAR(); } while (0)
#define GDN_CL(x) ((x) < NCH ? (x) : NCH - 1)
#define GDN_RUN(LO_) do { \
    f32x4 Sreg = {0.f, 0.f, 0.f, 0.f}; \
    bf16x8 a1[4], ka[2]; float uu[4]; float eg; float td = 0.f, tdb = 0.f, tdc = 0.f, tdd = 0.f; \
    bf16x8 a1b[4], kab[2]; float uub[4]; float egb; \
    bf16x8 a1c[4], kac[2]; float uuc[4]; float egc; \
    bf16x8 a1d[4], kad[2]; float uud[4]; float egd; \
    GDN_LOAD(LO_, 0, a1, ka, uu, eg, td); GDN_LOAD(LO_, 1, a1b, kab, uub, egb, tdb); GDN_LOAD(LO_, 2, a1c, kac, uuc, egc, tdc); \
    _Pragma("unroll 1") for (int n = 0; n < NCH; n += 4) { \
        GDN_LOAD(LO_, GDN_CL(n + 3), a1d, kad, uud, egd, tdd); \
        GDN_WAIT(LO_, a1, ka, uu, eg, td); \
        GDN_STEP(LO_, n, a1, ka, uu, eg); \
        GDN_LOAD(LO_, GDN_CL(n + 4), a1, ka, uu, eg, td); \
        GDN_WAIT(LO_, a1b, kab, uub, egb, tdb); \
        GDN_STEP(LO_, n + 1, a1b, kab, uub, egb); \
        GDN_LOAD(LO_, GDN_CL(n + 5), a1b, kab, uub, egb, tdb); \
        GDN_WAIT(LO_, a1c, kac, uuc, egc, tdc); \
        GDN_STEP(LO_, n + 2, a1c, kac, uuc, egc); \
        GDN_LOAD(LO_, GDN_CL(n + 6), a1c, kac, uuc, egc, tdc); \
        GDN_WAIT(LO_, a1d, kad, uud, egd, tdd); \
        GDN_STEP(LO_, n + 3, a1d, kad, uud, egd); \
    } \
    asm volatile("s_waitcnt vmcnt(0)" ::: "memory"); } while (0)
    if (lo) GDN_RUN(true); else GDN_RUN(false);
#undef GDN_RUN
#undef GDN_CL
#undef GDN_STEP
#undef GDN_LOAD
#undef GDN_WAIT
#undef GLD128
#undef GLD32
}

__device__ __forceinline__ void phase_gdn_out(const Params& p, int e, unsigned char* lds) {
    const int tid = opaque_tid(), wave = tid >> 6, lane = tid & 63, fr = lane & 15, fq = lane >> 4;
    float* sPart = (float*)lds;
    const bf16_t* QS = (const bf16_t*)(p.ws + G_QS); const bf16_t* ATT = (const bf16_t*)(p.ws + G_ATT);
    const bf16_t* SST = (const bf16_t*)(p.ws + G_SST); const bf16_t* VNT = (const bf16_t*)(p.ws + G_VNT);
    const bf16_t* P = (const bf16_t*)(p.ws + OFF_BIG); bf16_t* O = (bf16_t*)(p.ws + OFF_HY);
    const float* gg = p.gdn_norm_g + e * 128;
    const int rb = wave & 3, chh = wave >> 2;
    for (int item = blockIdx.x; item < 1024; item += gridDim.x) {
        const int h = item & 3, n = item >> 2, tok = n * 64 + rb * 16 + fr;
        bf16x8 qa[4], aa[2];
#pragma unroll
        for (int ks = 0; ks < 4; ++ks) qa[ks] = *(const bf16x8*)(QS + (size_t)tok * 512 + h * 128 + ks * 32 + fq * 8);
#pragma unroll
        for (int ks = 0; ks < 2; ++ks) aa[ks] = *(const bf16x8*)(ATT + ((size_t)(h * 256 + n) * 64 + rb * 16 + fr) * 64 + ks * 32 + fq * 8);
        bf16x8 sbf[4][4], vbf[4][2]; u32x2 zwf[4];
#pragma unroll
        for (int jb = 0; jb < 4; ++jb) { const int j = chh * 64 + jb * 16 + fr;
#pragma unroll
            for (int ks = 0; ks < 4; ++ks) sbf[jb][ks] = *(const bf16x8*)(SST + ((size_t)(h * 256 + n) * 128 + j) * 128 + ks * 32 + fq * 8);
#pragma unroll
            for (int ks = 0; ks < 2; ++ks) vbf[jb][ks] = *(const bf16x8*)(VNT + ((size_t)(h * 256 + n) * 128 + j) * 64 + ks * 32 + fq * 8);
            zwf[jb] = *(const u32x2*)(P + (size_t)tok * EV_N + 1536 + h * 128 + chh * 64 + jb * 16 + fq * 4); }
        f32x4 o[4]; float sq = 0.f;
#pragma unroll
        for (int jb = 0; jb < 4; ++jb) {
            f32x4 d = {0.f, 0.f, 0.f, 0.f};
#pragma unroll
            for (int ks = 0; ks < 4; ++ks) d = mfma16(sbf[jb][ks], qa[ks], d);
#pragma unroll
            for (int ks = 0; ks < 2; ++ks) d = mfma16(vbf[jb][ks], aa[ks], d);
            o[jb] = d;
            sq += d[0] * d[0] + d[1] * d[1] + d[2] * d[2] + d[3] * d[3];
        }
        sq += __shfl_xor(sq, 16); sq += __shfl_xor(sq, 32);
        if (fq == 0) sPart[chh * 64 + rb * 16 + fr] = sq;
        __syncthreads();
        const float rs = rsqrtf((sPart[rb * 16 + fr] + sPart[64 + rb * 16 + fr]) * (1.0f / 128.0f) + 1e-6f);
#pragma unroll
        for (int jb = 0; jb < 4; ++jb) { const int c0 = chh * 64 + jb * 16 + fq * 4;
            const u32x2 zw = zwf[jb];
            const float zz[4] = {bf2f((bf16_t)(zw.x & 0xffff)), bf2f((bf16_t)(zw.x >> 16)), bf2f((bf16_t)(zw.y & 0xffff)), bf2f((bf16_t)(zw.y >> 16))};
            const f32x4 g4 = *(const f32x4*)(gg + c0);
            u32x2 w; w.x = pack2(o[jb][0] * rs * g4[0] * silu_f(zz[0]), o[jb][1] * rs * g4[1] * silu_f(zz[1])); w.y = pack2(o[jb][2] * rs * g4[2] * silu_f(zz[2]), o[jb][3] * rs * g4[3] * silu_f(zz[3]));
            *(u32x2*)(O + (size_t)tok * 1024 + h * 128 + c0) = w; }
        __syncthreads();
    }
}

__device__ __forceinline__ void phase_attn(const Params& p, unsigned char* lds_) {
    const int tid = opaque_tid(), wave = __builtin_amdgcn_readfirstlane(tid >> 6), lane = tid & 63, fr = lane & 15, fq = lane >> 4;
    LAS unsigned char* lds = (LAS unsigned char*)lds_;
    const bf16_t* Qb = (const bf16_t*)(p.ws + M_Q); const bf16_t* KN = (const bf16_t*)(p.ws + M_KN); const bf16_t* VT = (const bf16_t*)(p.ws + M_VT); const bf16_t* KPE = (const bf16_t*)(p.ws + M_KPE);
    bf16_t* O = (bf16_t*)(p.ws + OFF_HY);
    const float C = 0.07216878364870323f * 1.4426950408889634f;
    const int sw = (fr >> 1) & 7;
    const int kbn = fr * 256 + ((fq ^ fr) << 4);
    const int kbp = 16384 + fr * 128 + ((fq ^ sw) << 4);
    const int vb0 = fr * 128 + (((fq >> 1) ^ sw) << 4) + (fq & 1) * 8;
    for (int u = blockIdx.x; u < 256; u += gridDim.x) {
        const int h = u & 3, x = u >> 2;
        const int blk = (wave < 4) ? x : 127 - x;
        const int rowbase = blk * 128 + (wave & 3) * 32;
        const int cw = rowbase >> 6;
        const int ktmax = 2 * (127 - x) + 1;
        unsigned okn[2], okp, ov[2];
#pragma unroll
        for (int j = 0; j < 2; ++j) { const int key = (wave * 2 + j) * 4 + (lane >> 4); okn[j] = (unsigned)(key * 512 + h * 128 + (((lane & 15) ^ (key & 15)) << 3)); }
        { const int key = wave * 8 + (lane >> 3); okp = (unsigned)(key * 64 + (((lane & 7) ^ ((key >> 1) & 7)) << 3)); }
#pragma unroll
        for (int j = 0; j < 2; ++j) { const int d = (wave * 2 + j) * 8 + (lane >> 3); ov[j] = (unsigned)((h * 128 + d) * SEQ + (((lane & 7) ^ ((d >> 1) & 7)) << 3)); }
        { LAS unsigned* po = (LAS unsigned*)(lds + 122880) + tid; po[0] = okn[0]; po[512] = okn[1]; po[1024] = okp; po[1536] = ov[0]; po[2048] = ov[1]; }
#define ATT_DMA(KT_) do { const int kc_ = (KT_) <= ktmax ? (KT_) : ktmax; LAS unsigned char* b_ = lds + ((KT_) % 3) * 40960; \
        int tq_ = tid; asm volatile("" : "+v"(tq_)); const LAS unsigned* po_ = (const LAS unsigned*)(lds + 122880) + tq_; unsigned okn[2], okp, ov[2]; okn[0] = po_[0]; okn[1] = po_[512]; okp = po_[1024]; ov[0] = po_[1536]; ov[1] = po_[2048]; const bf16_t* kn_ = KN + (size_t)kc_ * 64 * 512; const bf16_t* kq_ = KPE + (size_t)kc_ * 64 * 64; const bf16_t* vt_ = VT + (size_t)kc_ * 64; \
        _Pragma("unroll") for (int j = 0; j < 2; ++j) __builtin_amdgcn_global_load_lds((const unsigned*)(kn_ + okn[j]), (LAS unsigned*)(b_ + (wave * 2 + j) * 1024), 16, 0, 0); \
        __builtin_amdgcn_global_load_lds((const unsigned*)(kq_ + okp), (LAS unsigned*)(b_ + 16384 + wave * 1024), 16, 0, 0); \
        _Pragma("unroll") for (int j = 0; j < 2; ++j) __builtin_amdgcn_global_load_lds((const unsigned*)(vt_ + ov[j]), (LAS unsigned*)(b_ + 24576 + (wave * 2 + j) * 1024), 16, 0, 0); } while (0)
        ATT_DMA(0); ATT_DMA(1);
        bf16x8 qf[2][6];
#pragma unroll
        for (int qs = 0; qs < 2; ++qs) {
            const int row = rowbase + qs * 16 + fr; const bf16_t* qp = Qb + (size_t)row * 768 + h * 192 + fq * 8;
#pragma unroll
            for (int ks = 0; ks < 6; ++ks) qf[qs][ks] = *(const bf16x8*)(qp + ks * 32);
            const int pos = p.pos[row];
#pragma unroll
            for (int i = 0; i < 8; ++i) { float c, s; rope_cs(pos, fq * 8 + i, c, s); const float x1 = bf2f((bf16_t)qf[qs][4][i]), x2 = bf2f((bf16_t)qf[qs][5][i]);
                qf[qs][4][i] = (short)f2bf((x1 * c - x2 * s) * C); qf[qs][5][i] = (short)f2bf((x2 * c + x1 * s) * C); }
#pragma unroll
            for (int ks = 0; ks < 4; ++ks)
#pragma unroll
                for (int i = 0; i < 8; ++i) qf[qs][ks][i] = (short)f2bf(bf2f((bf16_t)qf[qs][ks][i]) * C);
        }
        f32x4 acc[2][8];
#pragma unroll
        for (int qs = 0; qs < 2; ++qs)
#pragma unroll
            for (int db = 0; db < 8; ++db) acc[qs][db] = (f32x4){0.f, 0.f, 0.f, 0.f};
        float mrun[2] = {-1e30f, -1e30f}, lrun[2] = {0.f, 0.f};
#pragma unroll 1
        for (int kt = 0; kt <= ktmax; ++kt) {
            asm volatile("s_waitcnt vmcnt(5) lgkmcnt(0)" ::: "memory");
            __builtin_amdgcn_s_barrier();
            asm volatile("" ::: "memory");
            ATT_DMA(kt + 2);
            if (kt <= cw) {
                LAS unsigned char* Kt = lds + (kt % 3) * 40960; LAS unsigned char* Vt = Kt + 24576;
                f32x4 st[2][4];
                const f32x4 zero4 = {0.f, 0.f, 0.f, 0.f};
#define ATT_KF(ks_, nb_) (((ks_) < 4) ? *(const LAS bf16x8*)(Kt + (kbn ^ ((ks_) << 6)) + (nb_) * 4096) : *(const LAS bf16x8*)(Kt + (kbp ^ (((ks_) - 4) << 6)) + (nb_) * 2048))
                bf16x8 kf[3][2];
#pragma unroll
                for (int hs = 0; hs < 2; ++hs)
#pragma unroll
                    for (int j = 0; j < 2; ++j) kf[hs][j] = ATT_KF(hs >> 1, (hs & 1) * 2 + j);
#pragma unroll
                for (int hs = 0; hs < 12; ++hs) {
                    const int ks = hs >> 1, nb0 = (hs & 1) * 2;
                    if (hs + 2 < 12) {
#pragma unroll
                        for (int j = 0; j < 2; ++j) kf[(hs + 2) % 3][j] = ATT_KF((hs + 2) >> 1, ((hs + 2) & 1) * 2 + j); }
                    __builtin_amdgcn_sched_barrier(0);
#pragma unroll
                    for (int j = 0; j < 2; ++j) { st[0][nb0 + j] = mfma16(kf[hs % 3][j], qf[0][ks], ks == 0 ? zero4 : st[0][nb0 + j]); st[1][nb0 + j] = mfma16(kf[hs % 3][j], qf[1][ks], ks == 0 ? zero4 : st[1][nb0 + j]); }
                    __builtin_amdgcn_sched_barrier(0);
                }
#undef ATT_KF
                bf16x8 bp[2][2];
#pragma unroll
                for (int qs = 0; qs < 2; ++qs) {
                    float mx = -1e30f;
#pragma unroll
                    for (int nb = 0; nb < 4; ++nb)
#pragma unroll
                        for (int i = 0; i < 4; ++i) mx = fmaxf(mx, st[qs][nb][i]);
                    mx = fmaxf(mx, __shfl_xor(mx, 16)); mx = fmaxf(mx, __shfl_xor(mx, 32));
                    const float mnew = fmaxf(mrun[qs], mx); const float alpha = __builtin_amdgcn_exp2f(mrun[qs] - mnew); mrun[qs] = mnew;
                    float ps = 0.f;
#pragma unroll
                    for (int nb = 0; nb < 4; ++nb)
#pragma unroll
                        for (int i = 0; i < 4; ++i) { const float pv = __builtin_amdgcn_exp2f(st[qs][nb][i] - mnew); ps += pv; st[qs][nb][i] = pv; }
                    lrun[qs] = lrun[qs] * alpha + ps;
                    if (__builtin_amdgcn_ballot_w64(alpha != 1.0f) != 0ull) {
#pragma unroll
                        for (int db = 0; db < 8; ++db) acc[qs][db] *= alpha; }
#pragma unroll
                    for (int kk = 0; kk < 2; ++kk) { u32x4 w; w.x = pack2(st[qs][2 * kk][0], st[qs][2 * kk][1]); w.y = pack2(st[qs][2 * kk][2], st[qs][2 * kk][3]);
                        w.z = pack2(st[qs][2 * kk + 1][0], st[qs][2 * kk + 1][1]); w.w = pack2(st[qs][2 * kk + 1][2], st[qs][2 * kk + 1][3]); bp[qs][kk] = __builtin_bit_cast(bf16x8, w); }
                }
#define ATT_VLO(s_) (*(const LAS u32x2*)(Vt + (vb0 ^ ((((s_) >> 3) * 4) << 4)) + ((s_) & 7) * 2048))
#define ATT_VHI(s_) (*(const LAS u32x2*)(Vt + (vb0 ^ ((((s_) >> 3) * 4 + 2) << 4)) + ((s_) & 7) * 2048))
                u32x2 vlo[3], vhi[3];
#pragma unroll
                for (int s = 0; s < 2; ++s) { vlo[s] = ATT_VLO(s); vhi[s] = ATT_VHI(s); }
#pragma unroll
                for (int s = 0; s < 16; ++s) {
                    const int kk = s >> 3, db = s & 7;
                    if (s + 2 < 16) { vlo[(s + 2) % 3] = ATT_VLO(s + 2); vhi[(s + 2) % 3] = ATT_VHI(s + 2); }
                    __builtin_amdgcn_sched_barrier(0);
                    u32x4 w; w.x = vlo[s % 3].x; w.y = vlo[s % 3].y; w.z = vhi[s % 3].x; w.w = vhi[s % 3].y; const bf16x8 a = __builtin_bit_cast(bf16x8, w);
                    acc[0][db] = mfma16(a, bp[0][kk], acc[0][db]); acc[1][db] = mfma16(a, bp[1][kk], acc[1][db]);
                    __builtin_amdgcn_sched_barrier(0);
                }
#undef ATT_VLO
#undef ATT_VHI
            }
        }
#undef ATT_DMA
        asm volatile("s_waitcnt vmcnt(0)" ::: "memory");
#pragma unroll
        for (int qs = 0; qs < 2; ++qs) {
            float l = lrun[qs]; l += __shfl_xor(l, 16); l += __shfl_xor(l, 32); const float inv = 1.0f / l;
            bf16_t* op = O + (size_t)(rowbase + qs * 16 + fr) * 1024 + 512 + h * 128 + fq * 4;
#pragma unroll
            for (int db = 0; db < 8; ++db) { u32x2 w; w.x = pack2(acc[qs][db][0] * inv, acc[qs][db][1] * inv); w.y = pack2(acc[qs][db][2] * inv, acc[qs][db][3] * inv); *(u32x2*)(op + db * 16) = w; }
        }
        __syncthreads();
    }
}

__device__ __forceinline__ void mixer_even(int e, int l, const XcdBarrier& xbar, unsigned char* lds) {
#define LP() const Params p = lds_params(lds)
    _Pragma("unroll 1") for (int rep = 0; rep < (PROBE == 14 ? 2 : 1); ++rep) { LP(); phase_mla_prep(p, e); }
_Pragma("unroll 1") for (int rep = 0; rep < (PROBE == 4 ? 2 : 1); ++rep) { LP(); phase_gdn_intra(p, e, lds); }
    GSYNC();
    if (blockIdx.x < 64 && (blockIdx.x & 7) < 4) { _Pragma("unroll 1") for (int rep = 0; rep < (PROBE == 2 ? 2 : 1); ++rep) { LP(); phase_gdn_scan(p, lds); } }
    else {
        const int Gp = gridDim.x - 32, c = (blockIdx.x < 64) ? (int)(blockIdx.x >> 3) * 4 + (int)(blockIdx.x & 7) - 4 : (int)blockIdx.x - 32;
#pragma unroll 1
        for (int j = 0; j < 3; ++j) {
            LP();
            const bf16_t* CQN = (const bf16_t*)(p.ws + M_CQN); const bf16_t* CKVN = (const bf16_t*)(p.ws + M_CKVN);
            const bf16_t* wuq = (const bf16_t*)(p.ws + W_MIX) + 2816 * 1024 + 1024 * 1024; const bf16_t* wukv = wuq + 768 * 384;
            pg8::Gemm g; bf16_t* Op; int ldc, off;
            if (j == 0) { g = pg8::Gemm{CQN, wuq, SEQ, 768, 384}; Op = (bf16_t*)(p.ws + M_Q); ldc = 768; off = 0; }
            else if (j == 1) { g = pg8::Gemm{CKVN, wukv, SEQ, 512, 256}; Op = (bf16_t*)(p.ws + M_KN); ldc = 512; off = 192 % Gp; }
            else { g = pg8::Gemm{wukv + 512 * 256, CKVN, 512, SEQ, 256}; Op = (bf16_t*)(p.ws + M_VT); ldc = SEQ; off = 320 % Gp; }
            pg8::StaticOrder S; S.init(g.M, g.N, Gp, (c + Gp - off) % Gp); pg8::EpiBf16Plain E{Op, ldc};
            pg8::gemm_phase<pg8::EpiBf16Plain, pg8::StaticOrder, false>((LAS unsigned char*)lds, g, S, E, nullptr);
        }
        { LP(); phase_convert(p, l + 1, (float*)lds, c, Gp); }
        if (l == 0) { LP(); phase_ada(p, (float*)lds, 144, 576, c, Gp); }
    }
    GSYNC();
    _Pragma("unroll 1") for (int rep = 0; rep < (PROBE == 15 ? 2 : 1); ++rep) { LP(); phase_gdn_out(p, e, lds); }
_Pragma("unroll 1") for (int rep = 0; rep < (PROBE == 1 ? 2 : 1); ++rep) { LP(); phase_attn(p, lds); }
    GSYNC();
#undef LP
}

#define SSD_CONV(P_, tok0_, cc_, cwt_, cb_, BODY) do { \
        const float w0_ = (cwt_)[cc_], w1_ = (cwt_)[3072 + (cc_)], w2_ = (cwt_)[6144 + (cc_)], w3_ = (cwt_)[9216 + (cc_)], b_ = (cb_)[cc_]; \
        const bf16_t* src_ = (P_) + (size_t)(tok0_) * OD_N + 2048 + (cc_); \
        float x0_ = 0.f, x1_ = 0.f, x2_ = 0.f; \
        if ((tok0_) > 0) { x0_ = bf2f(src_[-3 * OD_N]); x1_ = bf2f(src_[-2 * OD_N]); x2_ = bf2f(src_[-1 * OD_N]); } \
        _Pragma("unroll") for (int t = 0; t < 64; ++t) { const float x3_ = bf2f(src_[(size_t)t * OD_N]); const float y = silu_f(b_ + w0_ * x0_ + w1_ * x1_ + w2_ * x2_ + w3_ * x3_); BODY; x0_ = x1_; x1_ = x2_; x2_ = x3_; } } while (0)

__device__ __forceinline__ void phase_ssd_states(const Params& p, int o, unsigned char* lds) {
    const int tid = opaque_tid(), wave = tid >> 6, lane = tid & 63, fr = lane & 15, fq = lane >> 4;
    bf16_t* XTS = (bf16_t*)lds; bf16_t* BT = (bf16_t*)(lds + 73728); float* sSc = (float*)(lds + 73728 + 18432);
    const bf16_t* P = (const bf16_t*)(p.ws + OFF_BIG);
    bf16_t* STt = (bf16_t*)(p.ws + OFF_MIX); float* CD = (float*)(p.ws + OFF_CD);
    const float* cwt = p.ssd_conv_w + (size_t)o * 4 * 3072; const float* cb = p.ssd_conv_b + (size_t)o * 3072;
    for (int item = blockIdx.x; item < 1024; item += gridDim.x) {
        const int g = item & 3, n = item >> 2, tok0 = n * 64;
        { const int hh = g * 8 + wave; const float raw = bf2f(P[(size_t)(tok0 + lane) * OD_N + 5120 + hh]); const float dt = softplus_f(raw + p.ssd_dt_bias[o * 32 + hh]);
          const float da = -expf(p.ssd_A_log[o * 32 + hh]) * dt; const float acs = wave_incl_scan(da, lane); const float last = __shfl(acs, 63);
          sSc[wave * 64 + lane] = dt * __expf(last - acs); if (lane == 63) CD[n * 32 + hh] = __expf(acs); }
        __syncthreads();
        if (tid < 256) { const int ch = tid * 2, cc = g * 512 + ch; const float* sc = sSc + (ch >> 6) * 64; bf16_t* dst = XTS + ch * 72;
          CONV_PAIR(P, OD_N, 2048 + cc, tok0, cwt, 3072, cc, cb[cc], cb[cc + 1], { dst[t] = f2bf(y0 * sc[t]); dst[72 + t] = f2bf(y1 * sc[t]); }); }
        else if (tid < 320) { const int ch = (tid - 256) * 2, cc = 2048 + g * 128 + ch; bf16_t* dst = BT + ch * 72;
          CONV_PAIR(P, OD_N, 2048 + cc, tok0, cwt, 3072, cc, cb[cc], cb[cc + 1], { dst[t] = f2bf(y0); dst[72 + t] = f2bf(y1); }); }
        __syncthreads();
        { const int hh = g * 8 + wave;
#pragma unroll 1
          for (int pb = 0; pb < 4; ++pb) {
              bf16x8 xf[2];
#pragma unroll
              for (int ks = 0; ks < 2; ++ks) xf[ks] = *(const bf16x8*)(XTS + (wave * 64 + pb * 16 + fr) * 72 + ks * 32 + fq * 8);
#pragma unroll
              for (int nb = 0; nb < 8; ++nb) { f32x4 d = {0.f, 0.f, 0.f, 0.f};
#pragma unroll
                  for (int ks = 0; ks < 2; ++ks) { const bf16x8 bf = *(const bf16x8*)(BT + (nb * 16 + fr) * 72 + ks * 32 + fq * 8); d = mfma16(bf, xf[ks], d); }
                  u32x2 w; w.x = pack2(d[0], d[1]); w.y = pack2(d[2], d[3]);
                  *(u32x2*)(STt + (((size_t)n * 32 + hh) * 64 + pb * 16 + fr) * 128 + nb * 16 + fq * 4) = w; } } }
        __syncthreads();
    }
}

__device__ __forceinline__ void phase_ssd_scan(const Params& p) {
    unsigned* ST = (unsigned*)(p.ws + OFF_MIX); const float* CD = (const float*)(p.ws + OFF_CD);
    for (size_t e2 = (size_t)blockIdx.x * 512 + opaque_tid(); e2 < 131072; e2 += (size_t)gridDim.x * 512) {
        const int hh = (int)(e2 >> 12); unsigned* ptr = ST + e2; float h0 = 0.f, h1 = 0.f;
#pragma unroll 1
        for (int c0 = 0; c0 < NCH; c0 += 32) {
            unsigned w[32]; float cd[32];
#pragma unroll
            for (int j = 0; j < 32; ++j) { w[j] = ptr[(size_t)(c0 + j) * 131072]; cd[j] = CD[(c0 + j) * 32 + hh]; }
            __builtin_amdgcn_sched_barrier(0);
#pragma unroll
            for (int j = 0; j < 32; ++j) { ptr[(size_t)(c0 + j) * 131072] = pack2(h0, h1); h0 = h0 * cd[j] + bf2f((bf16_t)(w[j] & 0xffff)); h1 = h1 * cd[j] + bf2f((bf16_t)(w[j] >> 16)); }
        }
    }
}

__device__ __forceinline__ void phase_ssd_out(const Params& p, int o, unsigned char* lds) {
    const int tid = opaque_tid(), wave = tid >> 6, lane = tid & 63, fr = lane & 15, fq = lane >> 4;
    bf16_t* Cs = (bf16_t*)lds; bf16_t* Bs = (bf16_t*)(lds + 17408); float* CBm = (float*)(lds + 34816); bf16_t* XT = (bf16_t*)(lds + 52224);
    float* sDt = (float*)(lds + 125952); float* sAcs = sDt + 512; float* sSum = sAcs + 512;
    const bf16_t* P = (const bf16_t*)(p.ws + OFF_BIG); const bf16_t* HS = (const bf16_t*)(p.ws + OFF_MIX); bf16_t* Y = (bf16_t*)(p.ws + OFF_HY);
    const float* cwt = p.ssd_conv_w + (size_t)o * 4 * 3072; const float* cb = p.ssd_conv_b + (size_t)o * 3072;
    for (int item = blockIdx.x; item < 1024; item += gridDim.x) {
        const int g = item & 3, n = item >> 2, tok0 = n * 64;
        const int hh = g * 8 + wave;
        { const float raw = bf2f(P[(size_t)(tok0 + lane) * OD_N + 5120 + hh]); const float dt = softplus_f(raw + p.ssd_dt_bias[o * 32 + hh]);
          const float da = -expf(p.ssd_A_log[o * 32 + hh]) * dt; const float acs = wave_incl_scan(da, lane);
          sDt[wave * 64 + lane] = dt; sAcs[wave * 64 + lane] = acs; if (tid < 64) sSum[tid] = 0.f; }
        _Pragma("unroll 1") for (int rep = 0; rep < (PROBE == 10 ? 2 : 1); ++rep) {
        if (tid < 256) { const int ch = tid * 2, cc = g * 512 + ch; bf16_t* dst = XT + ch * 72;
          CONV_PAIR(P, OD_N, 2048 + cc, tok0, cwt, 3072, cc, cb[cc], cb[cc + 1], { dst[t] = f2bf(y0); dst[72 + t] = f2bf(y1); }); }
        else if (tid < 384) { const int idx = tid - 256; const bool isc = idx >= 64; const int ch = (idx & 63) * 2, cc = 2048 + (isc ? 512 : 0) + g * 128 + ch; bf16_t* dst = (isc ? Cs : Bs) + ch;
          CONV_PAIR(P, OD_N, 2048 + cc, tok0, cwt, 3072, cc, cb[cc], cb[cc + 1], { *(unsigned*)(dst + t * 136) = pack2(y0, y1); }); }
        }
        __syncthreads();
        for (int tI = wave * 2; tI < wave * 2 + 2; ++tI) { const int lb = tI >> 2, sb = tI & 3; f32x4 d = {0.f, 0.f, 0.f, 0.f};
#pragma unroll
            for (int ks = 0; ks < 4; ++ks) { const bf16x8 xb = *(const bf16x8*)(Bs + (sb * 16 + fr) * 136 + ks * 32 + fq * 8), yb = *(const bf16x8*)(Cs + (lb * 16 + fr) * 136 + ks * 32 + fq * 8); d = mfma16(xb, yb, d); }
            *(f32x4*)(CBm + (lb * 16 + fr) * 68 + sb * 16 + fq * 4) = d; }
        __syncthreads();
        _Pragma("unroll 1") for (int rep = 0; rep < (PROBE == 12 ? 2 : 1); ++rep) {
        const float* dts = sDt + wave * 64; const float* acss = sAcs + wave * 64; const float Dh = p.ssd_D[o * 32 + hh];
        bf16x8 hb[4][4];
#pragma unroll
        for (int pb = 0; pb < 4; ++pb)
#pragma unroll
            for (int ks = 0; ks < 4; ++ks) hb[pb][ks] = *(const bf16x8*)(HS + (((size_t)n * 32 + hh) * 64 + pb * 16 + fr) * 128 + ks * 32 + fq * 8);
        u32x2 zwf[4][4];
#pragma unroll
        for (int lb = 0; lb < 4; ++lb)
#pragma unroll
            for (int pb = 0; pb < 4; ++pb) zwf[lb][pb] = *(const u32x2*)(P + (size_t)(tok0 + lb * 16 + fr) * OD_N + hh * 64 + pb * 16 + fq * 4);
#pragma unroll
        for (int lb = 0; lb < 4; ++lb) {
            const int l = lb * 16 + fr; const float al = acss[l]; const float eal = __expf(al);
            bf16x8 ga[2], ca[4];
#pragma unroll
            for (int ks = 0; ks < 2; ++ks) { float gv[8];
#pragma unroll
                for (int i = 0; i < 8; ++i) { const int s = ks * 32 + fq * 8 + i; gv[i] = (s <= l) ? CBm[l * 68 + s] * __expf(al - acss[s]) * dts[s] : 0.f; }
                u32x4 w; w.x = pack2(gv[0], gv[1]); w.y = pack2(gv[2], gv[3]); w.z = pack2(gv[4], gv[5]); w.w = pack2(gv[6], gv[7]); ga[ks] = __builtin_bit_cast(bf16x8, w); }
#pragma unroll
            for (int ks = 0; ks < 4; ++ks) ca[ks] = *(const bf16x8*)(Cs + l * 136 + ks * 32 + fq * 8);
            float sq = 0.f;
#pragma unroll
            for (int pb = 0; pb < 4; ++pb) {
                f32x4 yd = {0.f, 0.f, 0.f, 0.f}, yo = {0.f, 0.f, 0.f, 0.f};
#pragma unroll
                for (int ks = 0; ks < 2; ++ks) { const bf16x8 xb = *(const bf16x8*)(XT + (wave * 64 + pb * 16 + fr) * 72 + ks * 32 + fq * 8); yd = mfma16(xb, ga[ks], yd); }
#pragma unroll
                for (int ks = 0; ks < 4; ++ks) yo = mfma16(hb[pb][ks], ca[ks], yo);
                const u32x2 zw = zwf[lb][pb];
                const float zz[4] = {bf2f((bf16_t)(zw.x & 0xffff)), bf2f((bf16_t)(zw.x >> 16)), bf2f((bf16_t)(zw.y & 0xffff)), bf2f((bf16_t)(zw.y >> 16))};
                float v[4];
#pragma unroll
                for (int i = 0; i < 4; ++i) { const float xv = bf2f(XT[(wave * 64 + pb * 16 + fq * 4 + i) * 72 + l]); v[i] = (yd[i] + eal * yo[i] + Dh * xv) * silu_f(zz[i]); sq += v[i] * v[i]; }
                u32x2 w; w.x = pack2(v[0], v[1]); w.y = pack2(v[2], v[3]);
                *(u32x2*)(Y + (size_t)(tok0 + l) * 2048 + hh * 64 + pb * 16 + fq * 4) = w;
            }
            sq += __shfl_xor(sq, 16); sq += __shfl_xor(sq, 32);
            if (fq == 0 && rep == (PROBE == 12 ? 1 : 0)) atomicAdd(&sSum[l], sq);
        }
        }
        __syncthreads();
        const float* ng = p.ssd_norm_g + (size_t)o * 2048 + hh * 64;
        u32x2 yr[4][4];
#pragma unroll
        for (int lb = 0; lb < 4; ++lb)
#pragma unroll
            for (int pb = 0; pb < 4; ++pb) yr[lb][pb] = *(const u32x2*)(Y + (size_t)(tok0 + lb * 16 + fr) * 2048 + hh * 64 + pb * 16 + fq * 4);
#pragma unroll
        for (int lb = 0; lb < 4; ++lb) { const int l = lb * 16 + fr; const float rs = rsqrtf(sSum[l] * (1.0f / 512.0f) + 1e-6f);
#pragma unroll
            for (int pb = 0; pb < 4; ++pb) { const f32x4 g4 = *(const f32x4*)(ng + pb * 16 + fq * 4);
                u32x2* yp = (u32x2*)(Y + (size_t)(tok0 + l) * 2048 + hh * 64 + pb * 16 + fq * 4); const u32x2 r = yr[lb][pb];
                u32x2 w; w.x = pack2(bf2f((bf16_t)(r.x & 0xffff)) * rs * g4[0], bf2f((bf16_t)(r.x >> 16)) * rs * g4[1]); w.y = pack2(bf2f((bf16_t)(r.y & 0xffff)) * rs * g4[2], bf2f((bf16_t)(r.y >> 16)) * rs * g4[3]);
                *yp = w; } }
        __syncthreads();
    }
}

__device__ __forceinline__ void mixer_odd(int o, const XcdBarrier& xbar, unsigned char* lds) {
#define LP() const Params p = lds_params(lds)
_Pragma("unroll 1") for (int rep = 0; rep < (PROBE == 6 ? 2 : 1); ++rep) { LP(); phase_ssd_states(p, o, lds); }
    GSYNC();
    { LP(); phase_ssd_scan(p); }
    GSYNC();
_Pragma("unroll 1") for (int rep = 0; rep < (PROBE == 5 ? 2 : 1); ++rep) { LP(); phase_ssd_out(p, o, lds); }
    GSYNC();
#undef LP
}

__global__ void __launch_bounds__(512) mega(Params pk) {
    extern __shared__ __attribute__((aligned(16))) unsigned char lds[];
    cg::grid_group grid = cg::this_grid();
    LAS unsigned char* l3 = (LAS unsigned char*)lds;
    float* ldsf = (float*)lds;
    const int G = gridDim.x, bid = blockIdx.x;
    if (threadIdx.x == 0) {
        unsigned long long* dst = (unsigned long long*)(lds + LDS_PARAMS_OFF);
        dst[0] = (unsigned long long)pk.x; dst[1] = (unsigned long long)pk.c; dst[2] = (unsigned long long)pk.pos;
        const float* const* fp = &pk.ada_w;
        for (int i = 0; i < 25; ++i) dst[3 + i] = (unsigned long long)fp[i];
        dst[28] = (unsigned long long)pk.out; dst[29] = (unsigned long long)pk.ws;
    }
    if (threadIdx.x == 1) { ((LAS unsigned*)l3)[147440 / 4] = 0u; ((LAS unsigned*)l3)[147444 / 4] = 0u; }
    __syncthreads();
    if (bid == 0) { unsigned* bw = (unsigned*)(pk.ws + OFF_BAR); for (int i = threadIdx.x; i < 4096; i += 512) bw[i] = 0u; }
#define LP() const Params p = lds_params(lds)
    _Pragma("unroll 1") for (int rep = 0; rep < (PROBE == 13 ? 2 : 1); ++rep) { LP(); phase_ada(p, ldsf, 0, 144, bid, G); }
    grid.sync();
    XcdBarrier xbar = xcd_barrier_post((unsigned*)(pk.ws + OFF_BAR), (volatile LAS unsigned*)(l3 + 147440));
#pragma unroll 1
    for (int l = 0; l < 4; ++l) {
        const bool even = (l & 1) == 0; const int e = l >> 1;
#pragma unroll 1
        for (int sub = 0; sub < 3; ++sub) {
            if (sub == 0 && even) { _Pragma("unroll 1") for (int rep = 0; rep < (PROBE == 7 ? 2 : 1); ++rep) { LP(); phase_convert(p, l, ldsf, bid, G); } }
            _Pragma("unroll 1") for (int rep = 0; rep < (PROBE == 8 ? 2 : 1); ++rep) { LP(); const float* ml = (const float*)(p.ws + OFF_MOD) + l * 9216 + sub * 3072;
              phase_norm((l == 0 && sub == 0) ? p.x : p.out, (bf16_t*)(p.ws + OFF_HY), p.norm_g + (l * 3 + sub) * 1024, ml, ml + 1024); }
            GSYNC();
            const bf16_t* A2; const bf16_t* B2; int K2; float coef;
            if (sub != 1) {
                _Pragma("unroll 1") for (int rep = 0; rep < (PROBE == 3 ? 2 : 1); ++rep) { LP(); const bf16_t* W13 = (const bf16_t*)(p.ws + (size_t)(l & 1) * W_REGION2 + (sub ? W_13B : W_13A));
                  pg8::Gemm g{(const bf16_t*)(p.ws + OFF_HY), W13, SEQ, 5632, 1024}; pg8::StaticOrder S; S.init(SEQ, 5632, G, bid); pg8::EpiSwiglu E{(bf16_t*)(p.ws + OFF_BIG), DFF};
                  pg8::gemm_phase<pg8::EpiSwiglu, pg8::StaticOrder, false>(l3, g, S, E, nullptr); }
                GSYNC();
                { LP(); A2 = (const bf16_t*)(p.ws + OFF_BIG); B2 = (const bf16_t*)(p.ws + (size_t)(l & 1) * W_REGION2 + (sub ? W_2B : W_2A)); } K2 = DFF; coef = 0.5f;
            } else {
                const int Nin = even ? EV_N : OD_N;
                _Pragma("unroll 1") for (int rep = 0; rep < (PROBE == 17 ? 2 : 1); ++rep) { LP(); pg8::Gemm g{(const bf16_t*)(p.ws + OFF_HY), (const bf16_t*)(p.ws + (size_t)(l & 1) * W_REGION2 + W_MIX), SEQ, Nin, 1024}; pg8::StaticOrder S; S.init(SEQ, Nin, G, bid); pg8::EpiBf16Plain E{(bf16_t*)(p.ws + OFF_BIG), Nin};
                  pg8::gemm_phase<pg8::EpiBf16Plain, pg8::StaticOrder, false>(l3, g, S, E, nullptr); }
                GSYNC();
                if (even) mixer_even(e, l, xbar, lds); else mixer_odd(e, xbar, lds);
                { LP(); A2 = (const bf16_t*)(p.ws + OFF_HY); B2 = (const bf16_t*)(p.ws + (size_t)(l & 1) * W_REGION2 + W_MIX) + (even ? 2816 * 1024 : 5376 * 1024); } K2 = even ? 1024 : 2048;
                coef = 1.0f;
            }
            { LP(); const float* ml = (const float*)(p.ws + OFF_MOD) + l * 9216 + sub * 3072;
              pg8::Gemm g{A2, B2, SEQ, 1024, K2}; pg8::StaticOrder S; S.init(SEQ, 1024, G, bid); pg8::EpiResid E{p.out, (l == 0 && sub == 0) ? p.x : p.out, ml + 2048, coef};
              pg8::gemm_phase<pg8::EpiResid, pg8::StaticOrder, false>(l3, g, S, E, nullptr); }
            GSYNC();
        }
    }
    { LP(); phase_final(p.out, p.final_g); }
}

extern "C" void kernel_launch(void* const* d_in, const int* in_sizes, int n_in, void* d_out, int out_size, void* d_ws, size_t ws_size, hipStream_t stream) {
    static int grid_blocks = 0;
    if (grid_blocks == 0) {
        int dev = 0, cus = 0, per_cu = 0;
        hipGetDevice(&dev);
        hipDeviceGetAttribute(&cus, hipDeviceAttributeMultiprocessorCount, dev);
        if (hipFuncSetAttribute((const void*)mega, hipFuncAttributeMaxDynamicSharedMemorySize, LDS_BYTES) != hipSuccess) { fprintf(stderr, "hipFuncSetAttribute failed\n"); grid_blocks = -1; return; }
        hipOccupancyMaxActiveBlocksPerMultiprocessor(&per_cu, (const void*)mega, 512, LDS_BYTES);
        (void)hipGetLastError();
        if (per_cu < 1) per_cu = 1;
        grid_blocks = cus * per_cu;
        if (ws_size < WS_NEED || n_in != 28) { fprintf(stderr, "kernel_launch: ws %zu < %zu or n_in %d\n", ws_size, (size_t)WS_NEED, n_in); grid_blocks = -1; return; }
    }
    if (grid_blocks < 0) return;
    Params p{};
    p.x = (const float*)d_in[0]; p.c = (const float*)d_in[1]; p.pos = (const int*)d_in[2];
    const float** fp = &p.ada_w;
    for (int i = 0; i < 25; ++i) fp[i] = (const float*)d_in[3 + i];
    p.out = (float*)d_out; p.ws = (unsigned char*)d_ws;
    void* args[] = {&p};
    hipError_t e = hipLaunchCooperativeKernel((const void*)mega, dim3(grid_blocks), dim3(512), args, LDS_BYTES, stream);
    if (e != hipSuccess) fprintf(stderr, "cooperative launch failed: %s (grid %d)\n", hipGetErrorString(e), grid_blocks);
}
```

```cpp
#include <hip/hip_runtime.h>
#include <hip/hip_cooperative_groups.h>
#include <cstdio>
namespace cg = cooperative_groups;

#define LAS __attribute__((address_space(3)))
typedef unsigned short bf16_t;
typedef short bf16x8 __attribute__((ext_vector_type(8)));
typedef float f32x4 __attribute__((ext_vector_type(4)));
typedef unsigned u32x4 __attribute__((ext_vector_type(4)));
typedef unsigned u32x2 __attribute__((ext_vector_type(2)));

constexpr int PROBE = 0;
constexpr int SEQ = 16384, DM = 1024, DFF = 2816, NCH = 256;
constexpr int EV_N = 2816, OD_N = 5376;
constexpr int LDS_BYTES = 147456;
constexpr size_t MiB = 1048576;
constexpr size_t OFF_MOD = 0;
constexpr size_t OFF_EGL = 256 * 1024;
constexpr size_t OFF_CD  = 320 * 1024;
constexpr size_t OFF_W   = 1 * MiB;
constexpr size_t W_13A = OFF_W, W_13B = W_13A + 11534336, W_2A = W_13B + 11534336, W_2B = W_2A + 5767168, W_MIX = W_2B + 5767168;
constexpr size_t OFF_HY  = 53 * MiB;
constexpr size_t OFF_BIG = 117 * MiB;
constexpr size_t OFF_MLA = OFF_BIG + 88 * MiB;
constexpr size_t M_CQN = OFF_MLA, M_CKVN = M_CQN + 12 * MiB, M_KPE = M_CKVN + 8 * MiB, M_Q = M_KPE + 2 * MiB, M_KN = M_Q + 24 * MiB, M_VT = M_KN + 16 * MiB;
constexpr size_t OFF_MIX = 285 * MiB;
constexpr size_t G_U = OFF_MIX, G_W = G_U + 32 * MiB, G_QS = G_W + 16 * MiB, G_KET = G_QS + 16 * MiB, G_ATT = G_KET + 16 * MiB, G_ORAW = G_ATT + 8 * MiB;
constexpr size_t G_SST = G_ORAW, G_VNT = G_SST + 32 * MiB;
constexpr size_t W_REGION2 = 420 * MiB;
constexpr size_t WS_NEED = 473 * MiB;

struct Params {
    const float* x; const float* c; const int* pos;
    const float *ada_w, *ada_b, *norm_g, *w1, *w3, *w2, *ev_w_in, *gdn_conv_w, *gdn_A_log, *gdn_dt_bias, *gdn_norm_g,
        *mla_q_norm_g, *mla_w_uq, *mla_kv_norm_g, *mla_w_ukv, *ev_w_out, *ssd_w_in, *ssd_conv_w, *ssd_conv_b, *ssd_A_log, *ssd_dt_bias,
        *ssd_D, *ssd_norm_g, *ssd_w_out, *final_g;
    float* out; unsigned char* ws;
};

__device__ __forceinline__ float bf2f(bf16_t b) { return __uint_as_float(((unsigned)b) << 16); }
typedef float f32x2_t __attribute__((ext_vector_type(2)));
typedef __bf16 bf16x2_t __attribute__((ext_vector_type(2)));
__device__ __forceinline__ unsigned pack2(float lo, float hi) { const f32x2_t v = {lo, hi}; const bf16x2_t b = __builtin_convertvector(v, bf16x2_t); return __builtin_bit_cast(unsigned, b); }
__device__ __forceinline__ bf16_t f2bf(float f) { return (bf16_t)(pack2(f, 0.f) & 0xffffu); }
__device__ __forceinline__ float silu_f(float x) { return x * __builtin_amdgcn_rcpf(1.0f + __expf(-x)); }
__device__ __forceinline__ float sigmoid_f(float x) { return __builtin_amdgcn_rcpf(1.0f + __expf(-x)); }
__device__ __forceinline__ float softplus_f(float x) { return fmaxf(x, 0.f) + log1pf(__expf(-fabsf(x))); }
__device__ __forceinline__ float wave_sum(float v) {
#pragma unroll
    for (int o = 32; o > 0; o >>= 1) v += __shfl_xor(v, o);
    return v;
}
__device__ __forceinline__ float wave_incl_scan(float v, int lane) {
#pragma unroll
    for (int o = 1; o < 64; o <<= 1) { float t = __shfl_up(v, o); if (lane >= o) v += t; }
    return v;
}
__device__ __forceinline__ f32x4 mfma16(bf16x8 a, bf16x8 b, f32x4 c) { return __builtin_amdgcn_mfma_f32_16x16x32_bf16(a, b, c, 0, 0, 0); }

__constant__ double ROPE_INV_FREQ[32] = {1.0, 0.7498942093324559, 0.5623413251903491, 0.4216965034285822, 0.31622776601683794, 0.23713737056616552, 0.1778279410038923, 0.1333521432163324, 0.1, 0.07498942093324558, 0.05623413251903491, 0.042169650342858224, 0.03162277660168379, 0.023713737056616554, 0.01778279410038923, 0.01333521432163324, 0.01, 0.007498942093324558, 0.005623413251903491, 0.004216965034285823, 0.0031622776601683794, 0.0023713737056616554, 0.0017782794100389228, 0.001333521432163324, 0.001, 0.0007498942093324559, 0.0005623413251903491, 0.00042169650342858224, 0.00031622776601683794, 0.00023713737056616554, 0.00017782794100389227, 0.0001333521432163324};
__device__ __forceinline__ void rope_cs(int pos, int idx, float& c, float& s) {
    double t = (double)pos * ROPE_INV_FREQ[idx] * 0.15915494309189535;
    t -= floor(t);
    float f = (float)t;
    s = __builtin_amdgcn_sinf(f); c = __builtin_amdgcn_cosf(f);
}

__device__ __forceinline__ int opaque_tid() { int t = threadIdx.x; asm volatile("" : "+v"(t)); return t; }

constexpr int LDS_PARAMS_OFF = 147200;
__device__ __forceinline__ Params lds_params(const unsigned char* lds) {
    Params q;
    const LAS unsigned* w = (const LAS unsigned*)(LAS unsigned char*)lds + LDS_PARAMS_OFF / 4;
    unsigned long long v[31];
#pragma unroll
    for (int i = 0; i < 31; ++i) { const unsigned lo = __builtin_amdgcn_readfirstlane(w[2 * i]), hi = __builtin_amdgcn_readfirstlane(w[2 * i + 1]); v[i] = ((unsigned long long)hi << 32) | lo; }
    q.x = (const float*)v[0]; q.c = (const float*)v[1]; q.pos = (const int*)v[2];
    q.ada_w = (const float*)v[3];
    q.ada_b = (const float*)v[4];
    q.norm_g = (const float*)v[5];
    q.w1 = (const float*)v[6];
    q.w3 = (const float*)v[7];
    q.w2 = (const float*)v[8];
    q.ev_w_in = (const float*)v[9];
    q.gdn_conv_w = (const float*)v[10];
    q.gdn_A_log = (const float*)v[11];
    q.gdn_dt_bias = (const float*)v[12];
    q.gdn_norm_g = (const float*)v[13];
    q.mla_q_norm_g = (const float*)v[14];
    q.mla_w_uq = (const float*)v[15];
    q.mla_kv_norm_g = (const float*)v[16];
    q.mla_w_ukv = (const float*)v[17];
    q.ev_w_out = (const float*)v[18];
    q.ssd_w_in = (const float*)v[19];
    q.ssd_conv_w = (const float*)v[20];
    q.ssd_conv_b = (const float*)v[21];
    q.ssd_A_log = (const float*)v[22];
    q.ssd_dt_bias = (const float*)v[23];
    q.ssd_D = (const float*)v[24];
    q.ssd_norm_g = (const float*)v[25];
    q.ssd_w_out = (const float*)v[26];
    q.final_g = (const float*)v[27];
    q.out = (float*)v[28]; q.ws = (unsigned char*)v[29];
    return q;
}

#define XB_TMO      128
#define XB_XCNT(j)  (256  + 64 * (j))
#define XB_XSUB(j)  (1280 + 64 * (j))
#define XB_XGEN(j)  (2304 + 64 * (j))
#define XB_TOP      3328
#define XB_TOPGEN   3392
#define XCD_BAR_WORDS 3456
#define XB_SPIN_CAP (1u << 18)

__device__ __forceinline__ unsigned xb_ld(unsigned* p)              { return __hip_atomic_load(p, __ATOMIC_RELAXED, __HIP_MEMORY_SCOPE_AGENT); }
__device__ __forceinline__ unsigned xb_add(unsigned* p, unsigned v) { return __hip_atomic_fetch_add(p, v, __ATOMIC_RELAXED, __HIP_MEMORY_SCOPE_AGENT); }
__device__ __forceinline__ unsigned xb_xcc_id() { return (unsigned)__builtin_amdgcn_s_getreg((3 << 11) | 20) & 0xFu; }
#define XB_SPIN(cond, bar) do { unsigned _sp = 0; while (cond) { if (_sp < 64u) __builtin_amdgcn_s_sleep(1); else __builtin_amdgcn_s_sleep(32); \
    if ((++_sp & 255u) == 0u) { if (xb_ld(&(bar)[XB_TMO])) break; if (_sp > XB_SPIN_CAP) { atomicAdd(&(bar)[XB_TMO], 1u); break; } } } } while (0)

struct XcdBarrier {
    unsigned* bar; unsigned x;
    volatile LAS unsigned* st;
};

__device__ __forceinline__ XcdBarrier xcd_barrier_post(unsigned* bar, volatile LAS unsigned* st) {
    XcdBarrier b; b.bar = bar; b.x = xb_xcc_id(); b.st = st;
    if (threadIdx.x == 0) (void)xb_add(&bar[XB_XCNT(b.x)], 1u);
    return b;
}
__device__ __forceinline__ void xcd_barrier_complete(unsigned* bar, unsigned x, unsigned& nloc, unsigned& nx) {
    const unsigned G = gridDim.x * gridDim.y * gridDim.z;
    unsigned sum, cnt, mine, sp = 0u;
    for (;;) {
        sum = 0u; cnt = 0u; mine = 0u;
#pragma unroll
        for (unsigned j = 0; j < 16; ++j) { const unsigned c = xb_ld(&bar[XB_XCNT(j)]); sum += c; cnt += (c > 0u) ? 1u : 0u; mine = (j == x) ? c : mine; }
        if (sum == G) break;
        __builtin_amdgcn_s_sleep(1);
        if ((++sp & 255u) == 0u) { if (xb_ld(&bar[XB_TMO])) break; if (sp > XB_SPIN_CAP) { atomicAdd(&bar[XB_TMO], 1u); break; } }
    }
    nloc = mine > 0u ? mine : 1u; nx = cnt > 0u ? cnt : 1u;
}

__device__ __forceinline__ void xcd_barrier(const XcdBarrier& b) {
    asm volatile("s_waitcnt vmcnt(0)" ::: "memory");
    __syncthreads();
    if (threadIdx.x == 0) {
        unsigned* bar = b.bar;
        __builtin_amdgcn_s_waitcnt(0);
        unsigned nloc = b.st[0], nx = b.st[1];
        if (nloc == 0u) { xcd_barrier_complete(bar, b.x, nloc, nx); b.st[0] = nloc; b.st[1] = nx; }
        const unsigned old = xb_add(&bar[XB_XSUB(b.x)], 1u);
        const unsigned gen = old / nloc;
        if (old + 1u == (gen + 1u) * nloc) {
            __builtin_amdgcn_fence(__ATOMIC_RELEASE, "agent");
            asm volatile("s_waitcnt vmcnt(0)" ::: "memory");
            const unsigned og = xb_add(&bar[XB_TOP], 1u);
            const unsigned tg = og / nx;
            if (og + 1u == (tg + 1u) * nx) xb_add(&bar[XB_TOPGEN], 1u);
            else XB_SPIN(xb_ld(&bar[XB_TOPGEN]) == tg, bar);
            __builtin_amdgcn_fence(__ATOMIC_ACQUIRE, "agent");
            xb_add(&bar[XB_XGEN(b.x)], 1u);
            asm volatile("s_waitcnt vmcnt(0)" ::: "memory");
        } else {
            XB_SPIN(xb_ld(&bar[XB_XGEN(b.x)]) == gen, bar);
            __builtin_amdgcn_fence(__ATOMIC_ACQUIRE, "agent");
            asm volatile("s_waitcnt vmcnt(0)" ::: "memory");
        }
    }
    __syncthreads();
}


#define GSYNC() do { xcd_barrier(xbar); if (PROBE == 9) xcd_barrier(xbar); } while (0)
constexpr size_t OFF_BAR = 384 * 1024;

#define CONV_PAIR(P_, pitch_, col_, tok0_, w_, wstride_, cc_, b0_, b1_, BODY) do { \
        const unsigned* src_ = (const unsigned*)((P_) + (size_t)(tok0_) * (pitch_) + (col_)); \
        unsigned raw_[67]; \
        _Pragma("unroll") for (int t = 0; t < 67; ++t) raw_[t] = ((t >= 3) || (tok0_) > 0) ? src_[((long)t - 3) * ((pitch_) / 2)] : 0u; \
        const float wa0_ = (w_)[cc_], wa1_ = (w_)[(wstride_) + (cc_)], wa2_ = (w_)[2 * (wstride_) + (cc_)], wa3_ = (w_)[3 * (wstride_) + (cc_)]; \
        const float wb0_ = (w_)[(cc_) + 1], wb1_ = (w_)[(wstride_) + (cc_) + 1], wb2_ = (w_)[2 * (wstride_) + (cc_) + 1], wb3_ = (w_)[3 * (wstride_) + (cc_) + 1]; \
        __builtin_amdgcn_sched_barrier(0); \
        _Pragma("unroll") for (int t = 0; t < 64; ++t) { \
            const float y0 = silu_f((b0_) + wa0_ * __uint_as_float(raw_[t] << 16) + wa1_ * __uint_as_float(raw_[t + 1] << 16) + wa2_ * __uint_as_float(raw_[t + 2] << 16) + wa3_ * __uint_as_float(raw_[t + 3] << 16)); \
            const float y1 = silu_f((b1_) + wb0_ * __uint_as_float(raw_[t] & 0xffff0000u) + wb1_ * __uint_as_float(raw_[t + 1] & 0xffff0000u) + wb2_ * __uint_as_float(raw_[t + 2] & 0xffff0000u) + wb3_ * __uint_as_float(raw_[t + 3] & 0xffff0000u)); \
            BODY; } } while (0)
namespace pg8 {
#define PG8_LAS __attribute__((address_space(3)))
typedef unsigned short bf16_t;
typedef short bf16x8 __attribute__((ext_vector_type(8)));
typedef float f32x4 __attribute__((ext_vector_type(4)));
typedef unsigned u32x4 __attribute__((ext_vector_type(4)));
constexpr int BM = 256, BK = 64, HALF = 128, HTB = HALF * BK * 2  , STAGE_BYTES = 8 * HTB, NXCD = 8, WGM = 8;

__host__ __device__ __forceinline__ int lds_byte(int r, int c) { const int st = (r >> 4) * 2 + (c >> 5), rr = r & 15, cc = c & 31, ob = rr * 64 + cc * 2; return st * 1024 + (ob ^ (((ob >> 9) & 1) << 5)); }
__host__ __device__ __forceinline__ void stage_rc(int b, int& R, int& C) { const int st = b / 1024, sb = b % 1024, swz = sb ^ (((sb >> 9) & 1) << 5); R = (st >> 1) * 16 + swz / 64; C = (st & 1) * 32 + (swz % 64) / 2; }
__host__ __device__ __forceinline__ int perm32(int rho) { const int n = rho >> 4, i = rho & 15; return 8 * (i >> 2) + 4 * n + (i & 3); }

struct Unit { int pm, pn; };
struct Gemm { const bf16_t* A; const bf16_t* Bt; int M, N, K; };

struct StaticOrder {
    int nM, nN, nwg, G, c;
    __host__ __device__ void init(int M, int N, int G_, int c_) { nM = M / BM; nN = N / BM; nwg = nM * nN; G = G_; c = c_; }
    __host__ __device__ bool next(int i, Unit& u) const {
        const long L = (long)i * G + c; if (L >= nwg) return false;
        int wgid = (int)L; { const int q = nwg / NXCD, r = nwg % NXCD, xcd = wgid % NXCD, off = wgid / NXCD; wgid = (xcd < r ? xcd * (q + 1) : r * (q + 1) + (xcd - r) * q) + off; }
        const int nig = WGM * nN, gid = wgid / nig, fm = gid * WGM, gsz = (nM - fm) < WGM ? (nM - fm) : WGM;
        u.pm = fm + ((wgid % nig) % gsz); u.pn = (wgid % nig) / gsz; return true;
    }
    __device__ __forceinline__ void a_ready(const Unit&) const {}
    __device__ __forceinline__ void done(const Unit&) const {}
};
__device__ __forceinline__ unsigned cvt_pk_bf16(float lo, float hi) { unsigned r; asm volatile("v_cvt_pk_bf16_f32 %0, %1, %2" : "=v"(r) : "v"(lo), "v"(hi)); return r; }
struct EpiBf16Plain {
    static constexpr bool PERM = true, AFTER_DRAIN = false;
    bf16_t* O; int ldc;
    __device__ __forceinline__ void operator()(const f32x4 (&acc)[2][2][4][2], const Unit& u, int wr, int wc, int fr, int fq) const {
        const int row0 = u.pm * BM + wr * 64 + fr; const int col0 = u.pn * BM + wc * 32 + 8 * fq;
#pragma unroll
        for (int ai = 0; ai < 2; ++ai)
#pragma unroll
            for (int m = 0; m < 4; ++m) { bf16_t* rowp = O + (size_t)(row0 + ai * HALF + m * 16) * ldc + col0;
#pragma unroll
                for (int bj = 0; bj < 2; ++bj) { const f32x4 v0 = acc[ai][bj][m][0], v1 = acc[ai][bj][m][1];
                    u32x4 w; w.x = cvt_pk_bf16(v0[0], v0[1]); w.y = cvt_pk_bf16(v0[2], v0[3]); w.z = cvt_pk_bf16(v1[0], v1[1]); w.w = cvt_pk_bf16(v1[2], v1[3]);
                    *(u32x4*)(rowp + bj * HALF) = w; } }
    }
};
struct EpiSwiglu {
    static constexpr bool PERM = true, AFTER_DRAIN = false;
    bf16_t* U; int ldc;
    __device__ __forceinline__ void operator()(const f32x4 (&acc)[2][2][4][2], const Unit& u, int wr, int wc, int fr, int fq) const {
        const int row0 = u.pm * BM + wr * 64 + fr; const int col0 = u.pn * HALF + wc * 32 + 8 * fq;
#pragma unroll
        for (int ai = 0; ai < 2; ++ai)
#pragma unroll
            for (int m = 0; m < 4; ++m) { bf16_t* rowp = U + (size_t)(row0 + ai * HALF + m * 16) * ldc + col0;
                float r[8];
#pragma unroll
                for (int n = 0; n < 2; ++n)
#pragma unroll
                    for (int j = 0; j < 4; ++j) { const float a = acc[ai][0][m][n][j], b = acc[ai][1][m][n][j]; r[n * 4 + j] = a * __builtin_amdgcn_rcpf(1.0f + __expf(-a)) * b; }
                u32x4 w; w.x = cvt_pk_bf16(r[0], r[1]); w.y = cvt_pk_bf16(r[2], r[3]); w.z = cvt_pk_bf16(r[4], r[5]); w.w = cvt_pk_bf16(r[6], r[7]);
                *(u32x4*)rowp = w; }
    }
};
struct EpiResid {
    static constexpr bool PERM = false, AFTER_DRAIN = false;
    float* X; const float* Xin; const float* gate; float coef;
    __device__ __forceinline__ void operator()(const f32x4 (&acc)[2][2][4][2], const Unit& u, int wr, int wc, int fr, int fq) const {
        const int row0 = u.pm * BM + wr * 64 + fr, col0 = u.pn * BM + wc * 32 + 4 * fq;
        f32x4 gv[2][2];
#pragma unroll
        for (int bj = 0; bj < 2; ++bj)
#pragma unroll
            for (int n = 0; n < 2; ++n) gv[bj][n] = *(const f32x4*)(gate + col0 + bj * HALF + n * 16) * coef;
#pragma unroll
        for (int am = 0; am < 4; ++am) {
            const int ai = am >> 1, m0 = (am & 1) * 2;
            f32x4 xv[2][2][2];
#pragma unroll
            for (int mm = 0; mm < 2; ++mm) { const float* rowp = Xin + (size_t)(row0 + ai * HALF + (m0 + mm) * 16) * 1024 + col0;
#pragma unroll
                for (int bj = 0; bj < 2; ++bj)
#pragma unroll
                    for (int n = 0; n < 2; ++n) xv[mm][bj][n] = *(const f32x4*)(rowp + bj * HALF + n * 16); }
#pragma unroll
            for (int mm = 0; mm < 2; ++mm) { float* rowp = X + (size_t)(row0 + ai * HALF + (m0 + mm) * 16) * 1024 + col0;
#pragma unroll
                for (int bj = 0; bj < 2; ++bj)
#pragma unroll
                    for (int n = 0; n < 2; ++n) *(f32x4*)(rowp + bj * HALF + n * 16) = xv[mm][bj][n] + gv[bj][n] * acc[ai][bj][m0 + mm][n]; }
            asm volatile("" ::: "memory");
        }
    }
};
template <class Epi, class Sched, bool STAMP = false>
__device__ __forceinline__ void gemm_phase(PG8_LAS unsigned char* lds, const Gemm g, const Sched& S, const Epi& E, unsigned long long* stamps) {
    int tid_ = threadIdx.x; asm volatile("" : "+v"(tid_)); const int tid = tid_, wid = __builtin_amdgcn_readfirstlane(tid >> 6), lane = tid & 63, wr = wid >> 2, wc = wid & 3, fr = lane & 15, fq = lane >> 4;
    const int K = g.K, nt = K / BK;
    int ts_lo = 0, ts_hi = 0, nts = 0; const unsigned long long rt_entry = STAMP ? (unsigned long long)wall_clock64() : 0ull;
#define PG8_STAMP() do { if (STAMP && wid == 0 && nts < 64) { const unsigned long long _c = (unsigned long long)clock64(); \
        ts_lo = (lane == nts) ? (int)(unsigned)_c : ts_lo; ts_hi = (lane == nts) ? (int)(unsigned)(_c >> 32) : ts_hi; ++nts; } } while (0)
    PG8_STAMP();
    unsigned voffA[2], voffB[2];
#pragma unroll
    for (int i = 0; i < 2; ++i) { int R, C; stage_rc(tid * 16 + i * 8192, R, C); const int Rb = Epi::PERM ? ((R & ~31) + perm32(R & 31)) : R;
        voffA[i] = (unsigned)(R * K + C) * 2u; voffB[i] = (unsigned)(Rb * K + C) * 2u; }
    const size_t kstep = (size_t)(BK * 2);
    const size_t hstep = (size_t)HALF * K * 2;
    const size_t tstep = 2 * hstep;
    const unsigned ldsw = (unsigned)wid * 1024u;
    const int aoff = lds_byte(wr * 64 + fr, fq * 8), boff = lds_byte(wc * 32 + fr, fq * 8);
#define PG8_SA(b, h) (((b) * 2 + (h)) * HTB)
#define PG8_SB(b, h) ((4 + (b) * 2 + (h)) * HTB)
#define PG8_STAGE(bufoff, gbase, voff) do { _Pragma("unroll") for (int _i = 0; _i < 2; ++_i) \
        __builtin_amdgcn_global_load_lds((const unsigned*)((const char*)(gbase) + (voff)[_i]), (PG8_LAS unsigned*)(lds + (bufoff) + ldsw + _i * 8192), 16, 0, 0); } while (0)
#define PG8_LDA(dst, b, h) do { _Pragma("unroll") for (int m = 0; m < 4; ++m) _Pragma("unroll") for (int k = 0; k < 2; ++k) dst[m][k] = *(const PG8_LAS bf16x8*)(lds + PG8_SA(b, h) + aoff + m * 2048 + k * 1024); } while (0)
#define PG8_LDB(dst, b, h) do { _Pragma("unroll") for (int n = 0; n < 2; ++n) _Pragma("unroll") for (int k = 0; k < 2; ++k) dst[n][k] = *(const PG8_LAS bf16x8*)(lds + PG8_SB(b, h) + boff + n * 2048 + k * 1024); } while (0)
#define PG8_MMA(ai, bj, At, Bt) do { __builtin_amdgcn_s_setprio(1); _Pragma("unroll") for (int m = 0; m < 4; ++m) _Pragma("unroll") for (int n = 0; n < 2; ++n) _Pragma("unroll") for (int k = 0; k < 2; ++k) \
        acc[ai][bj][m][n] = __builtin_amdgcn_mfma_f32_16x16x32_bf16(Bt[n][k], At[m][k], acc[ai][bj][m][n], 0, 0, 0); __builtin_amdgcn_s_setprio(0); } while (0)
#define PG8_WAIT_V(n) asm volatile("s_waitcnt vmcnt(" #n ")" ::: "memory")
#define PG8_WAIT_L(n) asm volatile("s_waitcnt lgkmcnt(" #n ")" ::: "memory")
#define PG8_BAR __builtin_amdgcn_s_barrier()
#define PG8_SCHED __builtin_amdgcn_sched_barrier(0)
    Unit cur, nxt; int ui = 0;
    if (!S.next(0, cur)) return;
    f32x4 acc[2][2][4][2];
#pragma unroll
    for (int a = 0; a < 2; ++a)
#pragma unroll
        for (int b = 0; b < 2; ++b)
#pragma unroll
            for (int m = 0; m < 4; ++m)
#pragma unroll
                for (int n = 0; n < 2; ++n) acc[a][b][m][n] = (f32x4){0.f, 0.f, 0.f, 0.f};
    bf16x8 At[4][2], B0[2][2], B1[2][2];
    const char* cA = (const char*)g.A + (size_t)cur.pm * tstep; const char* cB = (const char*)g.Bt + (size_t)cur.pn * tstep;
    S.a_ready(cur);
    PG8_STAGE(PG8_SB(0, 0), cB, voffB); PG8_STAGE(PG8_SA(0, 0), cA, voffA); PG8_STAGE(PG8_SB(0, 1), cB + hstep, voffB); PG8_STAGE(PG8_SA(0, 1), cA + hstep, voffA);
    if (wr == 1) PG8_BAR;
    PG8_WAIT_V(4); PG8_BAR;
    PG8_STAGE(PG8_SB(1, 0), cB + kstep, voffB); PG8_STAGE(PG8_SA(1, 0), cA + kstep, voffA); PG8_STAGE(PG8_SB(1, 1), cB + hstep + kstep, voffB);
    PG8_WAIT_V(6); PG8_BAR;
    PG8_STAMP();
    for (;;) {
        const bool has_next = S.next(ui + 1, nxt);
        const char* nA = has_next ? (const char*)g.A + (size_t)nxt.pm * tstep : cA; const char* nB = has_next ? (const char*)g.Bt + (size_t)nxt.pn * tstep : cB;
        for (int t = 0; t < nt; t += 2) {
            const bool last = (t == nt - 2);
            const char* a1 = cA + (size_t)(t + 1) * kstep;
            const char* a2 = last ? nA : cA + (size_t)(t + 2) * kstep; const char* b2 = last ? nB : cB + (size_t)(t + 2) * kstep;
            const char* a3 = a2 + kstep; const char* b3 = b2 + kstep;
            if (last && has_next) S.a_ready(nxt);
            PG8_LDB(B0, 0, 0); PG8_SCHED; PG8_LDA(At, 0, 0); PG8_STAGE(PG8_SA(1, 1), a1 + hstep, voffA);
            PG8_WAIT_L(8); PG8_BAR; PG8_WAIT_L(0); PG8_MMA(0, 0, At, B0); PG8_BAR; PG8_SCHED;
            PG8_LDB(B1, 0, 1); PG8_STAGE(PG8_SB(0, 0), b2, voffB);
            PG8_BAR; PG8_WAIT_L(0); PG8_MMA(0, 1, At, B1); PG8_BAR;
            PG8_LDA(At, 0, 1); PG8_STAGE(PG8_SA(0, 0), a2, voffA);
            PG8_BAR; PG8_WAIT_L(0); PG8_MMA(1, 0, At, B0); PG8_BAR; PG8_SCHED;
            PG8_STAGE(PG8_SB(0, 1), b2 + hstep, voffB);
            PG8_WAIT_V(6); PG8_BAR; PG8_MMA(1, 1, At, B1); PG8_BAR;
            PG8_LDB(B0, 1, 0); PG8_SCHED; PG8_LDA(At, 1, 0); PG8_STAGE(PG8_SA(0, 1), a2 + hstep, voffA);
            PG8_WAIT_L(8); PG8_BAR; PG8_WAIT_L(0); PG8_MMA(0, 0, At, B0); PG8_BAR; PG8_SCHED;
            PG8_LDB(B1, 1, 1); PG8_STAGE(PG8_SB(1, 0), b3, voffB);
            PG8_BAR; PG8_WAIT_L(0); PG8_MMA(0, 1, At, B1); PG8_BAR;
            PG8_LDA(At, 1, 1); PG8_STAGE(PG8_SA(1, 0), a3, voffA);
            PG8_BAR; PG8_WAIT_L(0); PG8_MMA(1, 0, At, B0); PG8_BAR; PG8_SCHED;
            PG8_STAGE(PG8_SB(1, 1), b3 + hstep, voffB);
            PG8_WAIT_V(6); PG8_BAR; PG8_MMA(1, 1, At, B1); PG8_BAR;
        }
        PG8_STAMP();
        if constexpr (!Epi::AFTER_DRAIN) { E(acc, cur, wr, wc, fr, fq); S.done(cur); }
        PG8_STAMP();
        if (!has_next) break;
#pragma unroll
        for (int a = 0; a < 2; ++a)
#pragma unroll
            for (int b = 0; b < 2; ++b)
#pragma unroll
                for (int m = 0; m < 4; ++m)
#pragma unroll
                    for (int n = 0; n < 2; ++n) acc[a][b][m][n] = (f32x4){0.f, 0.f, 0.f, 0.f};
        cur = nxt; cA = nA; cB = nB; ++ui;
    }
    PG8_WAIT_V(0);
    if (wr == 0) PG8_BAR;
    PG8_BAR;
    if constexpr (Epi::AFTER_DRAIN) { E.fused(acc, cur, wr, wc, fr, fq, lds, wid, lane); S.done(cur); }
    PG8_STAMP();
    if (STAMP && wid == 0) { stamps[lane] = lane < nts ? (((unsigned long long)(unsigned)ts_hi << 32) | (unsigned)ts_lo) : 0ull;
        if (lane == 62) stamps[62] = rt_entry; if (lane == 63) stamps[63] = (unsigned long long)wall_clock64(); }
#undef PG8_STAMP
#undef PG8_SA
#undef PG8_SB
#undef PG8_STAGE
#undef PG8_LDA
#undef PG8_LDB
#undef PG8_MMA
#undef PG8_WAIT_V
#undef PG8_WAIT_L
#undef PG8_BAR
#undef PG8_SCHED
}
}

__device__ __forceinline__ void phase_ada(const Params& p, float* ldsf, int t0, int t1, int vb, int VG) {
    const int tid = opaque_tid();
    float* mod = (float*)(p.ws + OFF_MOD);
    const int cq = tid & 15, ks = tid >> 4;
    for (int t = t0 + vb; t < t1; t += VG) {
        const int l = t / 144, cgi = t % 144; const int col = cgi * 64 + cq * 4;
        const float* W = p.ada_w + (size_t)l * 1024 * 9216 + col;
        f32x4 acc = {0.f, 0.f, 0.f, 0.f};
        f32x4 wv[32];
#pragma unroll
        for (int i = 0; i < 32; ++i) wv[i] = __builtin_nontemporal_load((const f32x4*)(W + (size_t)(ks * 32 + i) * 9216));
        __builtin_amdgcn_sched_barrier(0);
#pragma unroll
        for (int i = 0; i < 32; ++i) { const float cv = p.c[ks * 32 + i]; const float ca = cv / (1.0f + expf(-cv)); acc += wv[i] * ca; }
        *(f32x4*)(ldsf + (ks * 16 + cq) * 4) = acc;
        __syncthreads();
        if (tid < 64) { const int cqq = tid >> 2, j = tid & 3; float s = 0.f; for (int k2 = 0; k2 < 32; ++k2) s += ldsf[(k2 * 16 + cqq) * 4 + j];
            const int o = l * 9216 + cgi * 64 + cqq * 4 + j; mod[o] = s + p.ada_b[o]; }
        __syncthreads();
    }
}

__device__ __forceinline__ int conv_col(int mode, int r, int& which) {
    which = 0;
    if (mode == 1) { const int pn = r >> 8, w = r & 255; which = (w >= 128) ? 1 : 0; return pn * 128 + (w & 127); }
    if (mode == 2) { if (r < 512) return (r >> 7) * 256 + (r & 127); const int rr = r - 512; return (rr >> 7) * 256 + 128 + (rr & 127); }
    return r;
}
__device__ __forceinline__ void convT(bf16_t* dst, const float* src0, const float* src1, int K, int ldsrc, int Nsrc, int Ndst, int mode, int& tbase, float* tile, int vb, int VG) {
    const int tid = opaque_tid();
    const int nkt = K >> 7, ntiles = nkt * (Ndst >> 6);
    const int first = (vb + VG - (tbase % VG)) % VG;
    for (int t = first; t < ntiles; t += VG) {
        const int nt_ = t / nkt, kt = t % nkt; const int r0 = nt_ * 64, k0 = kt * 128;
        { const int n = tid & 63, kk = tid >> 6; int which; const int col = conv_col(mode, r0 + n, which); const bool valid = col < Nsrc;
          const float* src = (which ? src1 : src0) + (size_t)k0 * ldsrc + col;
          float v[16];
#pragma unroll
          for (int it = 0; it < 16; ++it) v[it] = valid ? __builtin_nontemporal_load(src + (size_t)(kk + it * 8) * ldsrc) : 0.f;
#pragma unroll
          for (int it = 0; it < 16; ++it) tile[(kk + it * 8) * 65 + n] = v[it]; }
        __syncthreads();
        { const int kp = tid & 63, n = tid >> 6;
#pragma unroll
          for (int it = 0; it < 8; ++it) { const int nn = n + it * 8; const float v0 = tile[(2 * kp) * 65 + nn], v1 = tile[(2 * kp + 1) * 65 + nn];
              *(unsigned*)(dst + (size_t)(r0 + nn) * K + k0 + 2 * kp) = pack2(v0, v1); } }
        __syncthreads();
    }
    tbase += ntiles;
}
__device__ __forceinline__ void phase_convert(const Params& p, int l, float* tile, int vb, int VG) {
    int tb = 0;
    unsigned char* wsw = p.ws + (size_t)(l & 1) * W_REGION2;
    for (int f = 0; f < 2; ++f) {
        const size_t wo = (size_t)(l * 2 + f) * 1024 * 2816;
        convT((bf16_t*)(wsw + (f ? W_13B : W_13A)), p.w1 + wo, p.w3 + wo, 1024, 2816, 2816, 5632, 1, tb, tile, vb, VG);
        convT((bf16_t*)(wsw + (f ? W_2B : W_2A)), p.w2 + wo, nullptr, 2816, 1024, 1024, 1024, 0, tb, tile, vb, VG);
    }
    const int e = l >> 1;
    if ((l & 1) == 0) {
        bf16_t* wi = (bf16_t*)(wsw + W_MIX); bf16_t* wout = wi + 2816 * 1024; bf16_t* wuq = wout + 1024 * 1024; bf16_t* wukv = wuq + 768 * 384;
        convT(wi, p.ev_w_in + (size_t)e * 1024 * 2760, nullptr, 1024, 2760, 2760, 2816, 0, tb, tile, vb, VG);
        convT(wout, p.ev_w_out + (size_t)e * 1024 * 1024, nullptr, 1024, 1024, 1024, 1024, 0, tb, tile, vb, VG);
        convT(wuq, p.mla_w_uq + (size_t)e * 384 * 768, nullptr, 384, 768, 768, 768, 0, tb, tile, vb, VG);
        convT(wukv, p.mla_w_ukv + (size_t)e * 256 * 1024, nullptr, 256, 1024, 1024, 1024, 2, tb, tile, vb, VG);
    } else {
        bf16_t* wi = (bf16_t*)(wsw + W_MIX); bf16_t* wout = wi + 5376 * 1024;
        convT(wi, p.ssd_w_in + (size_t)e * 1024 * 5152, nullptr, 1024, 5152, 5152, 5376, 0, tb, tile, vb, VG);
        convT(wout, p.ssd_w_out + (size_t)e * 2048 * 1024, nullptr, 2048, 1024, 1024, 1024, 0, tb, tile, vb, VG);
    }
}

__device__ __forceinline__ void phase_norm(const float* X, bf16_t* H, const float* g, const float* shift, const float* scale) {
    const int tid = opaque_tid(), wave = tid >> 6, lane = tid & 63;
    for (int row = (blockIdx.x * 8 + wave) * 2; row < SEQ; row += gridDim.x * 16) {
        const f32x4* xr = (const f32x4*)(X + (size_t)row * 1024);
        f32x4 v[2][4]; float ss[2] = {0.f, 0.f};
#pragma unroll
        for (int r = 0; r < 2; ++r)
#pragma unroll
            for (int i = 0; i < 4; ++i) v[r][i] = xr[r * 256 + lane + 64 * i];
#pragma unroll
        for (int r = 0; r < 2; ++r) {
#pragma unroll
            for (int i = 0; i < 4; ++i) ss[r] += v[r][i][0] * v[r][i][0] + v[r][i][1] * v[r][i][1] + v[r][i][2] * v[r][i][2] + v[r][i][3] * v[r][i][3];
            ss[r] = wave_sum(ss[r]); }
#pragma unroll
        for (int i = 0; i < 4; ++i) { const int col = (lane + 64 * i) * 4;
            const f32x4 g4 = *(const f32x4*)(g + col), sc = *(const f32x4*)(scale + col), sh = *(const f32x4*)(shift + col);
#pragma unroll
            for (int r = 0; r < 2; ++r) { const float rstd = rsqrtf(ss[r] * (1.0f / 1024.0f) + 1e-6f);
                float y[4];
#pragma unroll
                for (int j = 0; j < 4; ++j) y[j] = (v[r][i][j] * rstd * g4[j]) * (1.0f + sc[j]) + sh[j];
                u32x2 w; w.x = pack2(y[0], y[1]); w.y = pack2(y[2], y[3]);
                *(u32x2*)(H + (size_t)(row + r) * 1024 + col) = w; } }
    }
}
__device__ __forceinline__ void phase_final(float* X, const float* g) {
    const int tid = opaque_tid(), wave = tid >> 6, lane = tid & 63;
    for (int row = (blockIdx.x * 8 + wave) * 2; row < SEQ; row += gridDim.x * 16) {
        f32x4* xr = (f32x4*)(X + (size_t)row * 1024);
        f32x4 v[2][4]; float ss[2] = {0.f, 0.f};
#pragma unroll
        for (int r = 0; r < 2; ++r)
#pragma unroll
            for (int i = 0; i < 4; ++i) v[r][i] = xr[r * 256 + lane + 64 * i];
#pragma unroll
        for (int r = 0; r < 2; ++r) {
#pragma unroll
            for (int i = 0; i < 4; ++i) ss[r] += v[r][i][0] * v[r][i][0] + v[r][i][1] * v[r][i][1] + v[r][i][2] * v[r][i][2] + v[r][i][3] * v[r][i][3];
            ss[r] = wave_sum(ss[r]); }
#pragma unroll
        for (int i = 0; i < 4; ++i) { const f32x4 g4 = *(const f32x4*)(g + (lane + 64 * i) * 4);
#pragma unroll
            for (int r = 0; r < 2; ++r) xr[r * 256 + lane + 64 * i] = v[r][i] * rsqrtf(ss[r] * (1.0f / 1024.0f) + 1e-6f) * g4; }
    }
}

__device__ __forceinline__ void phase_mla_prep(const Params& p, int e) {
    const int tid = opaque_tid(), wave = tid >> 6, lane = tid & 63;
    const bf16_t* P = (const bf16_t*)(p.ws + OFF_BIG);
    bf16_t* CQN = (bf16_t*)(p.ws + M_CQN); bf16_t* CKVN = (bf16_t*)(p.ws + M_CKVN); bf16_t* KPE = (bf16_t*)(p.ws + M_KPE);
    const float* gq = p.mla_q_norm_g + e * 384; const float* gkv = p.mla_kv_norm_g + e * 256;
    for (int tok = blockIdx.x * 8 + wave; tok < SEQ; tok += gridDim.x * 8) {
        const bf16_t* pr = P + (size_t)tok * EV_N;
        { float q[6]; float ssq = 0.f;
#pragma unroll
          for (int i = 0; i < 3; ++i) { const unsigned w = *(const unsigned*)(pr + 2056 + lane * 2 + 128 * i); q[2 * i] = bf2f((bf16_t)(w & 0xffff)); q[2 * i + 1] = bf2f((bf16_t)(w >> 16)); ssq += q[2 * i] * q[2 * i] + q[2 * i + 1] * q[2 * i + 1]; }
          const u32x2 wk = *(const u32x2*)(pr + 2440 + lane * 4); float v[4] = {bf2f((bf16_t)(wk.x & 0xffff)), bf2f((bf16_t)(wk.x >> 16)), bf2f((bf16_t)(wk.y & 0xffff)), bf2f((bf16_t)(wk.y >> 16))};
          float ssk = v[0] * v[0] + v[1] * v[1] + v[2] * v[2] + v[3] * v[3];
#pragma unroll
          for (int o = 32; o > 0; o >>= 1) { ssq += __shfl_xor(ssq, o); ssk += __shfl_xor(ssk, o); }
          const float r = rsqrtf(ssq * (1.0f / 384.0f) + 1e-6f), rk = rsqrtf(ssk * (1.0f / 256.0f) + 1e-6f);
#pragma unroll
          for (int i = 0; i < 3; ++i) { const int col = lane * 2 + 128 * i; *(unsigned*)(CQN + (size_t)tok * 384 + col) = pack2(q[2 * i] * r * gq[col], q[2 * i + 1] * r * gq[col + 1]); }
          const int col = lane * 4; u32x2 o; o.x = pack2(v[0] * rk * gkv[col], v[1] * rk * gkv[col + 1]); o.y = pack2(v[2] * rk * gkv[col + 2], v[3] * rk * gkv[col + 3]);
          *(u32x2*)(CKVN + (size_t)tok * 256 + col) = o; }
        { const float v = bf2f(pr[2696 + lane]); const float pa = __shfl_xor(v, 32); float c, s; rope_cs(p.pos[tok], lane & 31, c, s);
          KPE[(size_t)tok * 64 + lane] = f2bf(lane < 32 ? v * c - pa * s : v * c + pa * s); }
    }
}

__device__ __forceinline__ void phase_gdn_intra(const Params& p, int e, unsigned char* lds) {
    const int tid = opaque_tid(), wave = tid >> 6, lane = tid & 63, fr = lane & 15, fq = lane >> 4;
    float* R0 = (float*)lds; float* R1 = (float*)(lds + 33792); float* R2 = (float*)(lds + 67584);
    bf16_t* QB = (bf16_t*)(lds + 101376); bf16_t* KB = (bf16_t*)(lds + 118784);
    float* sBeta = (float*)(lds + 136192); float* sGc = sBeta + 64;
    const bf16_t* P = (const bf16_t*)(p.ws + OFF_BIG);
    float* U = (float*)(p.ws + G_U); bf16_t* Wb = (bf16_t*)(p.ws + G_W); bf16_t* QS = (bf16_t*)(p.ws + G_QS); bf16_t* KET = (bf16_t*)(p.ws + G_KET); bf16_t* ATT = (bf16_t*)(p.ws + G_ATT);
    float* EGL = (float*)(p.ws + OFF_EGL);
    const float* cw = p.gdn_conv_w + (size_t)e * 4 * 1536;
    for (int item = blockIdx.x; item < 1024; item += gridDim.x) {
        const int h = item & 3, n = item >> 2, tok0 = n * 64;
        if (tid < 192) {
            const int part = tid >> 6, c2 = (tid & 63) * 2, ch = part * 512 + h * 128 + c2;
            float* dst = (part == 0 ? R0 : (part == 1 ? R1 : R2)) + c2;
            CONV_PAIR(P, EV_N, ch, tok0, cw, 1536, ch, 0.f, 0.f, { dst[t * 132] = y0; dst[t * 132 + 1] = y1; });
        } else if (tid >= 384 && tid < 448) {
            const int t = tid - 384; const bf16_t* pr = P + (size_t)(tok0 + t) * EV_N;
            const float bl = bf2f(pr[2048 + h]), a = bf2f(pr[2052 + h]);
            sBeta[t] = sigmoid_f(bl);
            float g = -expf(p.gdn_A_log[e * 4 + h]) * softplus_f(a + p.gdn_dt_bias[e * 4 + h]);
            g = wave_incl_scan(g, lane);
            sGc[t] = g;
        }
        __syncthreads();
        for (int i4 = 0; i4 < 4; ++i4) {
            const bool isq = wave < 4;
            float* rowb = (isq ? R0 : R1) + ((wave & 3) * 16 + i4 * 4) * 132;
            float a[4], b[4], ss[4];
#pragma unroll
            for (int r = 0; r < 4; ++r) { a[r] = rowb[r * 132 + lane]; b[r] = rowb[r * 132 + lane + 64]; ss[r] = a[r] * a[r] + b[r] * b[r]; }
#pragma unroll
            for (int o = 32; o > 0; o >>= 1)
#pragma unroll
                for (int r = 0; r < 4; ++r) ss[r] += __shfl_xor(ss[r], o);
#pragma unroll
            for (int r = 0; r < 4; ++r) {
                const int t = (wave & 3) * 16 + i4 * 4 + r; float* row = rowb + r * 132;
                const float sc = rsqrtf(ss[r] + 1e-6f) * (isq ? 0.08838834764831845f : 1.0f);
                const float av = a[r] * sc, bv = b[r] * sc;
                bf16_t* brow = (isq ? QB : KB) + t * 136; brow[lane] = f2bf(av); brow[lane + 64] = f2bf(bv);
                if (!isq) { row[lane] = av; row[lane + 64] = bv; }
                else { const float eg = __expf(sGc[t]); bf16_t* qo = QS + (size_t)(tok0 + t) * 512 + h * 128; qo[lane] = f2bf(av * eg); qo[lane + 64] = f2bf(bv * eg); }
            }
        }
        __syncthreads();
        {
            float* Amat = R0;
            const int m = wave >> 2, ib = wave & 3; const bf16_t* Y = m ? QB : KB;
            bf16x8 yf[4];
#pragma unroll
            for (int ks = 0; ks < 4; ++ks) yf[ks] = *(const bf16x8*)(Y + (ib * 16 + fr) * 136 + ks * 32 + fq * 8);
            const int irow = ib * 16 + fr; const float gi = sGc[irow], bi = sBeta[irow];
#pragma unroll
            for (int jb = 0; jb < 4; ++jb) {
                f32x4 d = {0.f, 0.f, 0.f, 0.f};
#pragma unroll
                for (int ks = 0; ks < 4; ++ks) { const bf16x8 xf = *(const bf16x8*)(KB + (jb * 16 + fr) * 136 + ks * 32 + fq * 8); d = mfma16(xf, yf[ks], d); }
                float v[4];
#pragma unroll
                for (int i = 0; i < 4; ++i) { const int j = jb * 16 + fq * 4 + i; const bool keep = m ? (j <= irow) : (j < irow); const float dec = keep ? __expf(gi - sGc[j]) : 0.f; v[i] = d[i] * dec * (m ? 1.0f : bi); }
                if (m == 0) { f32x4 o = {v[0], v[1], v[2], v[3]}; *(f32x4*)(Amat + irow * 64 + jb * 16 + fq * 4) = o; }
                else { u32x2 o; o.x = pack2(v[0], v[1]); o.y = pack2(v[2], v[3]); *(u32x2*)(ATT + ((size_t)(h * 256 + n) * 64 + irow) * 64 + jb * 16 + fq * 4) = o; }
            }
            const float gl = sGc[63];
            { const int t = tid & 63; const float ek = __expf(gl - sGc[t]);
#pragma unroll 4
              for (int it = 0; it < 16; ++it) { const int k = (tid >> 6) + 8 * it; KET[((size_t)(h * 256 + n) * 128 + k) * 64 + t] = f2bf(R1[t * 132 + k] * ek); } }
            if (tid == 0) EGL[h * 256 + n] = __expf(gl);
        }
        __syncthreads();
        if (tid < 256) {
            const float* Amat = R0;
            const int c = tid & 127; const bool isw = tid >= 128;
            float s[64];
#pragma unroll
            for (int i = 0; i < 64; ++i) s[i] = 0.f;
#pragma unroll
            for (int i = 0; i < 64; ++i) {
                float rhs = isw ? R1[i * 132 + c] * sBeta[i] * __expf(sGc[i]) : R2[i * 132 + c] * sBeta[i];
#pragma unroll
                for (int j4 = 0; j4 < (i + 3) / 4; ++j4) { const f32x4 a = *(const f32x4*)(Amat + i * 64 + j4 * 4);
                    rhs -= a[0] * s[j4 * 4 + 0]; rhs -= a[1] * s[j4 * 4 + 1]; rhs -= a[2] * s[j4 * 4 + 2]; rhs -= a[3] * s[j4 * 4 + 3]; }
                s[i] = rhs;
                if (isw) Wb[(size_t)(tok0 + i) * 512 + h * 128 + c] = f2bf(rhs); else U[(size_t)(tok0 + i) * 512 + h * 128 + c] = rhs;
            }
        }
        __syncthreads();
    }
}

__device__ __forceinline__ void phase_gdn_scan(const Params& p, unsigned char* lds_) {
    const int tid = opaque_tid(), wave = __builtin_amdgcn_readfirstlane(tid >> 6), lane = tid & 63, fr = lane & 15, fq = lane >> 4;
    const int h = blockIdx.x & 7, slice = blockIdx.x >> 3, j0 = slice * 16;
    LAS bf16_t* ST = (LAS bf16_t*)lds_; LAS bf16_t* VN = ST + 16 * 136;
    for (int i = tid; i < 16 * 136 / 2; i += 512) ((LAS unsigned*)ST)[i] = 0u;
    const float* U = (const float*)(p.ws + G_U); const bf16_t* Wb = (const bf16_t*)(p.ws + G_W);
    const bf16_t* KET = (const bf16_t*)(p.ws + G_KET); const float* EG = (const float*)(p.ws + OFF_EGL) + h * 256;
    bf16_t* SST = (bf16_t*)(p.ws + G_SST) + (size_t)(h * 256) * 16384 + (size_t)(j0 + fr) * 128 + wave * 16 + fq * 4;
    bf16_t* VNT = (bf16_t*)(p.ws + G_VNT) + (size_t)(h * 256) * 8192 + (size_t)(j0 + fr) * 64 + (wave & 3) * 16 + fq * 4;
    { u32x2 z; z.x = 0u; z.y = 0u; *(u32x2*)(SST) = z; }
    __syncthreads();
    const bool lo = wave < 4; const int rb = wave & 3;
    const bf16_t* A1 = Wb + (size_t)(rb * 16 + fr) * 512 + h * 128 + fq * 8;
    const size_t uoff = (size_t)(rb * 16 + fq * 4) * 512 + h * 128 + j0 + fr;
    const bf16_t* KEp = KET + ((size_t)(h * 256) * 128 + wave * 16 + fr) * 64 + fq * 8;
    const float* tch; size_t tstep;
    { const int L = slice * 32 + (wave & 3) * 8 + (lane & 7);
      if (L < 128) { tch = (const float*)(Wb + (size_t)(L >> 1) * 512 + h * 128 + (L & 1) * 64); tstep = 64 * 512 / 2; }
      else         { tch = (const float*)(KET + (size_t)(h * 256) * 8192 + (L - 128) * 64); tstep = 8192 / 2; } }
#define GLD128(dst, ptr) asm volatile("global_load_dwordx4 %0, %1, off" : "=v"(dst) : "v"(ptr))
#define GLD32(dst, ptr) asm volatile("global_load_dword %0, %1, off" : "=v"(dst) : "v"(ptr))
#define GDN_LOAD(LO_, N_, a1_, ka_, uu_, eg_, td_) do { const size_t tb_ = (size_t)(N_) * 64 * 512; \
        if (LO_) { _Pragma("unroll") for (int ks = 0; ks < 4; ++ks) GLD128(a1_[ks], A1 + tb_ + ks * 32); \
                  _Pragma("unroll") for (int i = 0; i < 4; ++i) GLD32(uu_[i], U + tb_ + uoff + (size_t)i * 512); } \
        _Pragma("unroll") for (int ks = 0; ks < 2; ++ks) GLD128(ka_[ks], KEp + (size_t)(N_) * 8192 + ks * 32); \
        GLD32(eg_, EG + (N_)); \
        if (!(LO_)) { GLD32(td_, tch + (size_t)GDN_CL((N_) + 5) * tstep); } } while (0)
#define GDN_WAIT(LO_, a1_, ka_, uu_, eg_, td_) do { if (LO_) asm volatile("s_waitcnt vmcnt(33)" : "+v"(a1_[0]), "+v"(a1_[1]), "+v"(a1_[2]), "+v"(a1_[3]), "+v"(ka_[0]), "+v"(ka_[1]), \
            "+v"(uu_[0]), "+v"(uu_[1]), "+v"(uu_[2]), "+v"(uu_[3]), "+v"(eg_)); \
        else asm volatile("s_waitcnt vmcnt(12)" : "+v"(ka_[0]), "+v"(ka_[1]), "+v"(eg_), "+v"(td_)); } while (0)
#define LDS_BAR() do { asm volatile("s_waitcnt lgkmcnt(0)" ::: "memory"); __builtin_amdgcn_s_barrier(); asm volatile("" ::: "memory"); } while (0)
#define GDN_STEP(LO_, N_, a1_, ka_, uu_, eg_) do { \
        if (LO_) { bf16x8 sb[4]; \
            _Pragma("unroll") for (int ks = 0; ks < 4; ++ks) sb[ks] = *(const LAS bf16x8*)(ST + fr * 136 + ks * 32 + fq * 8); \
            f32x4 acc1 = {0.f, 0.f, 0.f, 0.f}; \
            _Pragma("unroll") for (int ks = 0; ks < 4; ++ks) acc1 = mfma16(a1_[ks], sb[ks], acc1); \
            u32x2 w; w.x = pack2(uu_[0] - acc1[0], uu_[1] - acc1[1]); w.y = pack2(uu_[2] - acc1[2], uu_[3] - acc1[3]); \
            *(LAS u32x2*)(VN + fr * 72 + rb * 16 + fq * 4) = w; *(u32x2*)(VNT + (size_t)(N_) * 8192) = w; } \
        LDS_BAR(); \
        bf16x8 vb[2]; \
        _Pragma("unroll") for (int ks = 0; ks < 2; ++ks) vb[ks] = *(const LAS bf16x8*)(VN + fr * 72 + ks * 32 + fq * 8); \
        f32x4 sacc = Sreg * eg_; \
        _Pragma("unroll") for (int ks = 0; ks < 2; ++ks) sacc = mfma16(ka_[ks], vb[ks], sacc); \
        Sreg = sacc; \
        { u32x2 w; w.x = pack2(Sreg[0], Sreg[1]); w.y = pack2(Sreg[2], Sreg[3]); *(LAS u32x2*)(ST + fr * 136 + wave * 16 + fq * 4) = w; \
          if ((N_) + 1 < NCH) *(u32x2*)(SST + (size_t)((N_) + 1) * 16384) = w; } \
        LDS_BAR(); } while (0)
#define GDN_CL(x) ((x) < NCH ? (x) : NCH - 1)
#define GDN_RUN(LO_) do { \
    f32x4 Sreg = {0.f, 0.f, 0.f, 0.f}; \
    bf16x8 a1[4], ka[2]; float uu[4]; float eg; float td = 0.f, tdb = 0.f, tdc = 0.f, tdd = 0.f; \
    bf16x8 a1b[4], kab[2]; float uub[4]; float egb; \
    bf16x8 a1c[4], kac[2]; float uuc[4]; float egc; \
    bf16x8 a1d[4], kad[2]; float uud[4]; float egd; \
    GDN_LOAD(LO_, 0, a1, ka, uu, eg, td); GDN_LOAD(LO_, 1, a1b, kab, uub, egb, tdb); GDN_LOAD(LO_, 2, a1c, kac, uuc, egc, tdc); \
    _Pragma("unroll 1") for (int n = 0; n < NCH; n += 4) { \
        GDN_LOAD(LO_, GDN_CL(n + 3), a1d, kad, uud, egd, tdd); \
        GDN_WAIT(LO_, a1, ka, uu, eg, td); \
        GDN_STEP(LO_, n, a1, ka, uu, eg); \
        GDN_LOAD(LO_, GDN_CL(n + 4), a1, ka, uu, eg, td); \
        GDN_WAIT(LO_, a1b, kab, uub, egb, tdb); \
        GDN_STEP(LO_, n + 1, a1b, kab, uub, egb); \
        GDN_LOAD(LO_, GDN_CL(n + 5), a1b, kab, uub, egb, tdb); \
        GDN_WAIT(LO_, a1c, kac, uuc, egc, tdc); \
        GDN_STEP(LO_, n + 2, a1c, kac, uuc, egc); \
        GDN_LOAD(LO_, GDN_CL(n + 6), a1c, kac, uuc, egc, tdc); \
        GDN_WAIT(LO_, a1d, kad, uud, egd, tdd); \
        GDN_STEP(LO_, n + 3, a1d, kad, uud, egd); \
    } \
    asm volatile("s_waitcnt vmcnt(0)" ::: "memory"); } while (0)
    if (lo) GDN_RUN(true); else GDN_RUN(false);
#undef GDN_RUN
#undef GDN_CL
#undef GDN_STEP
#undef GDN_LOAD
#undef GDN_WAIT
#undef GLD128
#undef GLD32
}

__device__ __forceinline__ void phase_gdn_out(const Params& p, int e, unsigned char* lds) {
    const int tid = opaque_tid(), wave = tid >> 6, lane = tid & 63, fr = lane & 15, fq = lane >> 4;
    float* sPart = (float*)lds;
    const bf16_t* QS = (const bf16_t*)(p.ws + G_QS); const bf16_t* ATT = (const bf16_t*)(p.ws + G_ATT);
    const bf16_t* SST = (const bf16_t*)(p.ws + G_SST); const bf16_t* VNT = (const bf16_t*)(p.ws + G_VNT);
    const bf16_t* P = (const bf16_t*)(p.ws + OFF_BIG); bf16_t* O = (bf16_t*)(p.ws + OFF_HY);
    const float* gg = p.gdn_norm_g + e * 128;
    const int rb = wave & 3, chh = wave >> 2;
    for (int item = blockIdx.x; item < 1024; item += gridDim.x) {
        const int h = item & 3, n = item >> 2, tok = n * 64 + rb * 16 + fr;
        bf16x8 qa[4], aa[2];
#pragma unroll
        for (int ks = 0; ks < 4; ++ks) qa[ks] = *(const bf16x8*)(QS + (size_t)tok * 512 + h * 128 + ks * 32 + fq * 8);
#pragma unroll
        for (int ks = 0; ks < 2; ++ks) aa[ks] = *(const bf16x8*)(ATT + ((size_t)(h * 256 + n) * 64 + rb * 16 + fr) * 64 + ks * 32 + fq * 8);
        bf16x8 sbf[4][4], vbf[4][2]; u32x2 zwf[4];
#pragma unroll
        for (int jb = 0; jb < 4; ++jb) { const int j = chh * 64 + jb * 16 + fr;
#pragma unroll
            for (int ks = 0; ks < 4; ++ks) sbf[jb][ks] = *(const bf16x8*)(SST + ((size_t)(h * 256 + n) * 128 + j) * 128 + ks * 32 + fq * 8);
#pragma unroll
            for (int ks = 0; ks < 2; ++ks) vbf[jb][ks] = *(const bf16x8*)(VNT + ((size_t)(h * 256 + n) * 128 + j) * 64 + ks * 32 + fq * 8);
            zwf[jb] = *(const u32x2*)(P + (size_t)tok * EV_N + 1536 + h * 128 + chh * 64 + jb * 16 + fq * 4); }
        f32x4 o[4]; float sq = 0.f;
#pragma unroll
        for (int jb = 0; jb < 4; ++jb) {
            f32x4 d = {0.f, 0.f, 0.f, 0.f};
#pragma unroll
            for (int ks = 0; ks < 4; ++ks) d = mfma16(sbf[jb][ks], qa[ks], d);
#pragma unroll
            for (int ks = 0; ks < 2; ++ks) d = mfma16(vbf[jb][ks], aa[ks], d);
            o[jb] = d;
            sq += d[0] * d[0] + d[1] * d[1] + d[2] * d[2] + d[3] * d[3];
        }
        sq += __shfl_xor(sq, 16); sq += __shfl_xor(sq, 32);
        if (fq == 0) sPart[chh * 64 + rb * 16 + fr] = sq;
        __syncthreads();
        const float rs = rsqrtf((sPart[rb * 16 + fr] + sPart[64 + rb * 16 + fr]) * (1.0f / 128.0f) + 1e-6f);
#pragma unroll
        for (int jb = 0; jb < 4; ++jb) { const int c0 = chh * 64 + jb * 16 + fq * 4;
            const u32x2 zw = zwf[jb];
            const float zz[4] = {bf2f((bf16_t)(zw.x & 0xffff)), bf2f((bf16_t)(zw.x >> 16)), bf2f((bf16_t)(zw.y & 0xffff)), bf2f((bf16_t)(zw.y >> 16))};
            const f32x4 g4 = *(const f32x4*)(gg + c0);
            u32x2 w; w.x = pack2(o[jb][0] * rs * g4[0] * silu_f(zz[0]), o[jb][1] * rs * g4[1] * silu_f(zz[1])); w.y = pack2(o[jb][2] * rs * g4[2] * silu_f(zz[2]), o[jb][3] * rs * g4[3] * silu_f(zz[3]));
            *(u32x2*)(O + (size_t)tok * 1024 + h * 128 + c0) = w; }
        __syncthreads();
    }
}

__device__ __forceinline__ void phase_attn(const Params& p, unsigned char* lds_) {
    const int tid = opaque_tid(), wave = __builtin_amdgcn_readfirstlane(tid >> 6), lane = tid & 63, fr = lane & 15, fq = lane >> 4;
    LAS unsigned char* lds = (LAS unsigned char*)lds_;
    const bf16_t* Qb = (const bf16_t*)(p.ws + M_Q); const bf16_t* KN = (const bf16_t*)(p.ws + M_KN); const bf16_t* VT = (const bf16_t*)(p.ws + M_VT); const bf16_t* KPE = (const bf16_t*)(p.ws + M_KPE);
    bf16_t* O = (bf16_t*)(p.ws + OFF_HY);
    const float C = 0.07216878364870323f * 1.4426950408889634f;
    const int sw = (fr >> 1) & 7;
    const int kbn = fr * 256 + ((fq ^ fr) << 4);
    const int kbp = 16384 + fr * 128 + ((fq ^ sw) << 4);
    const int vb0 = fr * 128 + (((fq >> 1) ^ sw) << 4) + (fq & 1) * 8;
    for (int u = blockIdx.x; u < 256; u += gridDim.x) {
        const int h = u & 3, x = u >> 2;
        const int blk = (wave < 4) ? x : 127 - x;
        const int rowbase = blk * 128 + (wave & 3) * 32;
        const int cw = rowbase >> 6;
        const int ktmax = 2 * (127 - x) + 1;
        unsigned okn[2], okp, ov[2];
#pragma unroll
        for (int j = 0; j < 2; ++j) { const int key = (wave * 2 + j) * 4 + (lane >> 4); okn[j] = (unsigned)(key * 512 + h * 128 + (((lane & 15) ^ (key & 15)) << 3)); }
        { const int key = wave * 8 + (lane >> 3); okp = (unsigned)(key * 64 + (((lane & 7) ^ ((key >> 1) & 7)) << 3)); }
#pragma unroll
        for (int j = 0; j < 2; ++j) { const int d = (wave * 2 + j) * 8 + (lane >> 3); ov[j] = (unsigned)((h * 128 + d) * SEQ + (((lane & 7) ^ ((d >> 1) & 7)) << 3)); }
        { LAS unsigned* po = (LAS unsigned*)(lds + 122880) + tid; po[0] = okn[0]; po[512] = okn[1]; po[1024] = okp; po[1536] = ov[0]; po[2048] = ov[1]; }
#define ATT_DMA(KT_) do { const int kc_ = (KT_) <= ktmax ? (KT_) : ktmax; LAS unsigned char* b_ = lds + ((KT_) % 3) * 40960; \
        int tq_ = tid; asm volatile("" : "+v"(tq_)); const LAS unsigned* po_ = (const LAS unsigned*)(lds + 122880) + tq_; unsigned okn[2], okp, ov[2]; okn[0] = po_[0]; okn[1] = po_[512]; okp = po_[1024]; ov[0] = po_[1536]; ov[1] = po_[2048]; const bf16_t* kn_ = KN + (size_t)kc_ * 64 * 512; const bf16_t* kq_ = KPE + (size_t)kc_ * 64 * 64; const bf16_t* vt_ = VT + (size_t)kc_ * 64; \
        _Pragma("unroll") for (int j = 0; j < 2; ++j) __builtin_amdgcn_global_load_lds((const unsigned*)(kn_ + okn[j]), (LAS unsigned*)(b_ + (wave * 2 + j) * 1024), 16, 0, 0); \
        __builtin_amdgcn_global_load_lds((const unsigned*)(kq_ + okp), (LAS unsigned*)(b_ + 16384 + wave * 1024), 16, 0, 0); \
        _Pragma("unroll") for (int j = 0; j < 2; ++j) __builtin_amdgcn_global_load_lds((const unsigned*)(vt_ + ov[j]), (LAS unsigned*)(b_ + 24576 + (wave * 2 + j) * 1024), 16, 0, 0); } while (0)
        ATT_DMA(0); ATT_DMA(1);
        bf16x8 qf[2][6];
#pragma unroll
        for (int qs = 0; qs < 2; ++qs) {
            const int row = rowbase + qs * 16 + fr; const bf16_t* qp = Qb + (size_t)row * 768 + h * 192 + fq * 8;
#pragma unroll
            for (int ks = 0; ks < 6; ++ks) qf[qs][ks] = *(const bf16x8*)(qp + ks * 32);
            const int pos = p.pos[row];
#pragma unroll
            for (int i = 0; i < 8; ++i) { float c, s; rope_cs(pos, fq * 8 + i, c, s); const float x1 = bf2f((bf16_t)qf[qs][4][i]), x2 = bf2f((bf16_t)qf[qs][5][i]);
                qf[qs][4][i] = (short)f2bf((x1 * c - x2 * s) * C); qf[qs][5][i] = (short)f2bf((x2 * c + x1 * s) * C); }
#pragma unroll
            for (int ks = 0; ks < 4; ++ks)
#pragma unroll
                for (int i = 0; i < 8; ++i) qf[qs][ks][i] = (short)f2bf(bf2f((bf16_t)qf[qs][ks][i]) * C);
        }
        f32x4 acc[2][8];
#pragma unroll
        for (int qs = 0; qs < 2; ++qs)
#pragma unroll
            for (int db = 0; db < 8; ++db) acc[qs][db] = (f32x4){0.f, 0.f, 0.f, 0.f};
        float mrun[2] = {-1e30f, -1e30f}, lrun[2] = {0.f, 0.f};
#pragma unroll 1
        for (int kt = 0; kt <= ktmax; ++kt) {
            asm volatile("s_waitcnt vmcnt(5) lgkmcnt(0)" ::: "memory");
            __builtin_amdgcn_s_barrier();
            asm volatile("" ::: "memory");
            ATT_DMA(kt + 2);
            if (kt <= cw) {
                LAS unsigned char* Kt = lds + (kt % 3) * 40960; LAS unsigned char* Vt = Kt + 24576;
                f32x4 st[2][4];
                const f32x4 zero4 = {0.f, 0.f, 0.f, 0.f};
#define ATT_KF(ks_, nb_) (((ks_) < 4) ? *(const LAS bf16x8*)(Kt + (kbn ^ ((ks_) << 6)) + (nb_) * 4096) : *(const LAS bf16x8*)(Kt + (kbp ^ (((ks_) - 4) << 6)) + (nb_) * 2048))
                bf16x8 kf[3][2];
#pragma unroll
                for (int hs = 0; hs < 2; ++hs)
#pragma unroll
                    for (int j = 0; j < 2; ++j) kf[hs][j] = ATT_KF(hs >> 1, (hs & 1) * 2 + j);
#pragma unroll
                for (int hs = 0; hs < 12; ++hs) {
                    const int ks = hs >> 1, nb0 = (hs & 1) * 2;
                    if (hs + 2 < 12) {
#pragma unroll
                        for (int j = 0; j < 2; ++j) kf[(hs + 2) % 3][j] = ATT_KF((hs + 2) >> 1, ((hs + 2) & 1) * 2 + j); }
                    __builtin_amdgcn_sched_barrier(0);
#pragma unroll
                    for (int j = 0; j < 2; ++j) { st[0][nb0 + j] = mfma16(kf[hs % 3][j], qf[0][ks], ks == 0 ? zero4 : st[0][nb0 + j]); st[1][nb0 + j] = mfma16(kf[hs % 3][j], qf[1][ks], ks == 0 ? zero4 : st[1][nb0 + j]); }
                    __builtin_amdgcn_sched_barrier(0);
                }
#undef ATT_KF
                bf16x8 bp[2][2];
#pragma unroll
                for (int qs = 0; qs < 2; ++qs) {
                    float mx = -1e30f;
#pragma unroll
                    for (int nb = 0; nb < 4; ++nb)
#pragma unroll
                        for (int i = 0; i < 4; ++i) mx = fmaxf(mx, st[qs][nb][i]);
                    mx = fmaxf(mx, __shfl_xor(mx, 16)); mx = fmaxf(mx, __shfl_xor(mx, 32));
                    const float mnew = fmaxf(mrun[qs], mx); const float alpha = __builtin_amdgcn_exp2f(mrun[qs] - mnew); mrun[qs] = mnew;
                    float ps = 0.f;
#pragma unroll
                    for (int nb = 0; nb < 4; ++nb)
#pragma unroll
                        for (int i = 0; i < 4; ++i) { const float pv = __builtin_amdgcn_exp2f(st[qs][nb][i] - mnew); ps += pv; st[qs][nb][i] = pv; }
                    lrun[qs] = lrun[qs] * alpha + ps;
                    if (__builtin_amdgcn_ballot_w64(alpha != 1.0f) != 0ull) {
#pragma unroll
                        for (int db = 0; db < 8; ++db) acc[qs][db] *= alpha; }
#pragma unroll
                    for (int kk = 0; kk < 2; ++kk) { u32x4 w; w.x = pack2(st[qs][2 * kk][0], st[qs][2 * kk][1]); w.y = pack2(st[qs][2 * kk][2], st[qs][2 * kk][3]);
                        w.z = pack2(st[qs][2 * kk + 1][0], st[qs][2 * kk + 1][1]); w.w = pack2(st[qs][2 * kk + 1][2], st[qs][2 * kk + 1][3]); bp[qs][kk] = __builtin_bit_cast(bf16x8, w); }
                }
#define ATT_VLO(s_) (*(const LAS u32x2*)(Vt + (vb0 ^ ((((s_) >> 3) * 4) << 4)) + ((s_) & 7) * 2048))
#define ATT_VHI(s_) (*(const LAS u32x2*)(Vt + (vb0 ^ ((((s_) >> 3) * 4 + 2) << 4)) + ((s_) & 7) * 2048))
                u32x2 vlo[3], vhi[3];
#pragma unroll
                for (int s = 0; s < 2; ++s) { vlo[s] = ATT_VLO(s); vhi[s] = ATT_VHI(s); }
#pragma unroll
                for (int s = 0; s < 16; ++s) {
                    const int kk = s >> 3, db = s & 7;
                    if (s + 2 < 16) { vlo[(s + 2) % 3] = ATT_VLO(s + 2); vhi[(s + 2) % 3] = ATT_VHI(s + 2); }
                    __builtin_amdgcn_sched_barrier(0);
                    u32x4 w; w.x = vlo[s % 3].x; w.y = vlo[s % 3].y; w.z = vhi[s % 3].x; w.w = vhi[s % 3].y; const bf16x8 a = __builtin_bit_cast(bf16x8, w);
                    acc[0][db] = mfma16(a, bp[0][kk], acc[0][db]); acc[1][db] = mfma16(a, bp[1][kk], acc[1][db]);
                    __builtin_amdgcn_sched_barrier(0);
                }
#undef ATT_VLO
#undef ATT_VHI
            }
        }
#undef ATT_DMA
        asm volatile("s_waitcnt vmcnt(0)" ::: "memory");
#pragma unroll
        for (int qs = 0; qs < 2; ++qs) {
            float l = lrun[qs]; l += __shfl_xor(l, 16); l += __shfl_xor(l, 32); const float inv = 1.0f / l;
            bf16_t* op = O + (size_t)(rowbase + qs * 16 + fr) * 1024 + 512 + h * 128 + fq * 4;
#pragma unroll
            for (int db = 0; db < 8; ++db) { u32x2 w; w.x = pack2(acc[qs][db][0] * inv, acc[qs][db][1] * inv); w.y = pack2(acc[qs][db][2] * inv, acc[qs][db][3] * inv); *(u32x2*)(op + db * 16) = w; }
        }
        __syncthreads();
    }
}

__device__ __forceinline__ void mixer_even(int e, int l, const XcdBarrier& xbar, unsigned char* lds) {
#define LP() const Params p = lds_params(lds)
    _Pragma("unroll 1") for (int rep = 0; rep < (PROBE == 14 ? 2 : 1); ++rep) { LP(); phase_mla_prep(p, e); }
_Pragma("unroll 1") for (int rep = 0; rep < (PROBE == 4 ? 2 : 1); ++rep) { LP(); phase_gdn_intra(p, e, lds); }
    GSYNC();
    if (blockIdx.x < 64 && (blockIdx.x & 7) < 4) { _Pragma("unroll 1") for (int rep = 0; rep < (PROBE == 2 ? 2 : 1); ++rep) { LP(); phase_gdn_scan(p, lds); } }
    else {
        const int Gp = gridDim.x - 32, c = (blockIdx.x < 64) ? (int)(blockIdx.x >> 3) * 4 + (int)(blockIdx.x & 7) - 4 : (int)blockIdx.x - 32;
#pragma unroll 1
        for (int j = 0; j < 3; ++j) {
            LP();
            const bf16_t* CQN = (const bf16_t*)(p.ws + M_CQN); const bf16_t* CKVN = (const bf16_t*)(p.ws + M_CKVN);
            const bf16_t* wuq = (const bf16_t*)(p.ws + W_MIX) + 2816 * 1024 + 1024 * 1024; const bf16_t* wukv = wuq + 768 * 384;
            pg8::Gemm g; bf16_t* Op; int ldc, off;
            if (j == 0) { g = pg8::Gemm{CQN, wuq, SEQ, 768, 384}; Op = (bf16_t*)(p.ws + M_Q); ldc = 768; off = 0; }
            else if (j == 1) { g = pg8::Gemm{CKVN, wukv, SEQ, 512, 256}; Op = (bf16_t*)(p.ws + M_KN); ldc = 512; off = 192 % Gp; }
            else { g = pg8::Gemm{wukv + 512 * 256, CKVN, 512, SEQ, 256}; Op = (bf16_t*)(p.ws + M_VT); ldc = SEQ; off = 320 % Gp; }
            pg8::StaticOrder S; S.init(g.M, g.N, Gp, (c + Gp - off) % Gp); pg8::EpiBf16Plain E{Op, ldc};
            pg8::gemm_phase<pg8::EpiBf16Plain, pg8::StaticOrder, false>((LAS unsigned char*)lds, g, S, E, nullptr);
        }
        { LP(); phase_convert(p, l + 1, (float*)lds, c, Gp); }
        if (l == 0) { LP(); phase_ada(p, (float*)lds, 144, 576, c, Gp); }
    }
    GSYNC();
    _Pragma("unroll 1") for (int rep = 0; rep < (PROBE == 15 ? 2 : 1); ++rep) { LP(); phase_gdn_out(p, e, lds); }
_Pragma("unroll 1") for (int rep = 0; rep < (PROBE == 1 ? 2 : 1); ++rep) { LP(); phase_attn(p, lds); }
    GSYNC();
#undef LP
}

#define SSD_CONV(P_, tok0_, cc_, cwt_, cb_, BODY) do { \
        const float w0_ = (cwt_)[cc_], w1_ = (cwt_)[3072 + (cc_)], w2_ = (cwt_)[6144 + (cc_)], w3_ = (cwt_)[9216 + (cc_)], b_ = (cb_)[cc_]; \
        const bf16_t* src_ = (P_) + (size_t)(tok0_) * OD_N + 2048 + (cc_); \
        float x0_ = 0.f, x1_ = 0.f, x2_ = 0.f; \
        if ((tok0_) > 0) { x0_ = bf2f(src_[-3 * OD_N]); x1_ = bf2f(src_[-2 * OD_N]); x2_ = bf2f(src_[-1 * OD_N]); } \
        _Pragma("unroll") for (int t = 0; t < 64; ++t) { const float x3_ = bf2f(src_[(size_t)t * OD_N]); const float y = silu_f(b_ + w0_ * x0_ + w1_ * x1_ + w2_ * x2_ + w3_ * x3_); BODY; x0_ = x1_; x1_ = x2_; x2_ = x3_; } } while (0)

__device__ __forceinline__ void phase_ssd_states(const Params& p, int o, unsigned char* lds) {
    const int tid = opaque_tid(), wave = tid >> 6, lane = tid & 63, fr = lane & 15, fq = lane >> 4;
    bf16_t* XTS = (bf16_t*)lds; bf16_t* BT = (bf16_t*)(lds + 73728); float* sSc = (float*)(lds + 73728 + 18432);
    const bf16_t* P = (const bf16_t*)(p.ws + OFF_BIG);
    bf16_t* STt = (bf16_t*)(p.ws + OFF_MIX); float* CD = (float*)(p.ws + OFF_CD);
    const float* cwt = p.ssd_conv_w + (size_t)o * 4 * 3072; const float* cb = p.ssd_conv_b + (size_t)o * 3072;
    for (int item = blockIdx.x; item < 1024; item += gridDim.x) {
        const int g = item & 3, n = item >> 2, tok0 = n * 64;
        { const int hh = g * 8 + wave; const float raw = bf2f(P[(size_t)(tok0 + lane) * OD_N + 5120 + hh]); const float dt = softplus_f(raw + p.ssd_dt_bias[o * 32 + hh]);
          const float da = -expf(p.ssd_A_log[o * 32 + hh]) * dt; const float acs = wave_incl_scan(da, lane); const float last = __shfl(acs, 63);
          sSc[wave * 64 + lane] = dt * __expf(last - acs); if (lane == 63) CD[n * 32 + hh] = __expf(acs); }
        __syncthreads();
        if (tid < 256) { const int ch = tid * 2, cc = g * 512 + ch; const float* sc = sSc + (ch >> 6) * 64; bf16_t* dst = XTS + ch * 72;
          CONV_PAIR(P, OD_N, 2048 + cc, tok0, cwt, 3072, cc, cb[cc], cb[cc + 1], { dst[t] = f2bf(y0 * sc[t]); dst[72 + t] = f2bf(y1 * sc[t]); }); }
        else if (tid < 320) { const int ch = (tid - 256) * 2, cc = 2048 + g * 128 + ch; bf16_t* dst = BT + ch * 72;
          CONV_PAIR(P, OD_N, 2048 + cc, tok0, cwt, 3072, cc, cb[cc], cb[cc + 1], { dst[t] = f2bf(y0); dst[72 + t] = f2bf(y1); }); }
        __syncthreads();
        { const int hh = g * 8 + wave;
#pragma unroll 1
          for (int pb = 0; pb < 4; ++pb) {
              bf16x8 xf[2];
#pragma unroll
              for (int ks = 0; ks < 2; ++ks) xf[ks] = *(const bf16x8*)(XTS + (wave * 64 + pb * 16 + fr) * 72 + ks * 32 + fq * 8);
#pragma unroll
              for (int nb = 0; nb < 8; ++nb) { f32x4 d = {0.f, 0.f, 0.f, 0.f};
#pragma unroll
                  for (int ks = 0; ks < 2; ++ks) { const bf16x8 bf = *(const bf16x8*)(BT + (nb * 16 + fr) * 72 + ks * 32 + fq * 8); d = mfma16(bf, xf[ks], d); }
                  u32x2 w; w.x = pack2(d[0], d[1]); w.y = pack2(d[2], d[3]);
                  *(u32x2*)(STt + (((size_t)n * 32 + hh) * 64 + pb * 16 + fr) * 128 + nb * 16 + fq * 4) = w; } } }
        __syncthreads();
    }
}

__device__ __forceinline__ void phase_ssd_scan(const Params& p) {
    unsigned* ST = (unsigned*)(p.ws + OFF_MIX); const float* CD = (const float*)(p.ws + OFF_CD);
    for (size_t e2 = (size_t)blockIdx.x * 512 + opaque_tid(); e2 < 131072; e2 += (size_t)gridDim.x * 512) {
        const int hh = (int)(e2 >> 12); unsigned* ptr = ST + e2; float h0 = 0.f, h1 = 0.f;
#pragma unroll 1
        for (int c0 = 0; c0 < NCH; c0 += 32) {
            unsigned w[32]; float cd[32];
#pragma unroll
            for (int j = 0; j < 32; ++j) { w[j] = ptr[(size_t)(c0 + j) * 131072]; cd[j] = CD[(c0 + j) * 32 + hh]; }
            __builtin_amdgcn_sched_barrier(0);
#pragma unroll
            for (int j = 0; j < 32; ++j) { ptr[(size_t)(c0 + j) * 131072] = pack2(h0, h1); h0 = h0 * cd[j] + bf2f((bf16_t)(w[j] & 0xffff)); h1 = h1 * cd[j] + bf2f((bf16_t)(w[j] >> 16)); }
        }
    }
}

__device__ __forceinline__ void phase_ssd_out(const Params& p, int o, unsigned char* lds) {
    const int tid = opaque_tid(), wave = tid >> 6, lane = tid & 63, fr = lane & 15, fq = lane >> 4;
    bf16_t* Cs = (bf16_t*)lds; bf16_t* Bs = (bf16_t*)(lds + 17408); float* CBm = (float*)(lds + 34816); bf16_t* XT = (bf16_t*)(lds + 52224);
    float* sDt = (float*)(lds + 125952); float* sAcs = sDt + 512; float* sSum = sAcs + 512;
    const bf16_t* P = (const bf16_t*)(p.ws + OFF_BIG); const bf16_t* HS = (const bf16_t*)(p.ws + OFF_MIX); bf16_t* Y = (bf16_t*)(p.ws + OFF_HY);
    const float* cwt = p.ssd_conv_w + (size_t)o * 4 * 3072; const float* cb = p.ssd_conv_b + (size_t)o * 3072;
    for (int item = blockIdx.x; item < 1024; item += gridDim.x) {
        const int g = item & 3, n = item >> 2, tok0 = n * 64;
        const int hh = g * 8 + wave;
        { const float raw = bf2f(P[(size_t)(tok0 + lane) * OD_N + 5120 + hh]); const float dt = softplus_f(raw + p.ssd_dt_bias[o * 32 + hh]);
          const float da = -expf(p.ssd_A_log[o * 32 + hh]) * dt; const float acs = wave_incl_scan(da, lane);
          sDt[wave * 64 + lane] = dt; sAcs[wave * 64 + lane] = acs; if (tid < 64) sSum[tid] = 0.f; }
        _Pragma("unroll 1") for (int rep = 0; rep < (PROBE == 10 ? 2 : 1); ++rep) {
        if (tid < 256) { const int ch = tid * 2, cc = g * 512 + ch; bf16_t* dst = XT + ch * 72;
          CONV_PAIR(P, OD_N, 2048 + cc, tok0, cwt, 3072, cc, cb[cc], cb[cc + 1], { dst[t] = f2bf(y0); dst[72 + t] = f2bf(y1); }); }
        else if (tid < 384) { const int idx = tid - 256; const bool isc = idx >= 64; const int ch = (idx & 63) * 2, cc = 2048 + (isc ? 512 : 0) + g * 128 + ch; bf16_t* dst = (isc ? Cs : Bs) + ch;
          CONV_PAIR(P, OD_N, 2048 + cc, tok0, cwt, 3072, cc, cb[cc], cb[cc + 1], { *(unsigned*)(dst + t * 136) = pack2(y0, y1); }); }
        }
        __syncthreads();
        for (int tI = wave * 2; tI < wave * 2 + 2; ++tI) { const int lb = tI >> 2, sb = tI & 3; f32x4 d = {0.f, 0.f, 0.f, 0.f};
#pragma unroll
            for (int ks = 0; ks < 4; ++ks) { const bf16x8 xb = *(const bf16x8*)(Bs + (sb * 16 + fr) * 136 + ks * 32 + fq * 8), yb = *(const bf16x8*)(Cs + (lb * 16 + fr) * 136 + ks * 32 + fq * 8); d = mfma16(xb, yb, d); }
            *(f32x4*)(CBm + (lb * 16 + fr) * 68 + sb * 16 + fq * 4) = d; }
        __syncthreads();
        _Pragma("unroll 1") for (int rep = 0; rep < (PROBE == 12 ? 2 : 1); ++rep) {
        const float* dts = sDt + wave * 64; const float* acss = sAcs + wave * 64; const float Dh = p.ssd_D[o * 32 + hh];
        bf16x8 hb[4][4];
#pragma unroll
        for (int pb = 0; pb < 4; ++pb)
#pragma unroll
            for (int ks = 0; ks < 4; ++ks) hb[pb][ks] = *(const bf16x8*)(HS + (((size_t)n * 32 + hh) * 64 + pb * 16 + fr) * 128 + ks * 32 + fq * 8);
        u32x2 zwf[4][4];
#pragma unroll
        for (int lb = 0; lb < 4; ++lb)
#pragma unroll
            for (int pb = 0; pb < 4; ++pb) zwf[lb][pb] = *(const u32x2*)(P + (size_t)(tok0 + lb * 16 + fr) * OD_N + hh * 64 + pb * 16 + fq * 4);
#pragma unroll
        for (int lb = 0; lb < 4; ++lb) {
            const int l = lb * 16 + fr; const float al = acss[l]; const float eal = __expf(al);
            bf16x8 ga[2], ca[4];
#pragma unroll
            for (int ks = 0; ks < 2; ++ks) { float gv[8];
#pragma unroll
                for (int i = 0; i < 8; ++i) { const int s = ks * 32 + fq * 8 + i; gv[i] = (s <= l) ? CBm[l * 68 + s] * __expf(al - acss[s]) * dts[s] : 0.f; }
                u32x4 w; w.x = pack2(gv[0], gv[1]); w.y = pack2(gv[2], gv[3]); w.z = pack2(gv[4], gv[5]); w.w = pack2(gv[6], gv[7]); ga[ks] = __builtin_bit_cast(bf16x8, w); }
#pragma unroll
            for (int ks = 0; ks < 4; ++ks) ca[ks] = *(const bf16x8*)(Cs + l * 136 + ks * 32 + fq * 8);
            float sq = 0.f;
#pragma unroll
            for (int pb = 0; pb < 4; ++pb) {
                f32x4 yd = {0.f, 0.f, 0.f, 0.f}, yo = {0.f, 0.f, 0.f, 0.f};
#pragma unroll
                for (int ks = 0; ks < 2; ++ks) { const bf16x8 xb = *(const bf16x8*)(XT + (wave * 64 + pb * 16 + fr) * 72 + ks * 32 + fq * 8); yd = mfma16(xb, ga[ks], yd); }
#pragma unroll
                for (int ks = 0; ks < 4; ++ks) yo = mfma16(hb[pb][ks], ca[ks], yo);
                const u32x2 zw = zwf[lb][pb];
                const float zz[4] = {bf2f((bf16_t)(zw.x & 0xffff)), bf2f((bf16_t)(zw.x >> 16)), bf2f((bf16_t)(zw.y & 0xffff)), bf2f((bf16_t)(zw.y >> 16))};
                float v[4];
#pragma unroll
                for (int i = 0; i < 4; ++i) { const float xv = bf2f(XT[(wave * 64 + pb * 16 + fq * 4 + i) * 72 + l]); v[i] = (yd[i] + eal * yo[i] + Dh * xv) * silu_f(zz[i]); sq += v[i] * v[i]; }
                u32x2 w; w.x = pack2(v[0], v[1]); w.y = pack2(v[2], v[3]);
                *(u32x2*)(Y + (size_t)(tok0 + l) * 2048 + hh * 64 + pb * 16 + fq * 4) = w;
            }
            sq += __shfl_xor(sq, 16); sq += __shfl_xor(sq, 32);
            if (fq == 0 && rep == (PROBE == 12 ? 1 : 0)) atomicAdd(&sSum[l], sq);
        }
        }
        __syncthreads();
        const float* ng = p.ssd_norm_g + (size_t)o * 2048 + hh * 64;
        u32x2 yr[4][4];
#pragma unroll
        for (int lb = 0; lb < 4; ++lb)
#pragma unroll
            for (int pb = 0; pb < 4; ++pb) yr[lb][pb] = *(const u32x2*)(Y + (size_t)(tok0 + lb * 16 + fr) * 2048 + hh * 64 + pb * 16 + fq * 4);
#pragma unroll
        for (int lb = 0; lb < 4; ++lb) { const int l = lb * 16 + fr; const float rs = rsqrtf(sSum[l] * (1.0f / 512.0f) + 1e-6f);
#pragma unroll
            for (int pb = 0; pb < 4; ++pb) { const f32x4 g4 = *(const f32x4*)(ng + pb * 16 + fq * 4);
                u32x2* yp = (u32x2*)(Y + (size_t)(tok0 + l) * 2048 + hh * 64 + pb * 16 + fq * 4); const u32x2 r = yr[lb][pb];
                u32x2 w; w.x = pack2(bf2f((bf16_t)(r.x & 0xffff)) * rs * g4[0], bf2f((bf16_t)(r.x >> 16)) * rs * g4[1]); w.y = pack2(bf2f((bf16_t)(r.y & 0xffff)) * rs * g4[2], bf2f((bf16_t)(r.y >> 16)) * rs * g4[3]);
                *yp = w; } }
        __syncthreads();
    }
}

__device__ __forceinline__ void mixer_odd(int o, const XcdBarrier& xbar, unsigned char* lds) {
#define LP() const Params p = lds_params(lds)
_Pragma("unroll 1") for (int rep = 0; rep < (PROBE == 6 ? 2 : 1); ++rep) { LP(); phase_ssd_states(p, o, lds); }
    GSYNC();
    { LP(); phase_ssd_scan(p); }
    GSYNC();
_Pragma("unroll 1") for (int rep = 0; rep < (PROBE == 5 ? 2 : 1); ++rep) { LP(); phase_ssd_out(p, o, lds); }
    GSYNC();
#undef LP
}

__global__ void __launch_bounds__(512) mega(Params pk) {
    extern __shared__ __attribute__((aligned(16))) unsigned char lds[];
    cg::grid_group grid = cg::this_grid();
    LAS unsigned char* l3 = (LAS unsigned char*)lds;
    float* ldsf = (float*)lds;
    const int G = gridDim.x, bid = blockIdx.x;
    if (threadIdx.x == 0) {
        unsigned long long* dst = (unsigned long long*)(lds + LDS_PARAMS_OFF);
        dst[0] = (unsigned long long)pk.x; dst[1] = (unsigned long long)pk.c; dst[2] = (unsigned long long)pk.pos;
        const float* const* fp = &pk.ada_w;
        for (int i = 0; i < 25; ++i) dst[3 + i] = (unsigned long long)fp[i];
        dst[28] = (unsigned long long)pk.out; dst[29] = (unsigned long long)pk.ws;
    }
    if (threadIdx.x == 1) { ((LAS unsigned*)l3)[147440 / 4] = 0u; ((LAS unsigned*)l3)[147444 / 4] = 0u; }
    __syncthreads();
    if (bid == 0) { unsigned* bw = (unsigned*)(pk.ws + OFF_BAR); for (int i = threadIdx.x; i < 4096; i += 512) bw[i] = 0u; }
#define LP() const Params p = lds_params(lds)
    _Pragma("unroll 1") for (int rep = 0; rep < (PROBE == 13 ? 2 : 1); ++rep) { LP(); phase_ada(p, ldsf, 0, 144, bid, G); }
    grid.sync();
    XcdBarrier xbar = xcd_barrier_post((unsigned*)(pk.ws + OFF_BAR), (volatile LAS unsigned*)(l3 + 147440));
#pragma unroll 1
    for (int l = 0; l < 4; ++l) {
        const bool even = (l & 1) == 0; const int e = l >> 1;
#pragma unroll 1
        for (int sub = 0; sub < 3; ++sub) {
            if (sub == 0 && even) { _Pragma("unroll 1") for (int rep = 0; rep < (PROBE == 7 ? 2 : 1); ++rep) { LP(); phase_convert(p, l, ldsf, bid, G); } }
            _Pragma("unroll 1") for (int rep = 0; rep < (PROBE == 8 ? 2 : 1); ++rep) { LP(); const float* ml = (const float*)(p.ws + OFF_MOD) + l * 9216 + sub * 3072;
              phase_norm((l == 0 && sub == 0) ? p.x : p.out, (bf16_t*)(p.ws + OFF_HY), p.norm_g + (l * 3 + sub) * 1024, ml, ml + 1024); }
            GSYNC();
            const bf16_t* A2; const bf16_t* B2; int K2; float coef;
            if (sub != 1) {
                _Pragma("unroll 1") for (int rep = 0; rep < (PROBE == 3 ? 2 : 1); ++rep) { LP(); const bf16_t* W13 = (const bf16_t*)(p.ws + (size_t)(l & 1) * W_REGION2 + (sub ? W_13B : W_13A));
                  pg8::Gemm g{(const bf16_t*)(p.ws + OFF_HY), W13, SEQ, 5632, 1024}; pg8::StaticOrder S; S.init(SEQ, 5632, G, bid); pg8::EpiSwiglu E{(bf16_t*)(p.ws + OFF_BIG), DFF};
                  pg8::gemm_phase<pg8::EpiSwiglu, pg8::StaticOrder, false>(l3, g, S, E, nullptr); }
                GSYNC();
                { LP(); A2 = (const bf16_t*)(p.ws + OFF_BIG); B2 = (const bf16_t*)(p.ws + (size_t)(l & 1) * W_REGION2 + (sub ? W_2B : W_2A)); } K2 = DFF; coef = 0.5f;
            } else {
                const int Nin = even ? EV_N : OD_N;
                _Pragma("unroll 1") for (int rep = 0; rep < (PROBE == 17 ? 2 : 1); ++rep) { LP(); pg8::Gemm g{(const bf16_t*)(p.ws + OFF_HY), (const bf16_t*)(p.ws + (size_t)(l & 1) * W_REGION2 + W_MIX), SEQ, Nin, 1024}; pg8::StaticOrder S; S.init(SEQ, Nin, G, bid); pg8::EpiBf16Plain E{(bf16_t*)(p.ws + OFF_BIG), Nin};
                  pg8::gemm_phase<pg8::EpiBf16Plain, pg8::StaticOrder, false>(l3, g, S, E, nullptr); }
                GSYNC();
                if (even) mixer_even(e, l, xbar, lds); else mixer_odd(e, xbar, lds);
                { LP(); A2 = (const bf16_t*)(p.ws + OFF_HY); B2 = (const bf16_t*)(p.ws + (size_t)(l & 1) * W_REGION2 + W_MIX) + (even ? 2816 * 1024 : 5376 * 1024); } K2 = even ? 1024 : 2048;
                coef = 1.0f;
            }
            { LP(); const float* ml = (const float*)(p.ws + OFF_MOD) + l * 9216 + sub * 3072;
              pg8::Gemm g{A2, B2, SEQ, 1024, K2}; pg8::StaticOrder S; S.init(SEQ, 1024, G, bid); pg8::EpiResid E{p.out, (l == 0 && sub == 0) ? p.x : p.out, ml + 2048, coef};
              pg8::gemm_phase<pg8::EpiResid, pg8::StaticOrder, false>(l3, g, S, E, nullptr); }
            GSYNC();
        }
    }
    { LP(); phase_final(p.out, p.final_g); }
}

extern "C" void kernel_launch(void* const* d_in, const int* in_sizes, int n_in, void* d_out, int out_size, void* d_ws, size_t ws_size, hipStream_t stream) {
    static int grid_blocks = 0;
    if (grid_blocks == 0) {
        int dev = 0, cus = 0, per_cu = 0;
        hipGetDevice(&dev);
        hipDeviceGetAttribute(&cus, hipDeviceAttributeMultiprocessorCount, dev);
        if (hipFuncSetAttribute((const void*)mega, hipFuncAttributeMaxDynamicSharedMemorySize, LDS_BYTES) != hipSuccess) { fprintf(stderr, "hipFuncSetAttribute failed\n"); grid_blocks = -1; return; }
        hipOccupancyMaxActiveBlocksPerMultiprocessor(&per_cu, (const void*)mega, 512, LDS_BYTES);
        (void)hipGetLastError();
        if (per_cu < 1) per_cu = 1;
        grid_blocks = cus * per_cu;
        if (ws_size < WS_NEED || n_in != 28) { fprintf(stderr, "kernel_launch: ws %zu < %zu or n_in %d\n", ws_size, (size_t)WS_NEED, n_in); grid_blocks = -1; return; }
    }
    if (grid_blocks < 0) return;
    Params p{};
    p.x = (const float*)d_in[0]; p.c = (const float*)d_in[1]; p.pos = (const int*)d_in[2];
    const float** fp = &p.ada_w;
    for (int i = 0; i < 25; ++i) fp[i] = (const float*)d_in[3 + i];
    p.out = (float*)d_out; p.ws = (unsigned char*)d_ws;
    void* args[] = {&p};
    hipError_t e = hipLaunchCooperativeKernel((const void*)mega, dim3(grid_blocks), dim3(512), args, LDS_BYTES, stream);
    if (e != hipSuccess) fprintf(stderr, "cooperative launch failed: %s (grid %d)\n", hipGetErrorString(e), grid_blocks);
}
```
